# Optimizing an MI355X kernel written in HIP

```python
import math
import jax
import jax.numpy as jnp
from jax import lax
import numpy as np

D_MODEL = 2048
BATCH = 8
SEQ = 4096
DEPTH = 1

CHUNK = 64
PLE_DIM = 256
MIX_WIDTH = D_MODEL
SSM_WIDTH = MIX_WIDTH // 2
SSM_GROUP = 16
SSM_GROUPS = SSM_WIDTH // SSM_GROUP
SSM_STATE = 64
SB_WIDTH = MIX_WIDTH - SSM_WIDTH
SB_HEAD_DIM = 128
SB_HEADS = SB_WIDTH // SB_HEAD_DIM
Q_BLOCK = 128
D_FF = ((8 * D_MODEL // 3 + 255) // 256) * 256
EPS = 1e-6
DT_MIN = 1e-3
DT_MAX = 1e-1
LAMBDA_RE_MAX = -1e-4

kernel_name = "hybrid_s5_stickbreaking_macaron_layer"


def rms_norm(x, gain):
    xf = x.astype(jnp.float32)
    y = xf * lax.rsqrt(jnp.mean(xf * xf, axis=-1, keepdims=True) + EPS)
    return (y * gain.astype(jnp.float32)).astype(x.dtype)


def swiglu(h, w_gate, w_up, w_down):
    return (jax.nn.silu(h @ w_gate) * (h @ w_up)) @ w_down


def _ssm_combine(left, right):
    a_l, b_l = left
    a_r, b_r = right
    return a_l * a_r, a_r * b_l + b_r


def s5_mixer(u, lam_re, lam_im, b_re, b_im, c_re, c_im, log_dt, d_skip, w_glu, b_glu):
    bsz, seq, _ = u.shape
    f32 = jnp.float32
    lam = lax.complex(jnp.minimum(lam_re.astype(f32), LAMBDA_RE_MAX), lam_im.astype(f32))
    dt = jnp.exp(log_dt.astype(f32))[:, None]
    lam_bar = jnp.exp(lam * dt)
    b_bar = ((lam_bar - 1.0) / lam)[:, :, None] * lax.complex(b_re.astype(f32), b_im.astype(f32))
    c = lax.complex(c_re.astype(f32), c_im.astype(f32))
    d = d_skip.astype(f32).reshape(SSM_GROUPS, SSM_GROUP)
    n_chunks = seq // CHUNK
    u_c = u.astype(f32).reshape(bsz, n_chunks, CHUNK, SSM_GROUPS, SSM_GROUP).transpose(1, 0, 2, 3, 4)
    a_chunk = jnp.broadcast_to(lam_bar, (bsz, CHUNK, SSM_GROUPS, SSM_STATE))

    def step(state, u_k):
        bu = jnp.einsum("bcgh,gph->bcgp", u_k, b_bar)
        a_cum, s_in = lax.associative_scan(_ssm_combine, (a_chunk, bu), axis=1)
        s = s_in + a_cum * state[:, None]
        y = jnp.real(jnp.einsum("bcgp,ghp->bcgh", s, c)) + d * u_k
        return s[:, -1], y

    state0 = jnp.zeros((bsz, SSM_GROUPS, SSM_STATE), jnp.complex64)
    _, y = lax.scan(step, state0, u_c)
    y = y.transpose(1, 0, 2, 3, 4).reshape(bsz, seq, SSM_WIDTH)
    z = jax.nn.gelu(y)
    out = z * jax.nn.sigmoid(z @ w_glu.astype(f32) + b_glu.astype(f32))
    return out.astype(u.dtype)


def stick_breaking_attention(q, k, v):
    f32 = jnp.float32
    seq = q.shape[2]
    scale = SB_HEAD_DIM ** -0.5
    qf, kf, vf = q.astype(f32), k.astype(f32), v.astype(f32)
    outs = []
    for blk in range(seq // Q_BLOCK):
        q0 = blk * Q_BLOCK
        k_end = q0 + Q_BLOCK
        z = jnp.einsum("bhqd,bhkd->bhqk", qf[:, :, q0:k_end], kf[:, :, :k_end]) * scale
        q_pos = q0 + jnp.arange(Q_BLOCK)[:, None]
        k_pos = jnp.arange(k_end)[None, :]
        before = k_pos < q_pos
        log_keep = jnp.where(before, jax.nn.log_sigmoid(-z), 0.0)
        log_pass = lax.cumsum(log_keep, axis=3, reverse=True) - log_keep
        w = jnp.where(before, jnp.exp(jax.nn.log_sigmoid(z) + log_pass), 0.0)
        outs.append(jnp.einsum("bhqk,bhkd->bhqd", w, vf[:, :, :k_end]))
    return jnp.concatenate(outs, axis=2).astype(q.dtype)


def setup_inputs(seed: int = 0) -> dict:
    key = jax.random.key(seed)
    ks = iter(jax.random.split(key, 40))
    D, F = D_MODEL, D_FF
    G, H, P = SSM_GROUPS, SSM_GROUP, SSM_STATE

    def nrm(shape, scale):
        return scale * jax.random.normal(next(ks), shape, jnp.float32)

    def gain(n):
        return 1.0 + nrm((DEPTH, n), 0.02)

    n_idx = jnp.arange(P, dtype=jnp.float32)
    return {
        "x": nrm((BATCH, SEQ, D), 1.0),
        "p": nrm((DEPTH, BATCH, SEQ, PLE_DIM), 1.0),
        "ffn1_norm": gain(D),
        "ffn1_w_gate": nrm((DEPTH, D, F), D ** -0.5),
        "ffn1_w_up": nrm((DEPTH, D, F), D ** -0.5),
        "ffn1_w_down": nrm((DEPTH, F, D), F ** -0.5),
        "mix_norm": gain(D),
        "w_in": nrm((DEPTH, D, SSM_WIDTH + 3 * SB_WIDTH), D ** -0.5),
        "ssm_lambda_re": -0.5 + nrm((DEPTH, G, P), 0.01),
        "ssm_lambda_im": math.pi * jnp.broadcast_to(n_idx, (DEPTH, G, P)) + nrm((DEPTH, G, P), 0.01),
        "ssm_b_re": nrm((DEPTH, G, P, H), (2 * H) ** -0.5),
        "ssm_b_im": nrm((DEPTH, G, P, H), (2 * H) ** -0.5),
        "ssm_c_re": nrm((DEPTH, G, H, P), (2 * P) ** -0.5),
        "ssm_c_im": nrm((DEPTH, G, H, P), (2 * P) ** -0.5),
        "ssm_log_dt": jax.random.uniform(next(ks), (DEPTH, G), jnp.float32, math.log(DT_MIN), math.log(DT_MAX)),
        "ssm_d": nrm((DEPTH, SSM_WIDTH), 1.0),
        "ssm_w_glu": nrm((DEPTH, SSM_WIDTH, SSM_WIDTH), SSM_WIDTH ** -0.5),
        "ssm_b_glu": nrm((DEPTH, SSM_WIDTH), 0.01),
        "q_norm": gain(SB_HEAD_DIM),
        "k_norm": gain(SB_HEAD_DIM),
        "out_norm_ssm": gain(SSM_WIDTH),
        "out_norm_sb": gain(SB_WIDTH),
        "w_out": nrm((DEPTH, MIX_WIDTH, D), MIX_WIDTH ** -0.5),
        "ffn2_norm": gain(D),
        "ffn2_w_gate": nrm((DEPTH, D, F), D ** -0.5),
        "ffn2_w_up": nrm((DEPTH, D, F), D ** -0.5),
        "ffn2_w_down": nrm((DEPTH, F, D), F ** -0.5),
        "ple_norm": gain(D),
        "w_ple_gate": nrm((DEPTH, D, D), D ** -0.5),
        "w_ple_proj": nrm((DEPTH, PLE_DIM, D), PLE_DIM ** -0.5),
        "ple_post_norm": gain(D),
    }


def reference(x, p, ffn1_norm, ffn1_w_gate, ffn1_w_up, ffn1_w_down, mix_norm, w_in,
              ssm_lambda_re, ssm_lambda_im, ssm_b_re, ssm_b_im, ssm_c_re, ssm_c_im,
              ssm_log_dt, ssm_d, ssm_w_glu, ssm_b_glu, q_norm, k_norm,
              out_norm_ssm, out_norm_sb, w_out, ffn2_norm, ffn2_w_gate, ffn2_w_up,
              ffn2_w_down, ple_norm, w_ple_gate, w_ple_proj, ple_post_norm):
    bsz, seq, _ = x.shape
    for i in range(DEPTH):
        x = x + 0.5 * swiglu(rms_norm(x, ffn1_norm[i]), ffn1_w_gate[i], ffn1_w_up[i], ffn1_w_down[i])

        h = rms_norm(x, mix_norm[i])
        proj = h @ w_in[i]
        u = proj[..., :SSM_WIDTH]
        q = proj[..., SSM_WIDTH:SSM_WIDTH + SB_WIDTH].reshape(bsz, seq, SB_HEADS, SB_HEAD_DIM)
        k = proj[..., SSM_WIDTH + SB_WIDTH:SSM_WIDTH + 2 * SB_WIDTH].reshape(bsz, seq, SB_HEADS, SB_HEAD_DIM)
        v = proj[..., SSM_WIDTH + 2 * SB_WIDTH:].reshape(bsz, seq, SB_HEADS, SB_HEAD_DIM)

        y_ssm = s5_mixer(u, ssm_lambda_re[i], ssm_lambda_im[i], ssm_b_re[i], ssm_b_im[i],
                         ssm_c_re[i], ssm_c_im[i], ssm_log_dt[i], ssm_d[i], ssm_w_glu[i], ssm_b_glu[i])

        q = rms_norm(q, q_norm[i]).transpose(0, 2, 1, 3)
        k = rms_norm(k, k_norm[i]).transpose(0, 2, 1, 3)
        y_sb = stick_breaking_attention(q, k, v.transpose(0, 2, 1, 3))
        y_sb = y_sb.transpose(0, 2, 1, 3).reshape(bsz, seq, SB_WIDTH)

        mixed = jnp.concatenate([rms_norm(y_ssm, out_norm_ssm[i]), rms_norm(y_sb, out_norm_sb[i])], axis=-1)
        x = x + mixed @ w_out[i]

        x = x + 0.5 * swiglu(rms_norm(x, ffn2_norm[i]), ffn2_w_gate[i], ffn2_w_up[i], ffn2_w_down[i])

        gate = jax.nn.sigmoid(rms_norm(x, ple_norm[i]) @ w_ple_gate[i])
        e = (p[i] @ w_ple_proj[i]) * gate
        x = x + rms_norm(e, ple_post_norm[i])
    return x
```

```cpp
#include <hip/hip_runtime.h>
#include <hip/hip_cooperative_groups.h>
#include <cstdio>
#include <cstdint>
namespace cg = cooperative_groups;
namespace pg8 {
#define PG8_LAS __attribute__((address_space(3)))
typedef unsigned short bf16_t;
typedef short bf16x8 __attribute__((ext_vector_type(8)));
typedef float f32x4 __attribute__((ext_vector_type(4)));
typedef unsigned u32x4 __attribute__((ext_vector_type(4)));
constexpr int BM = 256, BK = 64, HALF = 128, HTB = HALF * BK * 2  , STAGE_BYTES = 8 * HTB, NXCD = 8, WGM = 8;

__host__ __device__ __forceinline__ int lds_byte(int r, int c) { const int st = (r >> 4) * 2 + (c >> 5), rr = r & 15, cc = c & 31, ob = rr * 64 + cc * 2; return st * 1024 + (ob ^ (((ob >> 9) & 1) << 5)); }
__host__ __device__ __forceinline__ void stage_rc(int b, int& R, int& C) { const int st = b / 1024, sb = b % 1024, swz = sb ^ (((sb >> 9) & 1) << 5); R = (st >> 1) * 16 + swz / 64; C = (st & 1) * 32 + (swz % 64) / 2; }
__host__ __device__ __forceinline__ int perm32(int rho) { const int n = rho >> 4, i = rho & 15; return 8 * (i >> 2) + 4 * n + (i & 3); }

struct Unit { int pm, pn, kh; };
struct Gemm { const bf16_t* A; const bf16_t* Bt; int M, N, K, KU; };

struct StaticOrder {
    int nM, nN, nwg, G, c;
    __host__ __device__ void init(int M, int N, int G_, int c_) { nM = M / BM; nN = N / BM; nwg = nM * nN; G = G_; c = c_; }
    __host__ __device__ bool next(int i, Unit& u) const {
        const long L = (long)i * G + c; if (L >= nwg) return false;
        int wgid = (int)L; { const int q = nwg / NXCD, r = nwg % NXCD, xcd = wgid % NXCD, off = wgid / NXCD; wgid = (xcd < r ? xcd * (q + 1) : r * (q + 1) + (xcd - r) * q) + off; }
        const int nig = WGM * nN, gid = wgid / nig, fm = gid * WGM, gsz = (nM - fm) < WGM ? (nM - fm) : WGM;
        u.pm = fm + ((wgid % nig) % gsz); u.pn = (wgid % nig) / gsz; u.kh = 0; return true;
    }
    __device__ __forceinline__ void a_ready(const Unit&) const {}
    __device__ __forceinline__ void done(const Unit&) const {}
};

__device__ __forceinline__ unsigned cvt_pk_bf16(float lo, float hi) { unsigned r; asm volatile("v_cvt_pk_bf16_f32 %0, %1, %2" : "=v"(r) : "v"(lo), "v"(hi)); return r; }
struct SplitOrder {
    StaticOrder base;
    __device__ bool next(int i, Unit& u) const { const bool r = base.next(i >> 1, u); u.kh = i & 1; return r; }
    __device__ __forceinline__ void a_ready(const Unit&) const {}
    __device__ __forceinline__ void done(const Unit&) const {}
};
typedef float f32x2 __attribute__((ext_vector_type(2)));
__device__ __forceinline__ float rstd_of(float ss, float inv_n) { return __builtin_amdgcn_rsqf(ss * inv_n + 1e-6f); }
__device__ __forceinline__ float sigmoid_f(float v) { return __builtin_amdgcn_rcpf(1.0f + __builtin_amdgcn_exp2f(-1.4426950408889634f * v)); }
__device__ __forceinline__ float bf_lo(unsigned w) { return __uint_as_float(w << 16); }
__device__ __forceinline__ float bf_hi(unsigned w) { return __uint_as_float(w & 0xffff0000u); }
__device__ __forceinline__ u32x4 pack8(const f32x4 a, const f32x4 b) { u32x4 w; w.x = cvt_pk_bf16(a[0], a[1]); w.y = cvt_pk_bf16(a[2], a[3]); w.z = cvt_pk_bf16(b[0], b[1]); w.w = cvt_pk_bf16(b[2], b[3]); return w; }
__device__ __forceinline__ float sumsq4(const f32x4 a) { return (a[0] * a[0] + a[1] * a[1]) + (a[2] * a[2] + a[3] * a[3]); }

struct EpiSwiGLU {
    static constexpr bool PERM = true, AFTER_DRAIN = false, MID = false;
    bf16_t* O; const float* ss; int ldo;
    __device__ __forceinline__ void operator()(f32x4 (&acc)[2][2][4][2], const Unit& u, int wr, int wc, int fr, int fq) const {
        const int row0 = u.pm * BM + wr * 64 + fr, col0 = u.pn * HALF + wc * 32 + 8 * fq;
#pragma unroll
        for (int ai = 0; ai < 2; ++ai)
#pragma unroll
            for (int m = 0; m < 4; ++m) {
                const int row = row0 + ai * HALF + m * 16; const float r = rstd_of(ss[row], 1.0f / 2048.0f);
                f32x4 o[2];
#pragma unroll
                for (int n = 0; n < 2; ++n) { const f32x4 g = acc[ai][0][m][n] * r, uu = acc[ai][1][m][n] * r;
#pragma unroll
                    for (int e = 0; e < 4; ++e) o[n][e] = g[e] * uu[e] * sigmoid_f(g[e]); }
                *(u32x4*)(O + (size_t)row * ldo + col0) = pack8(o[0], o[1]);
            }
    }
    __device__ __forceinline__ void mid(f32x4 (&)[2][2][4][2], const Unit&, int, int) const {}
};

template <int MODE> struct EpiResid {
    static constexpr bool PERM = true, AFTER_DRAIN = false, MID = (MODE == 1);
    const float* xin; float* xout; bf16_t* xb; float* ssout; const float* ssa; const float* ssb;
    __device__ __forceinline__ void mid(f32x4 (&acc)[2][2][4][2], const Unit& u, int wr, int fr) const {
        {
            const int row0 = u.pm * BM + wr * 64 + fr;
#pragma unroll
            for (int ai = 0; ai < 2; ++ai)
#pragma unroll
                for (int m = 0; m < 4; ++m) { const int row = row0 + ai * HALF + m * 16;
                    const float ra = rstd_of(ssa[row], 1.0f / 1024.0f), rb = rstd_of(ssb[row], 1.0f / 1024.0f), ratio = ra * __builtin_amdgcn_rcpf(rb);
#pragma unroll
                    for (int bj = 0; bj < 2; ++bj)
#pragma unroll
                        for (int n = 0; n < 2; ++n) acc[ai][bj][m][n] = acc[ai][bj][m][n] * ratio;
                    asm volatile("" ::: "memory"); }
        }
    }
    __device__ __forceinline__ void operator()(f32x4 (&acc)[2][2][4][2], const Unit& u, int wr, int wc, int fr, int fq) const {
        if (MODE == 1 && u.kh == 0) { mid(acc, u, wr, fr); return; }
        const int row0 = u.pm * BM + wr * 64 + fr, col0 = u.pn * BM + wc * 32 + 8 * fq;
#pragma unroll
        for (int ai = 0; ai < 2; ++ai)
#pragma unroll
            for (int m = 0; m < 4; ++m) {
                const int row = row0 + ai * HALF + m * 16; const size_t off = (size_t)row * 2048 + col0;
                float sc = 0.5f; if constexpr (MODE == 1) sc = rstd_of(ssb[row], 1.0f / 1024.0f);
                float q = 0.f;
#pragma unroll
                for (int bj = 0; bj < 2; ++bj) {
                    const f32x4 x0 = *(const f32x4*)(xin + off + bj * HALF), x1 = *(const f32x4*)(xin + off + bj * HALF + 4);
                    const f32x4 v0 = x0 + acc[ai][bj][m][0] * sc, v1 = x1 + acc[ai][bj][m][1] * sc;
                    *(f32x4*)(xout + off + bj * HALF) = v0; *(f32x4*)(xout + off + bj * HALF + 4) = v1;
                    *(u32x4*)(xb + off + bj * HALF) = pack8(v0, v1);
                    q += sumsq4(v0) + sumsq4(v1);
                }
                q += __shfl_xor(q, 16); q += __shfl_xor(q, 32);
                if (fq == 0) atomicAdd(ssout + row, q);
                asm volatile("" ::: "memory");
            }
    }
};

struct EpiWin {
    static constexpr bool PERM = true, AFTER_DRAIN = false, MID = false;
    const float* ss; bf16_t *UG, *Q, *K, *V; const float *gq, *gk; PG8_LAS float* xch;
    __device__ __forceinline__ void mid(f32x4 (&)[2][2][4][2], const Unit&, int, int) const {}
    __device__ __forceinline__ void operator()(f32x4 (&acc)[2][2][4][2], const Unit& u, int wr, int wc, int fr, int fq) const {
        const int row0 = u.pm * BM + wr * 64 + fr, seg = u.pn >> 2, lc0 = (u.pn & 3) * BM + wc * 32 + 8 * fq; const float* ssr = ss + row0;
        if (seg == 0) {
#pragma unroll
            for (int ai = 0; ai < 2; ++ai)
#pragma unroll
                for (int m = 0; m < 4; ++m) { const float r = rstd_of(ssr[ai * HALF + m * 16], 1.0f / 2048.0f); const int row = row0 + ai * HALF + m * 16, b = row >> 12, t = row & 4095;
#pragma unroll
                    for (int bj = 0; bj < 2; ++bj) { const int col = lc0 + bj * HALF, g = col >> 4, half = (col >> 3) & 1;
                        *(u32x4*)(UG + ((size_t)((b * 64 + g) * 4096 + t) * 16 + 8 * half)) = pack8(acc[ai][bj][m][0] * r, acc[ai][bj][m][1] * r); } }
        } else if (seg == 3) {
#pragma unroll
            for (int ai = 0; ai < 2; ++ai)
#pragma unroll
                for (int m = 0; m < 4; ++m) { const float r = rstd_of(ssr[ai * HALF + m * 16], 1.0f / 2048.0f); const int row = row0 + ai * HALF + m * 16;
#pragma unroll
                    for (int bj = 0; bj < 2; ++bj) *(u32x4*)(V + (size_t)row * 1024 + lc0 + bj * HALF) = pack8(acc[ai][bj][m][0] * r, acc[ai][bj][m][1] * r); }
        } else {
#pragma unroll
            for (int ai = 0; ai < 2; ++ai)
#pragma unroll
                for (int m = 0; m < 4; ++m) { const int rl = ai * HALF + wr * 64 + m * 16 + fr;
#pragma unroll
                    for (int bj = 0; bj < 2; ++bj) { float q = sumsq4(acc[ai][bj][m][0]) + sumsq4(acc[ai][bj][m][1]); q += __shfl_xor(q, 16); q += __shfl_xor(q, 32);
                        if (fq == 0) xch[rl * 8 + bj * 4 + wc] = q; } }
            asm volatile("s_waitcnt lgkmcnt(0)" ::: "memory"); __builtin_amdgcn_s_barrier(); asm volatile("" ::: "memory");
            const float* gain = (seg == 1) ? gq : gk; bf16_t* dst = (seg == 1) ? Q : K;
            const float osc = (seg == 1) ? (0.08838834764831845f * 1.4426950408889634f) : 1.0f;
            const int d0 = wc * 32 + 8 * fq;
            const f32x4 g0 = *(const f32x4*)(gain + d0) * osc, g1 = *(const f32x4*)(gain + d0 + 4) * osc;
#pragma unroll
            for (int ai = 0; ai < 2; ++ai)
#pragma unroll
                for (int m = 0; m < 4; ++m) { const int rl = ai * HALF + wr * 64 + m * 16 + fr, row = u.pm * BM + rl;
                    const float epr = 1e-6f * (ssr[ai * HALF + m * 16] * (1.0f / 2048.0f) + 1e-6f);
#pragma unroll
                    for (int bj = 0; bj < 2; ++bj) { const f32x4 p = *(const PG8_LAS f32x4*)(xch + rl * 8 + bj * 4);
                        const float rq = __builtin_amdgcn_rsqf(((p[0] + p[1]) + (p[2] + p[3])) * (1.0f / 128.0f) + epr);
                        *(u32x4*)(dst + (size_t)row * 1024 + lc0 + bj * HALF) = pack8(acc[ai][bj][m][0] * g0 * rq, acc[ai][bj][m][1] * g1 * rq); } }
        }
    }
};

struct EpiGlu {
    static constexpr bool PERM = true, AFTER_DRAIN = false, MID = false;
    const bf16_t* Z; const float* bias; bf16_t* Y; float* ssout;
    __device__ __forceinline__ void mid(f32x4 (&)[2][2][4][2], const Unit&, int, int) const {}
    __device__ __forceinline__ void operator()(f32x4 (&acc)[2][2][4][2], const Unit& u, int wr, int wc, int fr, int fq) const {
        const int row0 = u.pm * BM + wr * 64 + fr, col0 = u.pn * BM + wc * 32 + 8 * fq;
        f32x4 bv[2][2];
#pragma unroll
        for (int bj = 0; bj < 2; ++bj)
#pragma unroll
            for (int n = 0; n < 2; ++n) bv[bj][n] = *(const f32x4*)(bias + col0 + bj * HALF + 4 * n);
#pragma unroll
        for (int ai = 0; ai < 2; ++ai)
#pragma unroll
            for (int m = 0; m < 4; ++m) { const int row = row0 + ai * HALF + m * 16; float q = 0.f;
#pragma unroll
                for (int bj = 0; bj < 2; ++bj) { const u32x4 zb = *(const u32x4*)(Z + (size_t)row * 1024 + col0 + bj * HALF);
                    const f32x4 z0 = {bf_lo(zb.x), bf_hi(zb.x), bf_lo(zb.y), bf_hi(zb.y)}, z1 = {bf_lo(zb.z), bf_hi(zb.z), bf_lo(zb.w), bf_hi(zb.w)};
                    const f32x4 a0 = acc[ai][bj][m][0] + bv[bj][0], a1 = acc[ai][bj][m][1] + bv[bj][1]; f32x4 y0, y1;
#pragma unroll
                    for (int e = 0; e < 4; ++e) { y0[e] = z0[e] * sigmoid_f(a0[e]); y1[e] = z1[e] * sigmoid_f(a1[e]); }
                    *(u32x4*)(Y + (size_t)row * 2048 + col0 + bj * HALF) = pack8(y0, y1); q += sumsq4(y0) + sumsq4(y1); }
                q += __shfl_xor(q, 16); q += __shfl_xor(q, 32);
                if (fq == 0) atomicAdd(ssout + row, q);
                asm volatile("" ::: "memory"); }
    }
};

struct EpiPle {
    static constexpr bool PERM = true, AFTER_DRAIN = false, MID = false;
    const bf16_t* PP; const float* ss; bf16_t* E; float* ssout;
    __device__ __forceinline__ void mid(f32x4 (&)[2][2][4][2], const Unit&, int, int) const {}
    __device__ __forceinline__ void operator()(f32x4 (&acc)[2][2][4][2], const Unit& u, int wr, int wc, int fr, int fq) const {
        const int row0 = u.pm * BM + wr * 64 + fr, col0 = u.pn * BM + wc * 32 + 8 * fq;
#pragma unroll
        for (int ai = 0; ai < 2; ++ai)
#pragma unroll
            for (int m = 0; m < 4; ++m) { const int row = row0 + ai * HALF + m * 16; const float r = rstd_of(ss[row], 1.0f / 2048.0f); float q = 0.f;
#pragma unroll
                for (int bj = 0; bj < 2; ++bj) { const u32x4 pb = *(const u32x4*)(PP + (size_t)row * 2048 + col0 + bj * HALF);
                    const f32x4 p0 = {bf_lo(pb.x), bf_hi(pb.x), bf_lo(pb.y), bf_hi(pb.y)}, p1 = {bf_lo(pb.z), bf_hi(pb.z), bf_lo(pb.w), bf_hi(pb.w)};
                    const f32x4 a0 = acc[ai][bj][m][0] * r, a1 = acc[ai][bj][m][1] * r; f32x4 y0, y1;
#pragma unroll
                    for (int e = 0; e < 4; ++e) { y0[e] = p0[e] * sigmoid_f(a0[e]); y1[e] = p1[e] * sigmoid_f(a1[e]); }
                    *(u32x4*)(E + (size_t)row * 2048 + col0 + bj * HALF) = pack8(y0, y1); q += sumsq4(y0) + sumsq4(y1); }
                q += __shfl_xor(q, 16); q += __shfl_xor(q, 32);
                if (fq == 0) atomicAdd(ssout + row, q);
                asm volatile("" ::: "memory"); }
    }
};

struct EpiPlain {
    static constexpr bool PERM = true, AFTER_DRAIN = false, MID = false;
    bf16_t* O; int ldo;
    __device__ __forceinline__ void mid(f32x4 (&)[2][2][4][2], const Unit&, int, int) const {}
    __device__ __forceinline__ void operator()(f32x4 (&acc)[2][2][4][2], const Unit& u, int wr, int wc, int fr, int fq) const {
        const int row0 = u.pm * BM + wr * 64 + fr, col0 = u.pn * BM + wc * 32 + 8 * fq;
#pragma unroll
        for (int ai = 0; ai < 2; ++ai)
#pragma unroll
            for (int m = 0; m < 4; ++m) { const int row = row0 + ai * HALF + m * 16;
#pragma unroll
                for (int bj = 0; bj < 2; ++bj) *(u32x4*)(O + (size_t)row * ldo + col0 + bj * HALF) = pack8(acc[ai][bj][m][0], acc[ai][bj][m][1]); }
    }
};
template <class Epi, class Sched, bool ALIGN_EPI = false, bool SP2 = false>
__device__ __forceinline__ void gemm_phase(PG8_LAS unsigned char* lds, const Gemm g, const Sched& S, const Epi& E, const int wave_s) {
    unsigned ones_ = ~0u; asm volatile("" : "+s"(ones_));
    const int lane = (int)__builtin_amdgcn_mbcnt_hi(ones_, __builtin_amdgcn_mbcnt_lo(ones_, 0u)), wid = wave_s, tid = wid * 64 + lane, wr = wid >> 2, wc = wid & 3, fr = lane & 15, fq = lane >> 4;
    const int K = g.K, nt = g.KU / BK;
    unsigned voffA[2], voffB[2];
#pragma unroll
    for (int i = 0; i < 2; ++i) { int R, C; stage_rc(tid * 16 + i * 8192, R, C); const int Rb = Epi::PERM ? ((R & ~31) + perm32(R & 31)) : R;
        voffA[i] = (unsigned)(R * K + C) * 2u; voffB[i] = (unsigned)(Rb * K + C) * 2u; }
    const size_t kstep = (size_t)(BK * 2);
    const size_t hstep = (size_t)HALF * K * 2;
    const size_t tstep = 2 * hstep;
    const unsigned ldsw = (unsigned)wid * 1024u;
    const int aoff = lds_byte(wr * 64 + fr, fq * 8), boff = lds_byte(wc * 32 + fr, fq * 8);
#define PG8_SA(b, h) (((b) * 2 + (h)) * HTB)
#define PG8_SB(b, h) ((4 + (b) * 2 + (h)) * HTB)
#define PG8_STAGE(bufoff, gbase, voff) do { _Pragma("unroll") for (int _i = 0; _i < 2; ++_i) \
        __builtin_amdgcn_global_load_lds((const unsigned*)((const char*)(gbase) + (voff)[_i]), (PG8_LAS unsigned*)(lds + (bufoff) + ldsw + _i * 8192), 16, 0, 0); } while (0)
#define PG8_LDA(dst, b, h) do { _Pragma("unroll") for (int m = 0; m < 4; ++m) _Pragma("unroll") for (int k = 0; k < 2; ++k) dst[m][k] = *(const PG8_LAS bf16x8*)(lds + PG8_SA(b, h) + aoff + m * 2048 + k * 1024); } while (0)
#define PG8_LDB(dst, b, h) do { _Pragma("unroll") for (int n = 0; n < 2; ++n) _Pragma("unroll") for (int k = 0; k < 2; ++k) dst[n][k] = *(const PG8_LAS bf16x8*)(lds + PG8_SB(b, h) + boff + n * 2048 + k * 1024); } while (0)
#define PG8_MMA(ai, bj, At, Bt) do { __builtin_amdgcn_s_setprio(1); _Pragma("unroll") for (int m = 0; m < 4; ++m) _Pragma("unroll") for (int n = 0; n < 2; ++n) _Pragma("unroll") for (int k = 0; k < 2; ++k) \
        acc[ai][bj][m][n] = __builtin_amdgcn_mfma_f32_16x16x32_bf16(Bt[n][k], At[m][k], acc[ai][bj][m][n], 0, 0, 0); __builtin_amdgcn_s_setprio(0); } while (0)
#define PG8_WAIT_V(n) asm volatile("s_waitcnt vmcnt(" #n ")" ::: "memory")
#define PG8_WAIT_L(n) asm volatile("s_waitcnt lgkmcnt(" #n ")" ::: "memory")
#define PG8_BAR __builtin_amdgcn_s_barrier()
#define PG8_SCHED __builtin_amdgcn_sched_barrier(0)
    Unit cur, nxt; int ui = 0;
    if (!S.next(0, cur)) return;
    f32x4 acc[2][2][4][2];
#pragma unroll
    for (int a = 0; a < 2; ++a)
#pragma unroll
        for (int b = 0; b < 2; ++b)
#pragma unroll
            for (int m = 0; m < 4; ++m)
#pragma unroll
                for (int n = 0; n < 2; ++n) acc[a][b][m][n] = (f32x4){0.f, 0.f, 0.f, 0.f};
    bf16x8 At[4][2], B0[2][2], B1[2][2];
    const size_t khb = (size_t)g.KU * 2; const char* cA = (const char*)g.A + (size_t)cur.pm * tstep + cur.kh * khb; const char* cB = (const char*)g.Bt + (size_t)cur.pn * tstep + cur.kh * khb;
    S.a_ready(cur);
    if constexpr (SP2) {
        PG8_STAGE(PG8_SB(0, 0), cB, voffB); PG8_STAGE(PG8_SB(0, 1), cB + hstep, voffB); PG8_STAGE(PG8_SA(0, 0), cA, voffA); PG8_STAGE(PG8_SA(0, 1), cA + hstep, voffA);
        if (wr == 1) PG8_BAR;
        PG8_WAIT_V(2); PG8_BAR;
        PG8_STAGE(PG8_SB(1, 0), cB + kstep, voffB); PG8_STAGE(PG8_SA(1, 0), cA + kstep, voffA); PG8_STAGE(PG8_SB(1, 1), cB + hstep + kstep, voffB);
        PG8_WAIT_V(6); PG8_BAR;
    } else {
        PG8_STAGE(PG8_SB(0, 0), cB, voffB); PG8_STAGE(PG8_SA(0, 0), cA, voffA); PG8_STAGE(PG8_SB(0, 1), cB + hstep, voffB); PG8_STAGE(PG8_SA(0, 1), cA + hstep, voffA);
        if (wr == 1) PG8_BAR;
        PG8_WAIT_V(4); PG8_BAR;
        PG8_STAGE(PG8_SB(1, 0), cB + kstep, voffB); PG8_STAGE(PG8_SA(1, 0), cA + kstep, voffA); PG8_STAGE(PG8_SB(1, 1), cB + hstep + kstep, voffB);
        PG8_WAIT_V(6); PG8_BAR;
    }
    for (;;) {
        const bool has_next = S.next(ui + 1, nxt);
        const char* nA = has_next ? (const char*)g.A + (size_t)nxt.pm * tstep + nxt.kh * khb : cA; const char* nB = has_next ? (const char*)g.Bt + (size_t)nxt.pn * tstep + nxt.kh * khb : cB;
        for (int t = 0; t < nt; t += 2) {
            const bool last = (t == nt - 2);
            const char* a1 = cA + (size_t)(t + 1) * kstep;
            const char* a2 = last ? nA : cA + (size_t)(t + 2) * kstep; const char* b2 = last ? nB : cB + (size_t)(t + 2) * kstep;
            const char* a3 = a2 + kstep; const char* b3 = b2 + kstep;
            if (last && has_next) S.a_ready(nxt);
            if constexpr (SP2) {
            PG8_LDB(B0, 0, 0); PG8_LDB(B1, 0, 1); PG8_SCHED; PG8_LDA(At, 0, 0); PG8_STAGE(PG8_SA(1, 1), a1 + hstep, voffA);
            PG8_WAIT_V(8); PG8_WAIT_L(0); PG8_BAR; PG8_MMA(0, 0, At, B0); PG8_MMA(0, 1, At, B1); PG8_BAR; PG8_SCHED;
            PG8_LDA(At, 0, 1); PG8_STAGE(PG8_SB(0, 0), b2, voffB); PG8_STAGE(PG8_SB(0, 1), b2 + hstep, voffB); PG8_STAGE(PG8_SA(0, 0), a2, voffA);
            PG8_WAIT_V(8); PG8_WAIT_L(0); PG8_BAR; PG8_MMA(1, 0, At, B0); PG8_MMA(1, 1, At, B1); PG8_BAR; PG8_SCHED;
            PG8_LDB(B0, 1, 0); PG8_LDB(B1, 1, 1); PG8_SCHED; PG8_LDA(At, 1, 0); PG8_STAGE(PG8_SA(0, 1), a2 + hstep, voffA);
            PG8_WAIT_V(8); PG8_WAIT_L(0); PG8_BAR; PG8_MMA(0, 0, At, B0); PG8_MMA(0, 1, At, B1); PG8_BAR; PG8_SCHED;
            PG8_LDA(At, 1, 1); PG8_STAGE(PG8_SB(1, 0), b3, voffB); PG8_STAGE(PG8_SB(1, 1), b3 + hstep, voffB); PG8_STAGE(PG8_SA(1, 0), a3, voffA);
            PG8_WAIT_V(8); PG8_WAIT_L(0); PG8_BAR; PG8_MMA(1, 0, At, B0); PG8_MMA(1, 1, At, B1); PG8_BAR; PG8_SCHED;
            } else {
            PG8_LDB(B0, 0, 0); PG8_SCHED; PG8_LDA(At, 0, 0); PG8_STAGE(PG8_SA(1, 1), a1 + hstep, voffA);
            PG8_WAIT_L(8); PG8_BAR; PG8_WAIT_L(0); PG8_MMA(0, 0, At, B0); PG8_BAR; PG8_SCHED;
            PG8_LDB(B1, 0, 1); PG8_STAGE(PG8_SB(0, 0), b2, voffB);
            PG8_BAR; PG8_WAIT_L(0); PG8_MMA(0, 1, At, B1); PG8_BAR;
            PG8_LDA(At, 0, 1); PG8_STAGE(PG8_SA(0, 0), a2, voffA);
            PG8_BAR; PG8_WAIT_L(0); PG8_MMA(1, 0, At, B0); PG8_BAR; PG8_SCHED;
            PG8_STAGE(PG8_SB(0, 1), b2 + hstep, voffB);
            PG8_WAIT_V(6); PG8_BAR; PG8_MMA(1, 1, At, B1); PG8_BAR;
            PG8_LDB(B0, 1, 0); PG8_SCHED; PG8_LDA(At, 1, 0); PG8_STAGE(PG8_SA(0, 1), a2 + hstep, voffA);
            PG8_WAIT_L(8); PG8_BAR; PG8_WAIT_L(0); PG8_MMA(0, 0, At, B0); PG8_BAR; PG8_SCHED;
            PG8_LDB(B1, 1, 1); PG8_STAGE(PG8_SB(1, 0), b3, voffB);
            PG8_BAR; PG8_WAIT_L(0); PG8_MMA(0, 1, At, B1); PG8_BAR;
            PG8_LDA(At, 1, 1); PG8_STAGE(PG8_SA(1, 0), a3, voffA);
            PG8_BAR; PG8_WAIT_L(0); PG8_MMA(1, 0, At, B0); PG8_BAR; PG8_SCHED;
            PG8_STAGE(PG8_SB(1, 1), b3 + hstep, voffB);
            PG8_WAIT_V(6); PG8_BAR; PG8_MMA(1, 1, At, B1); PG8_BAR;
            }
        }
        if constexpr (ALIGN_EPI) { if (wr == 0) PG8_BAR; }
        if constexpr (!Epi::AFTER_DRAIN) { E(acc, cur, wr, wc, fr, fq); S.done(cur); }
        if (!has_next) break;
        if (!(Epi::MID && cur.kh == 0))
#pragma unroll
        for (int a = 0; a < 2; ++a)
#pragma unroll
            for (int b = 0; b < 2; ++b)
#pragma unroll
                for (int m = 0; m < 4; ++m)
#pragma unroll
                    for (int n = 0; n < 2; ++n) acc[a][b][m][n] = (f32x4){0.f, 0.f, 0.f, 0.f};
        cur = nxt; cA = nA; cB = nB; ++ui;
        if constexpr (ALIGN_EPI) { if (wr == 1) PG8_BAR; }
    }
    PG8_WAIT_V(0);
    if constexpr (!ALIGN_EPI) { if (wr == 0) PG8_BAR; }
    PG8_BAR;
    if constexpr (Epi::AFTER_DRAIN) { E.fused(acc, cur, wr, wc, fr, fq, lds, wid, lane); S.done(cur); }
#undef PG8_SA
#undef PG8_SB
#undef PG8_STAGE
#undef PG8_LDA
#undef PG8_LDB
#undef PG8_MMA
#undef PG8_WAIT_V
#undef PG8_WAIT_L
#undef PG8_BAR
#undef PG8_SCHED
}
}
constexpr int NWAVES = 8, NTHREADS = 512;
constexpr int DM = 2048, NB = 8, SEQ = 4096, MROWS = NB * SEQ, FF = 5632, PLE = 256;
constexpr int SSMW = 1024, NG = 64, GH = 16, NP = 64, SBW = 1024, NHEAD = 8, HD = 128, NIN = 4096;
constexpr size_t MiB = 1u << 20;
constexpr size_t WS_STAT = 0;
constexpr size_t WS_LAM8 = 1 * MiB;
constexpr size_t WS_SSMMAT = 2 * MiB;
constexpr size_t WS_WGU1 = 8 * MiB, WS_WD1 = 52 * MiB, WS_WIN = 74 * MiB, WS_WGLU = 90 * MiB, WS_WOUT = 92 * MiB, WS_WGU2 = 100 * MiB, WS_WD2 = 144 * MiB, WS_WPG = 166 * MiB, WS_WPP = 174 * MiB;
constexpr size_t WS_PB = 176 * MiB;
constexpr size_t WS_XB = 192 * MiB;
constexpr size_t WS_YMIX = 320 * MiB;
constexpr size_t WS_ACT = 448 * MiB;
constexpr size_t WS_UG = WS_ACT, WS_Q = WS_ACT + 64 * MiB, WS_K = WS_ACT + 128 * MiB, WS_V = WS_ACT + 192 * MiB, WS_Z = WS_ACT + 256 * MiB, WS_E = WS_ACT;
constexpr size_t WS_END = 800 * MiB;
enum { ST_SS1 = 0, ST_SS2, ST_SSM, ST_SB, ST_SS3, ST_SS4, ST_SSE, ST_N };
constexpr int RING_BYTES = 131072, XCH_OFF = RING_BYTES, LDS_BYTES = 147456;

#define GAS __attribute__((address_space(1)))
#define LAS __attribute__((address_space(3)))
typedef unsigned short bf16;
typedef unsigned v4u __attribute__((ext_vector_type(4)));
typedef unsigned v2u __attribute__((ext_vector_type(2)));
typedef float f32x4 __attribute__((ext_vector_type(4)));
typedef short bf16x8 __attribute__((ext_vector_type(8)));
#define LDS_WAIT() asm volatile("s_waitcnt lgkmcnt(0)" ::: "memory")
using pg8::cvt_pk_bf16;
__device__ __forceinline__ float wave_sum(float v) {
#pragma unroll
    for (int o = 1; o < 64; o <<= 1) v += __shfl_xor(v, o);
    return v;
}
__device__ __forceinline__ f32x4 mfma16(bf16x8 a, bf16x8 b, f32x4 c) { return __builtin_amdgcn_mfma_f32_16x16x32_bf16(a, b, c, 0, 0, 0); }

__device__ __forceinline__ void tr_item(const float* W, int K, int N, const float* gain, bf16* WT, int k0, int n0, int dstrow, LAS float* scr, int lane) {
#pragma unroll 8
    for (int i = 0; i < 32; ++i) { const int kk = 2 * i + (lane >> 5); float w = W[(size_t)(k0 + kk) * N + n0 + (lane & 31)]; if (gain) w *= gain[k0 + kk]; scr[kk * 33 + (lane & 31)] = w; }
    LDS_WAIT(); asm volatile("" ::: "memory");
    const int c = lane & 7;
#pragma unroll
    for (int j = 0; j < 4; ++j) { const int n = (lane >> 3) + 8 * j; const LAS float* s = scr + (8 * c) * 33 + n;
        v4u o; o.x = cvt_pk_bf16(s[0 * 33], s[1 * 33]); o.y = cvt_pk_bf16(s[2 * 33], s[3 * 33]); o.z = cvt_pk_bf16(s[4 * 33], s[5 * 33]); o.w = cvt_pk_bf16(s[6 * 33], s[7 * 33]);
        *(GAS v4u*)(WT + (size_t)(dstrow + n) * K + k0 + 8 * c) = o; }
    LDS_WAIT(); asm volatile("" ::: "memory");
}

struct In {
    const float *x, *p, *ffn1_norm, *ffn1_wg, *ffn1_wu, *ffn1_wd, *mix_norm, *w_in, *lam_re, *lam_im, *b_re, *b_im, *c_re, *c_im, *log_dt, *ssm_d, *w_glu, *b_glu, *q_norm, *k_norm,
        *on_ssm, *on_sb, *w_out, *ffn2_norm, *ffn2_wg, *ffn2_wu, *ffn2_wd, *ple_norm, *w_pg, *w_pp, *ple_post;
};

__device__ __forceinline__ void ssm_build(const In& in, unsigned char* ws, LAS unsigned char* lds, int g, int tid) {
    LAS float* PW = (LAS float*)lds;
    LAS float* CO = PW + 9 * 64 * 2;
    LAS float* CB = CO + 64 * 2;
    LAS float* KT = CB + 64 * 16 * 2;
    if (tid < 64) {
        const int p = tid; const float dt = expf(in.log_dt[g]); const float lr = fminf(in.lam_re[g * 64 + p], -1e-4f), li = in.lam_im[g * 64 + p];
        const float a = lr * dt, th = li * dt; float s1, c1; sincosf(th, &s1, &c1); const float ea = expf(a);
        const float l1r = ea * c1, l1i = ea * s1;
        float pr = 1.f, pi = 0.f;
#pragma unroll
        for (int t = 0; t <= 8; ++t) { PW[(t * 64 + p) * 2] = pr; PW[(t * 64 + p) * 2 + 1] = pi; const float nr = pr * l1r - pi * l1i, ni = pr * l1i + pi * l1r; pr = nr; pi = ni; }
        float* l8 = (float*)(ws + WS_LAM8) + (g * 64 + p) * 2; l8[0] = PW[(8 * 64 + p) * 2]; l8[1] = PW[(8 * 64 + p) * 2 + 1];
        const float sh = sinf(0.5f * th); const float nr = expm1f(a) * c1 - 2.f * sh * sh, ni = l1i;
        const float den = 1.f / (lr * lr + li * li);
        CO[p * 2] = (nr * lr + ni * li) * den; CO[p * 2 + 1] = (ni * lr - nr * li) * den;
    }
    __syncthreads();
    for (int i = tid; i < 1024; i += NTHREADS) { const int p = i >> 4; const float br = in.b_re[g * 1024 + i], bi = in.b_im[g * 1024 + i], cr = CO[p * 2], ci = CO[p * 2 + 1];
        CB[i * 2] = cr * br - ci * bi; CB[i * 2 + 1] = cr * bi + ci * br; }
    __syncthreads();
    for (int i = tid; i < 2048; i += NTHREADS) { const int tau = i >> 8, h = (i >> 4) & 15, h2 = i & 15; float s = 0.f;
        for (int p = 0; p < 64; ++p) { const float cr = in.c_re[g * 1024 + h * 64 + p], ci = in.c_im[g * 1024 + h * 64 + p], pr = PW[(tau * 64 + p) * 2], pi = PW[(tau * 64 + p) * 2 + 1];
            const float wr = cr * pr - ci * pi, wi = cr * pi + ci * pr; s += wr * CB[(p * 16 + h2) * 2] - wi * CB[(p * 16 + h2) * 2 + 1]; }
        KT[i] = s; }
    __syncthreads();
    bf16* Ms = (bf16*)(ws + WS_SSMMAT) + (size_t)g * 3 * 16384; bf16* Mi = Ms + 16384; bf16* Mo = Mi + 16384;
    for (int i = tid; i < 16384; i += NTHREADS) { const int r = i >> 7, c = i & 127;
        { const int p = r & 63, s = c >> 4, h2 = c & 15; const float pr = PW[((7 - s) * 64 + p) * 2], pi = PW[((7 - s) * 64 + p) * 2 + 1], br = CB[(p * 16 + h2) * 2], bi = CB[(p * 16 + h2) * 2 + 1];
          const float v = (r < 64) ? (pr * br - pi * bi) : (pr * bi + pi * br); Ms[i] = (bf16)(cvt_pk_bf16(v, 0.f) & 0xffffu); }
        { const int t = r >> 4, h = r & 15, s = c >> 4, h2 = c & 15; float v = 0.f; if (s <= t) { v = KT[((t - s) * 16 + h) * 16 + h2]; if (r == c) v += in.ssm_d[g * 16 + h]; } Mi[i] = (bf16)(cvt_pk_bf16(v, 0.f) & 0xffffu); }
        { const int t = r >> 4, h = r & 15, p = c & 63; const float cr = in.c_re[g * 1024 + h * 64 + p], ci = in.c_im[g * 1024 + h * 64 + p], pr = PW[((t + 1) * 64 + p) * 2], pi = PW[((t + 1) * 64 + p) * 2 + 1];
          const float v = (c < 64) ? (cr * pr - ci * pi) : -(cr * pi + ci * pr); Mo[i] = (bf16)(cvt_pk_bf16(v, 0.f) & 0xffffu); }
    }
    __syncthreads();
}

__device__ __forceinline__ void p0_prologue(const In& in, float* out, unsigned char* ws, LAS unsigned char* lds, int tid, int lane, int wave) {
    const int G = gridDim.x, bx = blockIdx.x;
    for (int g = bx; g < NG; g += G) ssm_build(in, ws, lds, g, tid);
    { float* st = (float*)(ws + WS_STAT) + MROWS; for (int i = bx * NTHREADS + tid; i < (ST_N - 1) * MROWS; i += G * NTHREADS) st[i] = 0.f; }
    LAS float* scr = (LAS float*)(lds + wave * 16384);
    const int gw = bx * NWAVES + wave, NGW = G * NWAVES;
    constexpr int I_GU = (DM / 64) * (FF / 32), I_D = (FF / 64) * (DM / 32), I_IN = (DM / 64) * (NIN / 32), I_GLU = (SSMW / 64) * (SSMW / 32), I_SQ = (DM / 64) * (DM / 32), I_PP = (PLE / 64) * (DM / 32);
    constexpr int NITEMS = 4 * I_GU + 2 * I_D + I_IN + I_GLU + 2 * I_SQ + I_PP;
#define TR_ITEM(NI, Wp, Kd, Nd, gainp, dstoff, MODE) \
        if (r < (NI)) { const int nbk = (Nd) / 32, kb = r / nbk, nb = r % nbk, k0 = 64 * kb, n0 = 32 * nb; \
            const int dr = (MODE) == 0 ? n0 : (n0 / 128) * 256 + (n0 % 128) + ((MODE) == 2 ? 128 : 0); \
            tr_item((Wp), (Kd), (Nd), (gainp), (bf16*)(ws + (dstoff)), k0, n0, dr, scr, lane); continue; } r -= (NI);
    for (int it = gw; it < NITEMS; it += NGW) {
        int r = it;
        TR_ITEM(I_GU, in.ffn1_wg, DM, FF, in.ffn1_norm, WS_WGU1, 1)
        TR_ITEM(I_GU, in.ffn1_wu, DM, FF, in.ffn1_norm, WS_WGU1, 2)
        TR_ITEM(I_D, in.ffn1_wd, FF, DM, (const float*)nullptr, WS_WD1, 0)
        TR_ITEM(I_IN, in.w_in, DM, NIN, in.mix_norm, WS_WIN, 0)
        TR_ITEM(I_GLU, in.w_glu, SSMW, SSMW, (const float*)nullptr, WS_WGLU, 0)
        TR_ITEM(I_SQ, in.w_out, DM, DM, (k0 < 1024 ? in.on_ssm : in.on_sb - 1024), WS_WOUT, 0)
        TR_ITEM(I_GU, in.ffn2_wg, DM, FF, in.ffn2_norm, WS_WGU2, 1)
        TR_ITEM(I_GU, in.ffn2_wu, DM, FF, in.ffn2_norm, WS_WGU2, 2)
        TR_ITEM(I_D, in.ffn2_wd, FF, DM, (const float*)nullptr, WS_WD2, 0)
        TR_ITEM(I_SQ, in.w_pg, DM, DM, in.ple_norm, WS_WPG, 0)
        TR_ITEM(I_PP, in.w_pp, PLE, DM, (const float*)nullptr, WS_WPP, 0)
    }
#undef TR_ITEM
    { bf16* XB = (bf16*)(ws + WS_XB); float* ss1 = (float*)(ws + WS_STAT) + ST_SS1 * MROWS;
      for (int m = gw; m < MROWS; m += NGW) { const GAS f32x4* xr = (const GAS f32x4*)(in.x + (size_t)m * DM) + lane; GAS v2u* o = (GAS v2u*)(XB + (size_t)m * DM) + lane; float s = 0.f;
#pragma unroll
          for (int j = 0; j < 8; ++j) { const f32x4 v = xr[64 * j]; s += (v.x * v.x + v.y * v.y) + (v.z * v.z + v.w * v.w); v2u w; w.x = cvt_pk_bf16(v.x, v.y); w.y = cvt_pk_bf16(v.z, v.w); o[64 * j] = w; }
          s = wave_sum(s); if (lane == 0) ss1[m] = s; } }
    { const GAS f32x4* ps = (const GAS f32x4*)in.p; GAS v2u* o = (GAS v2u*)(ws + WS_PB);
      for (int i = bx * NTHREADS + tid; i < MROWS * PLE / 4; i += G * NTHREADS) { const f32x4 v = ps[i]; v2u w; w.x = cvt_pk_bf16(v.x, v.y); w.y = cvt_pk_bf16(v.z, v.w); o[i] = w; } }
}

constexpr int SSM_DROW = 132, SSM_SROW = 136;
__device__ __forceinline__ void ssm_unit(unsigned char* ws, LAS unsigned char* lds, int b, int g, int lane, int wave) {
    const int r16 = lane & 15, q4 = lane >> 4;
    LAS float* DL = (LAS float*)lds; LAS bf16* S0 = (LAS bf16*)(lds + 64 * SSM_DROW * 4);
    const bf16* Ms = (const bf16*)(ws + WS_SSMMAT) + (size_t)g * 3 * 16384; const bf16* Mi = Ms + 16384; const bf16* Mo = Mi + 16384;
    bf16x8 aS[4], aI[4], aO[4];
#pragma unroll
    for (int ks = 0; ks < 4; ++ks) { const int o = (16 * wave + r16) * 128 + 32 * ks + 8 * q4; aS[ks] = *(const bf16x8*)(Ms + o); aI[ks] = *(const bf16x8*)(Mi + o); aO[ks] = *(const bf16x8*)(Mo + o); }
    const bf16* ug = (const bf16*)(ws + WS_UG) + (size_t)(b * 64 + g) * 4096 * 16;
    bf16* zb = (bf16*)(ws + WS_Z) + (size_t)b * 4096 * 1024 + g * 16;
    const float* l8 = (const float*)(ws + WS_LAM8) + (g * 64 + lane) * 2; const float l8r = l8[0], l8i = l8[1];
    float sre = 0.f, sim = 0.f;
    for (int seg = 0; seg < 8; ++seg) {
#pragma unroll
        for (int nt = 0; nt < 4; ++nt) { const int n = 64 * seg + 16 * nt + r16; f32x4 acc = {0.f, 0.f, 0.f, 0.f};
#pragma unroll
            for (int ks = 0; ks < 4; ++ks) { const bf16x8 bu = *(const bf16x8*)(ug + (size_t)(n * 8 + 2 * ks + (q4 >> 1)) * 16 + 8 * (q4 & 1)); acc = mfma16(aS[ks], bu, acc); }
            *(LAS f32x4*)(DL + (16 * nt + r16) * SSM_DROW + 16 * wave + 4 * q4) = acc; }
        __syncthreads();
        if (wave == 0) {
            for (int n = 0; n < 64; ++n) { S0[n * SSM_SROW + lane] = (bf16)(cvt_pk_bf16(sre, 0.f) & 0xffffu); S0[n * SSM_SROW + 64 + lane] = (bf16)(cvt_pk_bf16(sim, 0.f) & 0xffffu);
                const float dr = DL[n * SSM_DROW + lane], di = DL[n * SSM_DROW + 64 + lane];
                const float nr = l8r * sre - l8i * sim + dr, ni = l8r * sim + l8i * sre + di; sre = nr; sim = ni; }
        }
        __syncthreads();
#pragma unroll
        for (int nt = 0; nt < 4; ++nt) { const int n = 64 * seg + 16 * nt + r16; f32x4 acc = {0.f, 0.f, 0.f, 0.f};
#pragma unroll
            for (int ks = 0; ks < 4; ++ks) { const bf16x8 bu = *(const bf16x8*)(ug + (size_t)(n * 8 + 2 * ks + (q4 >> 1)) * 16 + 8 * (q4 & 1)); acc = mfma16(aI[ks], bu, acc); }
#pragma unroll
            for (int ks = 0; ks < 4; ++ks) { const bf16x8 bs = *(const LAS bf16x8*)(S0 + (16 * nt + r16) * SSM_SROW + 32 * ks + 8 * q4); acc = mfma16(aO[ks], bs, acc); }
            f32x4 z;
#pragma unroll
            for (int e = 0; e < 4; ++e) { const float y = acc[e]; const float t = 1.5957691216057308f * (y + 0.044715f * y * y * y); z[e] = y * __builtin_amdgcn_rcpf(1.0f + __builtin_amdgcn_exp2f(-1.4426950408889634f * t)); }
            v2u w; w.x = cvt_pk_bf16(z[0], z[1]); w.y = cvt_pk_bf16(z[2], z[3]);
            *(v2u*)(zb + (size_t)(n * 8 + wave) * 1024 + 4 * q4) = w; }
    }
    __syncthreads();
}

constexpr int AT_KROW = 136, AT_VROW = 72, AT_SROW = 68, AT_PROW = 72;
constexpr int AT_K_OFF = 0, AT_V_OFF = AT_K_OFF + 64 * AT_KROW * 2, AT_S_OFF = AT_V_OFF + 128 * AT_VROW * 2, AT_P_OFF = AT_S_OFF + 8 * 16 * AT_SROW * 4, AT_FLAG_OFF = AT_P_OFF + 8 * 16 * AT_PROW * 2;
static_assert(AT_FLAG_OFF + 64 <= RING_BYTES, "attention LDS");
constexpr float AT_THR = -152.0f;
__device__ __forceinline__ void attn_unit(unsigned char* ws, LAS unsigned char* lds, int b, int h, int qb, int tid, int lane, int wave) {
    const int r16 = lane & 15, q4 = lane >> 4;
    LAS bf16* Ks = (LAS bf16*)(lds + AT_K_OFF); LAS bf16* Vt = (LAS bf16*)(lds + AT_V_OFF);
    LAS float* Sw = (LAS float*)(lds + AT_S_OFF) + wave * 16 * AT_SROW; LAS bf16* Pw = (LAS bf16*)(lds + AT_P_OFF) + wave * 16 * AT_PROW;
    volatile LAS unsigned* flag = (volatile LAS unsigned*)(lds + AT_FLAG_OFF);
    const bf16* Qg = (const bf16*)(ws + WS_Q) + (size_t)b * SEQ * 1024 + h * 128;
    const bf16* Kg = (const bf16*)(ws + WS_K) + (size_t)b * SEQ * 1024 + h * 128;
    const bf16* Vg = (const bf16*)(ws + WS_V) + (size_t)b * SEQ * 1024 + h * 128;
    const int qw0 = 128 * qb + 16 * wave, qrow = qw0 + r16;
    bf16x8 qf[4];
#pragma unroll
    for (int ks = 0; ks < 4; ++ks) qf[ks] = *(const bf16x8*)(Qg + (size_t)qrow * 1024 + 32 * ks + 8 * q4);
    f32x4 o[8];
#pragma unroll
    for (int i = 0; i < 8; ++i) o[i] = (f32x4){0.f, 0.f, 0.f, 0.f};
    float carry = 0.f; bool done = false;
    const int pr0 = tid >> 4, pc = tid & 15;
    v4u kr[2], vr[2];
    int kt = 2 * qb + 1;
#define AT_LOAD(KT) do { _Pragma("unroll") for (int i = 0; i < 2; ++i) { const size_t go = (size_t)(64 * (KT) + pr0 + 32 * i) * 1024 + 8 * pc; kr[i] = *(const v4u*)(Kg + go); vr[i] = *(const v4u*)(Vg + go); } } while (0)
    AT_LOAD(kt);
    for (;;) {
        __syncthreads();
#pragma unroll
        for (int i = 0; i < 2; ++i) { const int row = pr0 + 32 * i; *(LAS v4u*)(Ks + row * AT_KROW + 8 * pc) = kr[i];
            const unsigned w0 = vr[i].x, w1 = vr[i].y, w2 = vr[i].z, w3 = vr[i].w; LAS bf16* vd = Vt + (8 * pc) * AT_VROW + row;
            vd[0 * AT_VROW] = (bf16)(w0 & 0xffffu); vd[1 * AT_VROW] = (bf16)(w0 >> 16); vd[2 * AT_VROW] = (bf16)(w1 & 0xffffu); vd[3 * AT_VROW] = (bf16)(w1 >> 16);
            vd[4 * AT_VROW] = (bf16)(w2 & 0xffffu); vd[5 * AT_VROW] = (bf16)(w2 >> 16); vd[6 * AT_VROW] = (bf16)(w3 & 0xffffu); vd[7 * AT_VROW] = (bf16)(w3 >> 16); }
        __syncthreads();
        if (kt > 0) AT_LOAD(kt - 1);
        const int j0 = 64 * kt;
        if (!done && j0 < qw0 + 15) {
#pragma unroll
            for (int t4 = 0; t4 < 4; ++t4) { f32x4 acc = {0.f, 0.f, 0.f, 0.f};
#pragma unroll
                for (int ks = 0; ks < 4; ++ks) { const bf16x8 ak = *(const LAS bf16x8*)(Ks + (16 * t4 + r16) * AT_KROW + 32 * ks + 8 * q4); acc = mfma16(ak, qf[ks], acc); }
                *(LAS f32x4*)(Sw + r16 * AT_SROW + 16 * t4 + 4 * q4) = acc; }
            LDS_WAIT(); __builtin_amdgcn_wave_barrier();
            float lk[16], ls[16];
#pragma unroll
            for (int c = 0; c < 4; ++c) { const f32x4 s = *(const LAS f32x4*)(Sw + r16 * AT_SROW + 16 * q4 + 4 * c);
#pragma unroll
                for (int e = 0; e < 4; ++e) { const float z2 = s[e]; const float az = __builtin_fabsf(z2); const float ex = __builtin_amdgcn_exp2f(-az); const float sp = fmaxf(z2, 0.f) + __builtin_amdgcn_logf(1.0f + ex);
                    const bool valid = (j0 + 16 * q4 + 4 * c + e) < qrow; lk[4 * c + e] = valid ? -sp : 0.f; ls[4 * c + e] = valid ? (z2 - sp) : -1.0e30f; } }
            float run = 0.f, ps[16];
#pragma unroll
            for (int i = 15; i >= 0; --i) { ps[i] = run; run += lk[i]; }
            const float t0 = __shfl(run, r16), t1 = __shfl(run, r16 + 16), t2 = __shfl(run, r16 + 32), t3 = __shfl(run, r16 + 48);
            const float offs = (q4 < 1 ? t1 : 0.f) + (q4 < 2 ? t2 : 0.f) + (q4 < 3 ? t3 : 0.f);
            const float base = carry + offs;
            float wv[16];
#pragma unroll
            for (int i = 0; i < 16; ++i) wv[i] = __builtin_amdgcn_exp2f(ls[i] + ps[i] + base);
            carry += (t0 + t1) + (t2 + t3);
            v4u p0, p1;
            p0.x = cvt_pk_bf16(wv[0], wv[1]); p0.y = cvt_pk_bf16(wv[2], wv[3]); p0.z = cvt_pk_bf16(wv[4], wv[5]); p0.w = cvt_pk_bf16(wv[6], wv[7]);
            p1.x = cvt_pk_bf16(wv[8], wv[9]); p1.y = cvt_pk_bf16(wv[10], wv[11]); p1.z = cvt_pk_bf16(wv[12], wv[13]); p1.w = cvt_pk_bf16(wv[14], wv[15]);
            *(LAS v4u*)(Pw + r16 * AT_PROW + 16 * q4) = p0; *(LAS v4u*)(Pw + r16 * AT_PROW + 16 * q4 + 8) = p1;
            LDS_WAIT(); __builtin_amdgcn_wave_barrier();
            bf16x8 bp[2];
#pragma unroll
            for (int ks = 0; ks < 2; ++ks) bp[ks] = *(const LAS bf16x8*)(Pw + r16 * AT_PROW + 32 * ks + 8 * q4);
#pragma unroll
            for (int dt = 0; dt < 8; ++dt)
#pragma unroll
                for (int ks = 0; ks < 2; ++ks) { const bf16x8 av = *(const LAS bf16x8*)(Vt + (16 * dt + r16) * AT_VROW + 32 * ks + 8 * q4); o[dt] = mfma16(av, bp[ks], o[dt]); }
            done = __all(carry < AT_THR);
        }
        if (lane == 0) flag[wave] = (!done && kt > 0) ? 1u : 0u;
        __syncthreads();
        unsigned any = 0;
#pragma unroll
        for (int i = 0; i < 8; ++i) any |= flag[i];
        if (!any) break;
        --kt;
    }
#undef AT_LOAD
    bf16* Y = (bf16*)(ws + WS_YMIX) + (size_t)(b * SEQ + qrow) * 2048 + 1024 + h * 128 + 4 * q4;
    float q = 0.f;
#pragma unroll
    for (int dt = 0; dt < 8; ++dt) { v2u w; w.x = cvt_pk_bf16(o[dt][0], o[dt][1]); w.y = cvt_pk_bf16(o[dt][2], o[dt][3]); *(v2u*)(Y + 16 * dt) = w; q += (o[dt][0] * o[dt][0] + o[dt][1] * o[dt][1]) + (o[dt][2] * o[dt][2] + o[dt][3] * o[dt][3]); }
    q += __shfl_xor(q, 16); q += __shfl_xor(q, 32);
    if (q4 == 0) atomicAdd((float*)(ws + WS_STAT) + ST_SB * MROWS + b * SEQ + qrow, q);
    __syncthreads();
}

struct Args { const float* in[31]; float* out; unsigned char* ws; };
#ifndef MK_PHASE_MASK
#define MK_PHASE_MASK 0xFFFFFFFFu
#endif
__global__ void __launch_bounds__(NTHREADS, 2) mk_fwd(Args args) {
    extern __shared__ __attribute__((aligned(16))) unsigned char lds_raw[];
    LAS unsigned char* lds = (LAS unsigned char*)lds_raw;
    cg::grid_group grid = cg::this_grid();
    const int wave_s = __builtin_amdgcn_readfirstlane(threadIdx.x >> 6);
#define FRESH_IDS unsigned ones_ = ~0u; asm volatile("" : "+s"(ones_)); const int lane = (int)__builtin_amdgcn_mbcnt_hi(ones_, __builtin_amdgcn_mbcnt_lo(ones_, 0u)), wave = wave_s, tid = wave * 64 + lane; (void)tid; (void)lane; (void)wave;
    const int G = gridDim.x, bx = blockIdx.x;
    unsigned char* ws = args.ws; float* out = args.out;
    In in;
    in.x = args.in[0]; in.p = args.in[1]; in.ffn1_norm = args.in[2]; in.ffn1_wg = args.in[3]; in.ffn1_wu = args.in[4]; in.ffn1_wd = args.in[5]; in.mix_norm = args.in[6]; in.w_in = args.in[7];
    in.lam_re = args.in[8]; in.lam_im = args.in[9]; in.b_re = args.in[10]; in.b_im = args.in[11]; in.c_re = args.in[12]; in.c_im = args.in[13]; in.log_dt = args.in[14]; in.ssm_d = args.in[15];
    in.w_glu = args.in[16]; in.b_glu = args.in[17]; in.q_norm = args.in[18]; in.k_norm = args.in[19]; in.on_ssm = args.in[20]; in.on_sb = args.in[21]; in.w_out = args.in[22];
    in.ffn2_norm = args.in[23]; in.ffn2_wg = args.in[24]; in.ffn2_wu = args.in[25]; in.ffn2_wd = args.in[26]; in.ple_norm = args.in[27]; in.w_pg = args.in[28]; in.w_pp = args.in[29]; in.ple_post = args.in[30];
    float* stat = (float*)(ws + WS_STAT);
    bf16* XB = (bf16*)(ws + WS_XB); bf16* ACT = (bf16*)(ws + WS_ACT); bf16* YMIX = (bf16*)(ws + WS_YMIX);
#define PH(k) ((MK_PHASE_MASK >> (k)) & 1u)

    if (PH(0)) { FRESH_IDS p0_prologue(in, out, ws, lds, tid, lane, wave); }
    grid.sync();
    if (PH(1)) { pg8::Gemm g{XB, (const bf16*)(ws + WS_WGU1), MROWS, 2 * FF, DM, DM}; pg8::StaticOrder S; S.init(MROWS, 2 * FF, G, bx);
        pg8::EpiSwiGLU E{ACT, stat + ST_SS1 * MROWS, FF}; pg8::gemm_phase<pg8::EpiSwiGLU, pg8::StaticOrder, true, true>(lds, g, S, E, wave_s); }
    grid.sync();
    if (PH(2)) { pg8::Gemm g{ACT, (const bf16*)(ws + WS_WD1), MROWS, DM, FF, FF}; pg8::StaticOrder S; S.init(MROWS, DM, G, bx);
        pg8::EpiResid<0> E{in.x, out, XB, stat + ST_SS2 * MROWS, nullptr, nullptr}; pg8::gemm_phase<pg8::EpiResid<0>, pg8::StaticOrder, true, true>(lds, g, S, E, wave_s); }
    grid.sync();
    if (PH(3)) { pg8::Gemm g{XB, (const bf16*)(ws + WS_WIN), MROWS, NIN, DM, DM}; pg8::StaticOrder S; S.init(MROWS, NIN, G, bx);
        pg8::EpiWin E{stat + ST_SS2 * MROWS, (bf16*)(ws + WS_UG), (bf16*)(ws + WS_Q), (bf16*)(ws + WS_K), (bf16*)(ws + WS_V), in.q_norm, in.k_norm, (LAS float*)(lds + XCH_OFF)};
        pg8::gemm_phase<pg8::EpiWin, pg8::StaticOrder, true, true>(lds, g, S, E, wave_s); }
    grid.sync();
    if (PH(4)) { FRESH_IDS
        for (int it = bx; it < 512 + 2048; it += G) {
            if (it < 512) ssm_unit(ws, lds, it >> 6, it & 63, lane, wave);
            else { const int a = it - 512; attn_unit(ws, lds, a >> 8, (a >> 5) & 7, a & 31, tid, lane, wave); }
        }
    }
    grid.sync();
    if (PH(5)) { pg8::Gemm g{(const bf16*)(ws + WS_Z), (const bf16*)(ws + WS_WGLU), MROWS, SSMW, SSMW, SSMW}; pg8::StaticOrder S; S.init(MROWS, SSMW, G, bx);
        pg8::EpiGlu E{(const bf16*)(ws + WS_Z), in.b_glu, YMIX, stat + ST_SSM * MROWS}; pg8::gemm_phase<pg8::EpiGlu, pg8::StaticOrder, true, true>(lds, g, S, E, wave_s); }
    grid.sync();
    if (PH(6)) { pg8::Gemm g{YMIX, (const bf16*)(ws + WS_WOUT), MROWS, DM, DM, DM / 2}; pg8::SplitOrder S; S.base.init(MROWS, DM, G, bx);
        pg8::EpiResid<1> E{out, out, XB, stat + ST_SS3 * MROWS, stat + ST_SSM * MROWS, stat + ST_SB * MROWS}; pg8::gemm_phase<pg8::EpiResid<1>, pg8::SplitOrder, true, true>(lds, g, S, E, wave_s); }
    grid.sync();
    if (PH(7)) { pg8::Gemm g{XB, (const bf16*)(ws + WS_WGU2), MROWS, 2 * FF, DM, DM}; pg8::StaticOrder S; S.init(MROWS, 2 * FF, G, bx);
        pg8::EpiSwiGLU E{ACT, stat + ST_SS3 * MROWS, FF}; pg8::gemm_phase<pg8::EpiSwiGLU, pg8::StaticOrder, true, true>(lds, g, S, E, wave_s); }
    grid.sync();
    if (PH(8)) { pg8::Gemm g{ACT, (const bf16*)(ws + WS_WD2), MROWS, DM, FF, FF}; pg8::StaticOrder S; S.init(MROWS, DM, G, bx);
        pg8::EpiResid<0> E{out, out, XB, stat + ST_SS4 * MROWS, nullptr, nullptr}; pg8::gemm_phase<pg8::EpiResid<0>, pg8::StaticOrder, true, true>(lds, g, S, E, wave_s); }
    grid.sync();
    if (PH(9)) { pg8::Gemm g{(const bf16*)(ws + WS_PB), (const bf16*)(ws + WS_WPP), MROWS, DM, PLE, PLE}; pg8::StaticOrder S; S.init(MROWS, DM, G, bx);
        pg8::EpiPlain E{YMIX, DM}; pg8::gemm_phase<pg8::EpiPlain, pg8::StaticOrder, true, true>(lds, g, S, E, wave_s); }
    asm volatile("s_waitcnt vmcnt(0)" ::: "memory"); __syncthreads();
    if (PH(10)) { pg8::Gemm g{XB, (const bf16*)(ws + WS_WPG), MROWS, DM, DM, DM}; pg8::StaticOrder S; S.init(MROWS, DM, G, bx);
        pg8::EpiPle E{YMIX, stat + ST_SS4 * MROWS, (bf16*)(ws + WS_E), stat + ST_SSE * MROWS}; pg8::gemm_phase<pg8::EpiPle, pg8::StaticOrder, true, true>(lds, g, S, E, wave_s); }
    grid.sync();
    if (PH(11)) { FRESH_IDS const bf16* E = (const bf16*)(ws + WS_E); const float* sse = stat + ST_SSE * MROWS; const int gw = bx * NWAVES + wave, NGW = G * NWAVES;
        for (int m = gw; m < MROWS; m += NGW) { const float r = pg8::rstd_of(sse[m], 1.0f / 2048.0f); GAS f32x4* xr = (GAS f32x4*)(out + (size_t)m * DM) + lane; const GAS v2u* er = (const GAS v2u*)(E + (size_t)m * DM) + lane;
            const GAS f32x4* gp = (const GAS f32x4*)in.ple_post + lane;
#pragma unroll
            for (int j = 0; j < 8; ++j) { f32x4 v = xr[64 * j]; const v2u w = er[64 * j]; const f32x4 gg = gp[64 * j];
                v.x += pg8::bf_lo(w.x) * r * gg.x; v.y += pg8::bf_hi(w.x) * r * gg.y; v.z += pg8::bf_lo(w.y) * r * gg.z; v.w += pg8::bf_hi(w.y) * r * gg.w; xr[64 * j] = v; } } }
#undef PH
}

extern "C" void kernel_launch(void* const* d_in, const int* in_sizes, int n_in, void* d_out, int out_size, void* d_ws, size_t ws_size, hipStream_t stream) {
    static int grid = 0;
    if (grid == 0) {
        if (n_in != 31 || out_size != MROWS * DM || ws_size < WS_END) { fprintf(stderr, "kernel_launch: unexpected shapes (n_in %d, out %d, ws %zu)\n", n_in, out_size, ws_size); grid = -1; return; }
        int dev = 0, cus = 0, per_cu = 0;
        hipGetDevice(&dev); hipDeviceGetAttribute(&cus, hipDeviceAttributeMultiprocessorCount, dev);
        if (hipFuncSetAttribute((const void*)mk_fwd, hipFuncAttributeMaxDynamicSharedMemorySize, LDS_BYTES) != hipSuccess) { fprintf(stderr, "kernel_launch: hipFuncSetAttribute failed\n"); grid = -1; return; }
        if (hipOccupancyMaxActiveBlocksPerMultiprocessor(&per_cu, (const void*)mk_fwd, NTHREADS, LDS_BYTES) != hipSuccess || per_cu < 1) { fprintf(stderr, "kernel_launch: occupancy query gives %d\n", per_cu); per_cu = 1; }
        (void)hipGetLastError();
        grid = cus * 1;
    }
    if (grid < 0) return;
    Args a{};
    for (int i = 0; i < 31; ++i) a.in[i] = (const float*)d_in[i];
    a.out = (float*)d_out; a.ws = (unsigned char*)d_ws;
    void* kargs[] = {&a};
    hipError_t e = hipLaunchCooperativeKernel((const void*)mk_fwd, dim3(grid), dim3(NTHREADS), kargs, LDS_BYTES, stream);
    if (e != hipSuccess) fprintf(stderr, "kernel_launch: cooperative launch failed: %s (grid %d)\n", hipGetErrorString(e), grid);
}
```

```cpp
#include <hip/hip_runtime.h>
#include <hip/hip_cooperative_groups.h>
#include <cstdio>
#include <cstdint>
namespace cg = cooperative_groups;
namespace pg8 {
#define PG8_LAS __attribute__((address_space(3)))
typedef unsigned short bf16_t;
typedef short bf16x8 __attribute__((ext_vector_type(8)));
typedef float f32x4 __attribute__((ext_vector_type(4)));
typedef unsigned u32x4 __attribute__((ext_vector_type(4)));
constexpr int BM = 256, BK = 64, HALF = 128, HTB = HALF * BK * 2  , STAGE_BYTES = 8 * HTB, NXCD = 8, WGM = 8;

__host__ __device__ __forceinline__ int lds_byte(int r, int c) { const int st = (r >> 4) * 2 + (c >> 5), rr = r & 15, cc = c & 31, ob = rr * 64 + cc * 2; return st * 1024 + (ob ^ (((ob >> 9) & 1) << 5)); }
__host__ __device__ __forceinline__ void stage_rc(int b, int& R, int& C) { const int st = b / 1024, sb = b % 1024, swz = sb ^ (((sb >> 9) & 1) << 5); R = (st >> 1) * 16 + swz / 64; C = (st & 1) * 32 + (swz % 64) / 2; }
__host__ __device__ __forceinline__ int perm32(int rho) { const int n = rho >> 4, i = rho & 15; return 8 * (i >> 2) + 4 * n + (i & 3); }

struct Unit { int pm, pn, kh; };
struct Gemm { const bf16_t* A; const bf16_t* Bt; int M, N, K, KU; };

struct StaticOrder {
    int nM, nN, nwg, G, c;
    __host__ __device__ void init(int M, int N, int G_, int c_) { nM = M / BM; nN = N / BM; nwg = nM * nN; G = G_; c = c_; }
    __host__ __device__ bool next(int i, Unit& u) const {
        const long L = (long)i * G + c; if (L >= nwg) return false;
        int wgid = (int)L; { const int q = nwg / NXCD, r = nwg % NXCD, xcd = wgid % NXCD, off = wgid / NXCD; wgid = (xcd < r ? xcd * (q + 1) : r * (q + 1) + (xcd - r) * q) + off; }
        const int nig = WGM * nN, gid = wgid / nig, fm = gid * WGM, gsz = (nM - fm) < WGM ? (nM - fm) : WGM;
        u.pm = fm + ((wgid % nig) % gsz); u.pn = (wgid % nig) / gsz; u.kh = 0; return true;
    }
    __device__ __forceinline__ void a_ready(const Unit&) const {}
    __device__ __forceinline__ void done(const Unit&) const {}
};

__device__ __forceinline__ unsigned cvt_pk_bf16(float lo, float hi) { unsigned r; asm volatile("v_cvt_pk_bf16_f32 %0, %1, %2" : "=v"(r) : "v"(lo), "v"(hi)); return r; }
struct SplitOrder {
    StaticOrder base;
    __device__ bool next(int i, Unit& u) const { const bool r = base.next(i >> 1, u); u.kh = i & 1; return r; }
    __device__ __forceinline__ void a_ready(const Unit&) const {}
    __device__ __forceinline__ void done(const Unit&) const {}
};
typedef float f32x2 __attribute__((ext_vector_type(2)));
__device__ __forceinline__ float rstd_of(float ss, float inv_n) { return __builtin_amdgcn_rsqf(ss * inv_n + 1e-6f); }
__device__ __forceinline__ float sigmoid_f(float v) { return __builtin_amdgcn_rcpf(1.0f + __builtin_amdgcn_exp2f(-1.4426950408889634f * v)); }
__device__ __forceinline__ float bf_lo(unsigned w) { return __uint_as_float(w << 16); }
__device__ __forceinline__ float bf_hi(unsigned w) { return __uint_as_float(w & 0xffff0000u); }
__device__ __forceinline__ u32x4 pack8(const f32x4 a, const f32x4 b) { u32x4 w; w.x = cvt_pk_bf16(a[0], a[1]); w.y = cvt_pk_bf16(a[2], a[3]); w.z = cvt_pk_bf16(b[0], b[1]); w.w = cvt_pk_bf16(b[2], b[3]); return w; }
__device__ __forceinline__ float sumsq4(const f32x4 a) { return (a[0] * a[0] + a[1] * a[1]) + (a[2] * a[2] + a[3] * a[3]); }

struct EpiSwiGLU {
    static constexpr bool PERM = true, AFTER_DRAIN = false, MID = false;
    bf16_t* O; const float* ss; int ldo;
    __device__ __forceinline__ void operator()(f32x4 (&acc)[2][2][4][2], const Unit& u, int wr, int wc, int fr, int fq) const {
        const int row0 = u.pm * BM + wr * 64 + fr, col0 = u.pn * HALF + wc * 32 + 8 * fq;
#pragma unroll
        for (int ai = 0; ai < 2; ++ai)
#pragma unroll
            for (int m = 0; m < 4; ++m) {
                const int row = row0 + ai * HALF + m * 16; const float r = rstd_of(ss[row], 1.0f / 2048.0f);
                f32x4 o[2];
#pragma unroll
                for (int n = 0; n < 2; ++n) { const f32x4 g = acc[ai][0][m][n] * r, uu = acc[ai][1][m][n] * r;
#pragma unroll
                    for (int e = 0; e < 4; ++e) o[n][e] = g[e] * uu[e] * sigmoid_f(g[e]); }
                *(u32x4*)(O + (size_t)row * ldo + col0) = pack8(o[0], o[1]);
            }
    }
    __device__ __forceinline__ void mid(f32x4 (&)[2][2][4][2], const Unit&, int, int) const {}
};

template <int MODE, bool XF32> struct EpiResid {
    static constexpr bool PERM = true, AFTER_DRAIN = false, MID = (MODE == 1);
    const float* xin; bf16_t* xb; float* ssout; const float* ssa; const float* ssb;
    __device__ __forceinline__ void mid(f32x4 (&acc)[2][2][4][2], const Unit& u, int wr, int fr) const {
        {
            const int row0 = u.pm * BM + wr * 64 + fr;
#pragma unroll
            for (int ai = 0; ai < 2; ++ai)
#pragma unroll
                for (int m = 0; m < 4; ++m) { const int row = row0 + ai * HALF + m * 16;
                    const float ra = rstd_of(ssa[row], 1.0f / 1024.0f), rb = rstd_of(ssb[row], 1.0f / 1024.0f), ratio = ra * __builtin_amdgcn_rcpf(rb);
#pragma unroll
                    for (int bj = 0; bj < 2; ++bj)
#pragma unroll
                        for (int n = 0; n < 2; ++n) acc[ai][bj][m][n] = acc[ai][bj][m][n] * ratio;
                    asm volatile("" ::: "memory"); }
        }
    }
    __device__ __forceinline__ void operator()(f32x4 (&acc)[2][2][4][2], const Unit& u, int wr, int wc, int fr, int fq) const {
        if (MODE == 1 && u.kh == 0) { mid(acc, u, wr, fr); return; }
        const int row0 = u.pm * BM + wr * 64 + fr, col0 = u.pn * BM + wc * 32 + 8 * fq;
#pragma unroll
        for (int ai = 0; ai < 2; ++ai)
#pragma unroll
            for (int m = 0; m < 4; ++m) {
                const int row = row0 + ai * HALF + m * 16; const size_t off = (size_t)row * 2048 + col0;
                float sc = 0.5f; if constexpr (MODE == 1) sc = rstd_of(ssb[row], 1.0f / 1024.0f);
                float q = 0.f;
#pragma unroll
                for (int bj = 0; bj < 2; ++bj) {
                    f32x4 x0, x1;
                    if constexpr (XF32) { x0 = *(const f32x4*)(xin + off + bj * HALF); x1 = *(const f32x4*)(xin + off + bj * HALF + 4); }
                    else { const u32x4 xw = *(const u32x4*)(xb + off + bj * HALF); x0 = (f32x4){bf_lo(xw.x), bf_hi(xw.x), bf_lo(xw.y), bf_hi(xw.y)}; x1 = (f32x4){bf_lo(xw.z), bf_hi(xw.z), bf_lo(xw.w), bf_hi(xw.w)}; }
                    const f32x4 v0 = x0 + acc[ai][bj][m][0] * sc, v1 = x1 + acc[ai][bj][m][1] * sc;
                    *(u32x4*)(xb + off + bj * HALF) = pack8(v0, v1);
                    q += sumsq4(v0) + sumsq4(v1);
                }
                q += __shfl_xor(q, 16); q += __shfl_xor(q, 32);
                if (fq == 0 && ssout) atomicAdd(ssout + row, q);
                asm volatile("" ::: "memory");
            }
    }
};

struct EpiWin {
    static constexpr bool PERM = true, AFTER_DRAIN = false, MID = false;
    const float* ss; bf16_t *UG, *Q, *K, *V; const float *gq, *gk; PG8_LAS float* xch;
    __device__ __forceinline__ void mid(f32x4 (&)[2][2][4][2], const Unit&, int, int) const {}
    __device__ __forceinline__ void operator()(f32x4 (&acc)[2][2][4][2], const Unit& u, int wr, int wc, int fr, int fq) const {
        const int row0 = u.pm * BM + wr * 64 + fr, seg = u.pn >> 2, lc0 = (u.pn & 3) * BM + wc * 32 + 8 * fq; const float* ssr = ss + row0;
        if (seg == 0) {
#pragma unroll
            for (int ai = 0; ai < 2; ++ai)
#pragma unroll
                for (int m = 0; m < 4; ++m) { const float r = rstd_of(ssr[ai * HALF + m * 16], 1.0f / 2048.0f); const int row = row0 + ai * HALF + m * 16, b = row >> 12, t = row & 4095;
#pragma unroll
                    for (int bj = 0; bj < 2; ++bj) { const int col = lc0 + bj * HALF, g = col >> 4, half = (col >> 3) & 1;
                        *(u32x4*)(UG + ((size_t)((b * 64 + g) * 4096 + t) * 16 + 8 * half)) = pack8(acc[ai][bj][m][0] * r, acc[ai][bj][m][1] * r); } }
        } else if (seg == 3) {
#pragma unroll
            for (int ai = 0; ai < 2; ++ai)
#pragma unroll
                for (int m = 0; m < 4; ++m) { const float r = rstd_of(ssr[ai * HALF + m * 16], 1.0f / 2048.0f); const int row = row0 + ai * HALF + m * 16;
#pragma unroll
                    for (int bj = 0; bj < 2; ++bj) *(u32x4*)(V + (size_t)row * 1024 + lc0 + bj * HALF) = pack8(acc[ai][bj][m][0] * r, acc[ai][bj][m][1] * r); }
        } else {
#pragma unroll
            for (int ai = 0; ai < 2; ++ai)
#pragma unroll
                for (int m = 0; m < 4; ++m) { const int rl = ai * HALF + wr * 64 + m * 16 + fr;
#pragma unroll
                    for (int bj = 0; bj < 2; ++bj) { float q = sumsq4(acc[ai][bj][m][0]) + sumsq4(acc[ai][bj][m][1]); q += __shfl_xor(q, 16); q += __shfl_xor(q, 32);
                        if (fq == 0) xch[rl * 8 + bj * 4 + wc] = q; } }
            asm volatile("s_waitcnt lgkmcnt(0)" ::: "memory"); __builtin_amdgcn_s_barrier(); asm volatile("" ::: "memory");
            const float* gain = (seg == 1) ? gq : gk; bf16_t* dst = (seg == 1) ? Q : K;
            const float osc = (seg == 1) ? (0.08838834764831845f * 1.4426950408889634f) : 1.0f;
            const int d0 = wc * 32 + 8 * fq;
            const f32x4 g0 = *(const f32x4*)(gain + d0) * osc, g1 = *(const f32x4*)(gain + d0 + 4) * osc;
#pragma unroll
            for (int ai = 0; ai < 2; ++ai)
#pragma unroll
                for (int m = 0; m < 4; ++m) { const int rl = ai * HALF + wr * 64 + m * 16 + fr, row = u.pm * BM + rl;
                    const float epr = 1e-6f * (ssr[ai * HALF + m * 16] * (1.0f / 2048.0f) + 1e-6f);
#pragma unroll
                    for (int bj = 0; bj < 2; ++bj) { const f32x4 p = *(const PG8_LAS f32x4*)(xch + rl * 8 + bj * 4);
                        const float rq = __builtin_amdgcn_rsqf(((p[0] + p[1]) + (p[2] + p[3])) * (1.0f / 128.0f) + epr);
                        *(u32x4*)(dst + (size_t)row * 1024 + lc0 + bj * HALF) = pack8(acc[ai][bj][m][0] * g0 * rq, acc[ai][bj][m][1] * g1 * rq); } }
        }
    }
};

struct EpiGlu {
    static constexpr bool PERM = true, AFTER_DRAIN = false, MID = false;
    const bf16_t* Z; const float* bias; bf16_t* Y; float* ssout;
    __device__ __forceinline__ void mid(f32x4 (&)[2][2][4][2], const Unit&, int, int) const {}
    __device__ __forceinline__ void operator()(f32x4 (&acc)[2][2][4][2], const Unit& u, int wr, int wc, int fr, int fq) const {
        const int row0 = u.pm * BM + wr * 64 + fr, col0 = u.pn * BM + wc * 32 + 8 * fq;
        f32x4 bv[2][2];
#pragma unroll
        for (int bj = 0; bj < 2; ++bj)
#pragma unroll
            for (int n = 0; n < 2; ++n) bv[bj][n] = *(const f32x4*)(bias + col0 + bj * HALF + 4 * n);
#pragma unroll
        for (int ai = 0; ai < 2; ++ai)
#pragma unroll
            for (int m = 0; m < 4; ++m) { const int row = row0 + ai * HALF + m * 16; float q = 0.f;
#pragma unroll
                for (int bj = 0; bj < 2; ++bj) { const u32x4 zb = *(const u32x4*)(Z + (size_t)row * 1024 + col0 + bj * HALF);
                    const f32x4 z0 = {bf_lo(zb.x), bf_hi(zb.x), bf_lo(zb.y), bf_hi(zb.y)}, z1 = {bf_lo(zb.z), bf_hi(zb.z), bf_lo(zb.w), bf_hi(zb.w)};
                    const f32x4 a0 = acc[ai][bj][m][0] + bv[bj][0], a1 = acc[ai][bj][m][1] + bv[bj][1]; f32x4 y0, y1;
#pragma unroll
                    for (int e = 0; e < 4; ++e) { y0[e] = z0[e] * sigmoid_f(a0[e]); y1[e] = z1[e] * sigmoid_f(a1[e]); }
                    *(u32x4*)(Y + (size_t)row * 2048 + col0 + bj * HALF) = pack8(y0, y1); q += sumsq4(y0) + sumsq4(y1); }
                q += __shfl_xor(q, 16); q += __shfl_xor(q, 32);
                if (fq == 0) atomicAdd(ssout + row, q);
                asm volatile("" ::: "memory"); }
    }
};

struct EpiPle {
    static constexpr bool PERM = true, AFTER_DRAIN = false, MID = false;
    const bf16_t* PP; const float* ss; bf16_t* E; float* ssout;
    __device__ __forceinline__ void mid(f32x4 (&)[2][2][4][2], const Unit&, int, int) const {}
    __device__ __forceinline__ void operator()(f32x4 (&acc)[2][2][4][2], const Unit& u, int wr, int wc, int fr, int fq) const {
        const int row0 = u.pm * BM + wr * 64 + fr, col0 = u.pn * BM + wc * 32 + 8 * fq;
#pragma unroll
        for (int ai = 0; ai < 2; ++ai)
#pragma unroll
            for (int m = 0; m < 4; ++m) { const int row = row0 + ai * HALF + m * 16; const float r = rstd_of(ss[row], 1.0f / 2048.0f); float q = 0.f;
#pragma unroll
                for (int bj = 0; bj < 2; ++bj) { const u32x4 pb = *(const u32x4*)(PP + (size_t)row * 2048 + col0 + bj * HALF);
                    const f32x4 p0 = {bf_lo(pb.x), bf_hi(pb.x), bf_lo(pb.y), bf_hi(pb.y)}, p1 = {bf_lo(pb.z), bf_hi(pb.z), bf_lo(pb.w), bf_hi(pb.w)};
                    const f32x4 a0 = acc[ai][bj][m][0] * r, a1 = acc[ai][bj][m][1] * r; f32x4 y0, y1;
#pragma unroll
                    for (int e = 0; e < 4; ++e) { y0[e] = p0[e] * sigmoid_f(a0[e]); y1[e] = p1[e] * sigmoid_f(a1[e]); }
                    *(u32x4*)(E + (size_t)row * 2048 + col0 + bj * HALF) = pack8(y0, y1); q += sumsq4(y0) + sumsq4(y1); }
                q += __shfl_xor(q, 16); q += __shfl_xor(q, 32);
                if (fq == 0) atomicAdd(ssout + row, q);
                asm volatile("" ::: "memory"); }
    }
};

struct EpiPlain {
    static constexpr bool PERM = true, AFTER_DRAIN = false, MID = false;
    bf16_t* O; int ldo;
    __device__ __forceinline__ void mid(f32x4 (&)[2][2][4][2], const Unit&, int, int) const {}
    __device__ __forceinline__ void operator()(f32x4 (&acc)[2][2][4][2], const Unit& u, int wr, int wc, int fr, int fq) const {
        const int row0 = u.pm * BM + wr * 64 + fr, col0 = u.pn * BM + wc * 32 + 8 * fq;
#pragma unroll
        for (int ai = 0; ai < 2; ++ai)
#pragma unroll
            for (int m = 0; m < 4; ++m) { const int row = row0 + ai * HALF + m * 16;
#pragma unroll
                for (int bj = 0; bj < 2; ++bj) *(u32x4*)(O + (size_t)row * ldo + col0 + bj * HALF) = pack8(acc[ai][bj][m][0], acc[ai][bj][m][1]); }
    }
};
template <class Epi, class Sched, bool ALIGN_EPI = false, bool SP2 = false>
__device__ __forceinline__ void gemm_phase(PG8_LAS unsigned char* lds, const Gemm g, const Sched& S, const Epi& E, const int wave_s) {
    unsigned ones_ = ~0u; asm volatile("" : "+s"(ones_));
    const int lane = (int)__builtin_amdgcn_mbcnt_hi(ones_, __builtin_amdgcn_mbcnt_lo(ones_, 0u)), wid = wave_s, tid = wid * 64 + lane, wr = wid >> 2, wc = wid & 3, fr = lane & 15, fq = lane >> 4;
    const int K = g.K, nt = g.KU / BK;
    unsigned voffA[2], voffB[2];
#pragma unroll
    for (int i = 0; i < 2; ++i) { int R, C; stage_rc(tid * 16 + i * 8192, R, C); const int Rb = Epi::PERM ? ((R & ~31) + perm32(R & 31)) : R;
        voffA[i] = (unsigned)(R * K + C) * 2u; voffB[i] = (unsigned)(Rb * K + C) * 2u; }
    const size_t kstep = (size_t)(BK * 2);
    const size_t hstep = (size_t)HALF * K * 2;
    const size_t tstep = 2 * hstep;
    const unsigned ldsw = (unsigned)wid * 1024u;
    const int aoff = lds_byte(wr * 64 + fr, fq * 8), boff = lds_byte(wc * 32 + fr, fq * 8);
#define PG8_SA(b, h) (((b) * 2 + (h)) * HTB)
#define PG8_SB(b, h) ((4 + (b) * 2 + (h)) * HTB)
#define PG8_STAGE(bufoff, gbase, voff) do { _Pragma("unroll") for (int _i = 0; _i < 2; ++_i) \
        __builtin_amdgcn_global_load_lds((const unsigned*)((const char*)(gbase) + (voff)[_i]), (PG8_LAS unsigned*)(lds + (bufoff) + ldsw + _i * 8192), 16, 0, 0); } while (0)
#define PG8_LDA(dst, b, h) do { _Pragma("unroll") for (int m = 0; m < 4; ++m) _Pragma("unroll") for (int k = 0; k < 2; ++k) dst[m][k] = *(const PG8_LAS bf16x8*)(lds + PG8_SA(b, h) + aoff + m * 2048 + k * 1024); } while (0)
#define PG8_LDB(dst, b, h) do { _Pragma("unroll") for (int n = 0; n < 2; ++n) _Pragma("unroll") for (int k = 0; k < 2; ++k) dst[n][k] = *(const PG8_LAS bf16x8*)(lds + PG8_SB(b, h) + boff + n * 2048 + k * 1024); } while (0)
#define PG8_MMA(ai, bj, At, Bt) do { __builtin_amdgcn_s_setprio(1); _Pragma("unroll") for (int m = 0; m < 4; ++m) _Pragma("unroll") for (int n = 0; n < 2; ++n) _Pragma("unroll") for (int k = 0; k < 2; ++k) \
        acc[ai][bj][m][n] = __builtin_amdgcn_mfma_f32_16x16x32_bf16(Bt[n][k], At[m][k], acc[ai][bj][m][n], 0, 0, 0); __builtin_amdgcn_s_setprio(0); } while (0)
#define PG8_WAIT_V(n) asm volatile("s_waitcnt vmcnt(" #n ")" ::: "memory")
#define PG8_WAIT_L(n) asm volatile("s_waitcnt lgkmcnt(" #n ")" ::: "memory")
#define PG8_BAR __builtin_amdgcn_s_barrier()
#define PG8_SCHED __builtin_amdgcn_sched_barrier(0)
    Unit cur, nxt; int ui = 0;
    if (!S.next(0, cur)) return;
    f32x4 acc[2][2][4][2];
#pragma unroll
    for (int a = 0; a < 2; ++a)
#pragma unroll
        for (int b = 0; b < 2; ++b)
#pragma unroll
            for (int m = 0; m < 4; ++m)
#pragma unroll
                for (int n = 0; n < 2; ++n) acc[a][b][m][n] = (f32x4){0.f, 0.f, 0.f, 0.f};
    bf16x8 At[4][2], B0[2][2], B1[2][2];
    const size_t khb = (size_t)g.KU * 2; const char* cA = (const char*)g.A + (size_t)cur.pm * tstep + cur.kh * khb; const char* cB = (const char*)g.Bt + (size_t)cur.pn * tstep + cur.kh * khb;
    S.a_ready(cur);
    if constexpr (SP2) {
        PG8_STAGE(PG8_SB(0, 0), cB, voffB); PG8_STAGE(PG8_SB(0, 1), cB + hstep, voffB); PG8_STAGE(PG8_SA(0, 0), cA, voffA); PG8_STAGE(PG8_SA(0, 1), cA + hstep, voffA);
        if (wr == 1) PG8_BAR;
        PG8_WAIT_V(2); PG8_BAR;
        PG8_STAGE(PG8_SB(1, 0), cB + kstep, voffB); PG8_STAGE(PG8_SA(1, 0), cA + kstep, voffA); PG8_STAGE(PG8_SB(1, 1), cB + hstep + kstep, voffB);
        PG8_WAIT_V(6); PG8_BAR;
    } else {
        PG8_STAGE(PG8_SB(0, 0), cB, voffB); PG8_STAGE(PG8_SA(0, 0), cA, voffA); PG8_STAGE(PG8_SB(0, 1), cB + hstep, voffB); PG8_STAGE(PG8_SA(0, 1), cA + hstep, voffA);
        if (wr == 1) PG8_BAR;
        PG8_WAIT_V(4); PG8_BAR;
        PG8_STAGE(PG8_SB(1, 0), cB + kstep, voffB); PG8_STAGE(PG8_SA(1, 0), cA + kstep, voffA); PG8_STAGE(PG8_SB(1, 1), cB + hstep + kstep, voffB);
        PG8_WAIT_V(6); PG8_BAR;
    }
    for (;;) {
        const bool has_next = S.next(ui + 1, nxt);
        const char* nA = has_next ? (const char*)g.A + (size_t)nxt.pm * tstep + nxt.kh * khb : cA; const char* nB = has_next ? (const char*)g.Bt + (size_t)nxt.pn * tstep + nxt.kh * khb : cB;
        for (int t = 0; t < nt; t += 2) {
            const bool last = (t == nt - 2);
            const char* a1 = cA + (size_t)(t + 1) * kstep;
            const char* a2 = last ? nA : cA + (size_t)(t + 2) * kstep; const char* b2 = last ? nB : cB + (size_t)(t + 2) * kstep;
            const char* a3 = a2 + kstep; const char* b3 = b2 + kstep;
            if (last && has_next) S.a_ready(nxt);
            if constexpr (SP2) {
            PG8_LDB(B0, 0, 0); PG8_LDB(B1, 0, 1); PG8_SCHED; PG8_LDA(At, 0, 0); PG8_STAGE(PG8_SA(1, 1), a1 + hstep, voffA);
            PG8_WAIT_V(8); PG8_WAIT_L(0); PG8_BAR; PG8_MMA(0, 0, At, B0); PG8_MMA(0, 1, At, B1); PG8_BAR; PG8_SCHED;
            PG8_LDA(At, 0, 1); PG8_STAGE(PG8_SB(0, 0), b2, voffB); PG8_STAGE(PG8_SB(0, 1), b2 + hstep, voffB); PG8_STAGE(PG8_SA(0, 0), a2, voffA);
            PG8_WAIT_V(8); PG8_WAIT_L(0); PG8_BAR; PG8_MMA(1, 0, At, B0); PG8_MMA(1, 1, At, B1); PG8_BAR; PG8_SCHED;
            PG8_LDB(B0, 1, 0); PG8_LDB(B1, 1, 1); PG8_SCHED; PG8_LDA(At, 1, 0); PG8_STAGE(PG8_SA(0, 1), a2 + hstep, voffA);
            PG8_WAIT_V(8); PG8_WAIT_L(0); PG8_BAR; PG8_MMA(0, 0, At, B0); PG8_MMA(0, 1, At, B1); PG8_BAR; PG8_SCHED;
            PG8_LDA(At, 1, 1); PG8_STAGE(PG8_SB(1, 0), b3, voffB); PG8_STAGE(PG8_SB(1, 1), b3 + hstep, voffB); PG8_STAGE(PG8_SA(1, 0), a3, voffA);
            PG8_WAIT_V(8); PG8_WAIT_L(0); PG8_BAR; PG8_MMA(1, 0, At, B0); PG8_MMA(1, 1, At, B1); PG8_BAR; PG8_SCHED;
            } else {
            PG8_LDB(B0, 0, 0); PG8_SCHED; PG8_LDA(At, 0, 0); PG8_STAGE(PG8_SA(1, 1), a1 + hstep, voffA);
            PG8_WAIT_L(8); PG8_BAR; PG8_WAIT_L(0); PG8_MMA(0, 0, At, B0); PG8_BAR; PG8_SCHED;
            PG8_LDB(B1, 0, 1); PG8_STAGE(PG8_SB(0, 0), b2, voffB);
            PG8_BAR; PG8_WAIT_L(0); PG8_MMA(0, 1, At, B1); PG8_BAR;
            PG8_LDA(At, 0, 1); PG8_STAGE(PG8_SA(0, 0), a2, voffA);
            PG8_BAR; PG8_WAIT_L(0); PG8_MMA(1, 0, At, B0); PG8_BAR; PG8_SCHED;
            PG8_STAGE(PG8_SB(0, 1), b2 + hstep, voffB);
            PG8_WAIT_V(6); PG8_BAR; PG8_MMA(1, 1, At, B1); PG8_BAR;
            PG8_LDB(B0, 1, 0); PG8_SCHED; PG8_LDA(At, 1, 0); PG8_STAGE(PG8_SA(0, 1), a2 + hstep, voffA);
            PG8_WAIT_L(8); PG8_BAR; PG8_WAIT_L(0); PG8_MMA(0, 0, At, B0); PG8_BAR; PG8_SCHED;
            PG8_LDB(B1, 1, 1); PG8_STAGE(PG8_SB(1, 0), b3, voffB);
            PG8_BAR; PG8_WAIT_L(0); PG8_MMA(0, 1, At, B1); PG8_BAR;
            PG8_LDA(At, 1, 1); PG8_STAGE(PG8_SA(1, 0), a3, voffA);
            PG8_BAR; PG8_WAIT_L(0); PG8_MMA(1, 0, At, B0); PG8_BAR; PG8_SCHED;
            PG8_STAGE(PG8_SB(1, 1), b3 + hstep, voffB);
            PG8_WAIT_V(6); PG8_BAR; PG8_MMA(1, 1, At, B1); PG8_BAR;
            }
        }
        if constexpr (ALIGN_EPI) { if (wr == 0) PG8_BAR; }
        if constexpr (!Epi::AFTER_DRAIN) { E(acc, cur, wr, wc, fr, fq); S.done(cur); }
        if (!has_next) break;
        if (!(Epi::MID && cur.kh == 0))
#pragma unroll
        for (int a = 0; a < 2; ++a)
#pragma unroll
            for (int b = 0; b < 2; ++b)
#pragma unroll
                for (int m = 0; m < 4; ++m)
#pragma unroll
                    for (int n = 0; n < 2; ++n) acc[a][b][m][n] = (f32x4){0.f, 0.f, 0.f, 0.f};
        cur = nxt; cA = nA; cB = nB; ++ui;
        if constexpr (ALIGN_EPI) { if (wr == 1) PG8_BAR; }
    }
    PG8_WAIT_V(0);
    if constexpr (!ALIGN_EPI) { if (wr == 0) PG8_BAR; }
    PG8_BAR;
    if constexpr (Epi::AFTER_DRAIN) { E.fused(acc, cur, wr, wc, fr, fq, lds, wid, lane); S.done(cur); }
#undef PG8_SA
#undef PG8_SB
#undef PG8_STAGE
#undef PG8_LDA
#undef PG8_LDB
#undef PG8_MMA
#undef PG8_WAIT_V
#undef PG8_WAIT_L
#undef PG8_BAR
#undef PG8_SCHED
}
}
constexpr int NWAVES = 8, NTHREADS = 512;
constexpr int DM = 2048, NB = 8, SEQ = 4096, MROWS = NB * SEQ, FF = 5632, PLE = 256;
constexpr int SSMW = 1024, NG = 64, GH = 16, NP = 64, SBW = 1024, NHEAD = 8, HD = 128, NIN = 4096;
constexpr size_t MiB = 1u << 20;
constexpr size_t WS_STAT = 0;
constexpr size_t WS_LAM8 = 1 * MiB;
constexpr size_t WS_SSMMAT = 2 * MiB;
constexpr size_t WS_WGU1 = 8 * MiB, WS_WD1 = 52 * MiB, WS_WIN = 74 * MiB, WS_WGLU = 90 * MiB, WS_WOUT = 92 * MiB, WS_WGU2 = 100 * MiB, WS_WD2 = 144 * MiB, WS_WPG = 166 * MiB, WS_WPP = 174 * MiB;
constexpr size_t WS_PB = 176 * MiB;
constexpr size_t WS_XB = 192 * MiB;
constexpr size_t WS_YMIX = 320 * MiB;
constexpr size_t WS_ACT = 448 * MiB;
constexpr size_t WS_UG = WS_ACT, WS_Q = WS_ACT + 64 * MiB, WS_K = WS_ACT + 128 * MiB, WS_V = WS_ACT + 192 * MiB, WS_Z = WS_ACT + 256 * MiB, WS_E = WS_ACT;
constexpr size_t WS_END = 800 * MiB;
enum { ST_SS1 = 0, ST_SS2, ST_SSM, ST_SB, ST_SS3, ST_SS4, ST_SSE, ST_N };
constexpr int RING_BYTES = 131072, XCH_OFF = RING_BYTES, LDS_BYTES = 147456;

#define GAS __attribute__((address_space(1)))
#define LAS __attribute__((address_space(3)))
typedef unsigned short bf16;
typedef unsigned v4u __attribute__((ext_vector_type(4)));
typedef unsigned v2u __attribute__((ext_vector_type(2)));
typedef float f32x4 __attribute__((ext_vector_type(4)));
typedef short bf16x8 __attribute__((ext_vector_type(8)));
#define LDS_WAIT() asm volatile("s_waitcnt lgkmcnt(0)" ::: "memory")
using pg8::cvt_pk_bf16;
__device__ __forceinline__ float wave_sum(float v) {
#pragma unroll
    for (int o = 1; o < 64; o <<= 1) v += __shfl_xor(v, o);
    return v;
}
__device__ __forceinline__ f32x4 mfma16(bf16x8 a, bf16x8 b, f32x4 c) { return __builtin_amdgcn_mfma_f32_16x16x32_bf16(a, b, c, 0, 0, 0); }

#ifndef MK_DUP
#define MK_DUP 0u
#endif
constexpr int P0_REP = 1 + (int)(MK_DUP & 1u), P4_REP = 1 + (int)((MK_DUP >> 4) & 1u);
__device__ __forceinline__ void tr_item(const float* W, int K, int N, const float* gain, bf16* WT, int k0, int n0, int dstrow, LAS float* scr, int lane) {
    const int c4 = lane & 15, r0 = lane >> 4;
#pragma unroll 4
    for (int i = 0; i < 16; ++i) { const int kk = 4 * i + r0; f32x4 v = *(const GAS f32x4*)(W + (size_t)(k0 + kk) * N + n0 + 4 * c4); if (gain) v = v * gain[k0 + kk];
        *(LAS f32x4*)(scr + kk * 64 + 4 * (c4 ^ (2 * ((kk >> 3) & 7)))) = v; }
    LDS_WAIT(); asm volatile("" ::: "memory");
    const int c = lane & 7;
#pragma unroll
    for (int ps = 0; ps < 2; ++ps) { const int ng = (lane >> 3) + 8 * ps; f32x4 v[8];
#pragma unroll
        for (int j = 0; j < 8; ++j) v[j] = *(const LAS f32x4*)(scr + (8 * c + j) * 64 + 4 * (ng ^ (2 * c)));
#pragma unroll
        for (int i = 0; i < 4; ++i) { v4u o; o.x = cvt_pk_bf16(v[0][i], v[1][i]); o.y = cvt_pk_bf16(v[2][i], v[3][i]); o.z = cvt_pk_bf16(v[4][i], v[5][i]); o.w = cvt_pk_bf16(v[6][i], v[7][i]);
            *(GAS v4u*)(WT + (size_t)(dstrow + 4 * ng + i) * K + k0 + 8 * c) = o; } }
    LDS_WAIT(); asm volatile("" ::: "memory");
}

struct In {
    const float *x, *p, *ffn1_norm, *ffn1_wg, *ffn1_wu, *ffn1_wd, *mix_norm, *w_in, *lam_re, *lam_im, *b_re, *b_im, *c_re, *c_im, *log_dt, *ssm_d, *w_glu, *b_glu, *q_norm, *k_norm,
        *on_ssm, *on_sb, *w_out, *ffn2_norm, *ffn2_wg, *ffn2_wu, *ffn2_wd, *ple_norm, *w_pg, *w_pp, *ple_post;
};

__device__ __forceinline__ void ssm_build(const In& in, unsigned char* ws, LAS unsigned char* lds, int g, int tid) {
    LAS float* PW = (LAS float*)lds;
    LAS float* CO = PW + 9 * 64 * 2;
    LAS float* CB = CO + 64 * 2;
    LAS float* KT = CB + 64 * 16 * 2;
    if (tid < 64) {
        const int p = tid; const float dt = expf(in.log_dt[g]); const float lr = fminf(in.lam_re[g * 64 + p], -1e-4f), li = in.lam_im[g * 64 + p];
        const float a = lr * dt, th = li * dt; float s1, c1; sincosf(th, &s1, &c1); const float ea = expf(a);
        const float l1r = ea * c1, l1i = ea * s1;
        float pr = 1.f, pi = 0.f;
#pragma unroll
        for (int t = 0; t <= 8; ++t) { PW[(t * 64 + p) * 2] = pr; PW[(t * 64 + p) * 2 + 1] = pi; const float nr = pr * l1r - pi * l1i, ni = pr * l1i + pi * l1r; pr = nr; pi = ni; }
        float* l8 = (float*)(ws + WS_LAM8) + (g * 64 + p) * 2; l8[0] = PW[(8 * 64 + p) * 2]; l8[1] = PW[(8 * 64 + p) * 2 + 1];
        const float sh = sinf(0.5f * th); const float nr = expm1f(a) * c1 - 2.f * sh * sh, ni = l1i;
        const float den = 1.f / (lr * lr + li * li);
        CO[p * 2] = (nr * lr + ni * li) * den; CO[p * 2 + 1] = (ni * lr - nr * li) * den;
    }
    __syncthreads();
    for (int i = tid; i < 1024; i += NTHREADS) { const int p = i >> 4; const float br = in.b_re[g * 1024 + i], bi = in.b_im[g * 1024 + i], cr = CO[p * 2], ci = CO[p * 2 + 1];
        CB[i * 2] = cr * br - ci * bi; CB[i * 2 + 1] = cr * bi + ci * br; }
    __syncthreads();
    for (int i = tid; i < 2048; i += NTHREADS) { const int tau = i >> 8, h = (i >> 4) & 15, h2 = i & 15; float s = 0.f;
        for (int p = 0; p < 64; ++p) { const float cr = in.c_re[g * 1024 + h * 64 + p], ci = in.c_im[g * 1024 + h * 64 + p], pr = PW[(tau * 64 + p) * 2], pi = PW[(tau * 64 + p) * 2 + 1];
            const float wr = cr * pr - ci * pi, wi = cr * pi + ci * pr; s += wr * CB[(p * 16 + h2) * 2] - wi * CB[(p * 16 + h2) * 2 + 1]; }
        KT[i] = s; }
    __syncthreads();
    bf16* Ms = (bf16*)(ws + WS_SSMMAT) + (size_t)g * 3 * 16384; bf16* Mi = Ms + 16384; bf16* Mo = Mi + 16384;
    for (int i = tid; i < 16384; i += NTHREADS) { const int r = i >> 7, c = i & 127;
        { const int p = r & 63, s = c >> 4, h2 = c & 15; const float pr = PW[((7 - s) * 64 + p) * 2], pi = PW[((7 - s) * 64 + p) * 2 + 1], br = CB[(p * 16 + h2) * 2], bi = CB[(p * 16 + h2) * 2 + 1];
          const float v = (r < 64) ? (pr * br - pi * bi) : (pr * bi + pi * br); Ms[i] = (bf16)(cvt_pk_bf16(v, 0.f) & 0xffffu); }
        { const int t = r >> 4, h = r & 15, s = c >> 4, h2 = c & 15; float v = 0.f; if (s <= t) { v = KT[((t - s) * 16 + h) * 16 + h2]; if (r == c) v += in.ssm_d[g * 16 + h]; } Mi[i] = (bf16)(cvt_pk_bf16(v, 0.f) & 0xffffu); }
        { const int t = r >> 4, h = r & 15, p = c & 63; const float cr = in.c_re[g * 1024 + h * 64 + p], ci = in.c_im[g * 1024 + h * 64 + p], pr = PW[((t + 1) * 64 + p) * 2], pi = PW[((t + 1) * 64 + p) * 2 + 1];
          const float v = (c < 64) ? (cr * pr - ci * pi) : -(cr * pi + ci * pr); Mo[i] = (bf16)(cvt_pk_bf16(v, 0.f) & 0xffffu); }
    }
    __syncthreads();
}

__device__ __forceinline__ void p0_prologue(const In& in, float* out, unsigned char* ws, LAS unsigned char* lds, int tid, int lane, int wave) {
    const int G = gridDim.x, bx = blockIdx.x;
    for (int g = bx; g < NG; g += G) ssm_build(in, ws, lds, g, tid);
    { float* st = (float*)(ws + WS_STAT) + MROWS; for (int i = bx * NTHREADS + tid; i < (ST_N - 1) * MROWS; i += G * NTHREADS) st[i] = 0.f; }
    LAS float* scr = (LAS float*)(lds + wave * 16384);
    const int gw = bx * NWAVES + wave, NGW = G * NWAVES;
    constexpr int I_GU = (DM / 64) * (FF / 64), I_D = (FF / 64) * (DM / 64), I_IN = (DM / 64) * (NIN / 64), I_GLU = (SSMW / 64) * (SSMW / 64), I_SQ = (DM / 64) * (DM / 64), I_PP = (PLE / 64) * (DM / 64);
    constexpr int NITEMS = 4 * I_GU + 2 * I_D + I_IN + I_GLU + 2 * I_SQ + I_PP;
#define TR_ITEM(NI, Wp, Kd, Nd, gainp, dstoff, MODE) \
        if (r < (NI)) { const int nbk = (Nd) / 64, kb = r / nbk, nb = r % nbk, k0 = 64 * kb, n0 = 64 * nb; \
            const int dr = (MODE) == 0 ? n0 : (n0 / 128) * 256 + (n0 % 128) + ((MODE) == 2 ? 128 : 0); \
            tr_item((Wp), (Kd), (Nd), (gainp), (bf16*)(ws + (dstoff)), k0, n0, dr, scr, lane); continue; } r -= (NI);
    for (int it = gw; it < NITEMS * P0_REP; it += NGW) {
        int r = it % NITEMS;
        TR_ITEM(I_GU, in.ffn1_wg, DM, FF, in.ffn1_norm, WS_WGU1, 1)
        TR_ITEM(I_GU, in.ffn1_wu, DM, FF, in.ffn1_norm, WS_WGU1, 2)
        TR_ITEM(I_D, in.ffn1_wd, FF, DM, (const float*)nullptr, WS_WD1, 0)
        TR_ITEM(I_IN, in.w_in, DM, NIN, in.mix_norm, WS_WIN, 0)
        TR_ITEM(I_GLU, in.w_glu, SSMW, SSMW, (const float*)nullptr, WS_WGLU, 0)
        TR_ITEM(I_SQ, in.w_out, DM, DM, (k0 < 1024 ? in.on_ssm : in.on_sb - 1024), WS_WOUT, 0)
        TR_ITEM(I_GU, in.ffn2_wg, DM, FF, in.ffn2_norm, WS_WGU2, 1)
        TR_ITEM(I_GU, in.ffn2_wu, DM, FF, in.ffn2_norm, WS_WGU2, 2)
        TR_ITEM(I_D, in.ffn2_wd, FF, DM, (const float*)nullptr, WS_WD2, 0)
        TR_ITEM(I_SQ, in.w_pg, DM, DM, in.ple_norm, WS_WPG, 0)
        TR_ITEM(I_PP, in.w_pp, PLE, DM, (const float*)nullptr, WS_WPP, 0)
    }
#undef TR_ITEM
    { bf16* XB = (bf16*)(ws + WS_XB); float* ss1 = (float*)(ws + WS_STAT) + ST_SS1 * MROWS;
      for (int mm = gw; mm < MROWS * P0_REP; mm += NGW) { const int m = mm % MROWS; const GAS f32x4* xr = (const GAS f32x4*)(in.x + (size_t)m * DM) + lane; GAS v2u* o = (GAS v2u*)(XB + (size_t)m * DM) + lane; float s = 0.f;
#pragma unroll
          for (int j = 0; j < 8; ++j) { const f32x4 v = xr[64 * j]; s += (v.x * v.x + v.y * v.y) + (v.z * v.z + v.w * v.w); v2u w; w.x = cvt_pk_bf16(v.x, v.y); w.y = cvt_pk_bf16(v.z, v.w); o[64 * j] = w; }
          s = wave_sum(s); if (lane == 0) ss1[m] = s; } }
    { const GAS f32x4* ps = (const GAS f32x4*)in.p; GAS v2u* o = (GAS v2u*)(ws + WS_PB);
      for (int i = bx * NTHREADS + tid; i < MROWS * PLE / 4; i += G * NTHREADS) { const f32x4 v = ps[i]; v2u w; w.x = cvt_pk_bf16(v.x, v.y); w.y = cvt_pk_bf16(v.z, v.w); o[i] = w; } }
}

constexpr int SSM_DROW = 132, SSM_SROW = 136;
__device__ __forceinline__ void ssm_unit(unsigned char* ws, LAS unsigned char* lds, int b, int g, int lane, int wave) {
    const int r16 = lane & 15, q4 = lane >> 4;
    LAS float* DL = (LAS float*)lds; LAS bf16* S0 = (LAS bf16*)(lds + 64 * SSM_DROW * 4);
    const bf16* Ms = (const bf16*)(ws + WS_SSMMAT) + (size_t)g * 3 * 16384; const bf16* Mi = Ms + 16384; const bf16* Mo = Mi + 16384;
    bf16x8 aS[4], aI[4], aO[4];
#pragma unroll
    for (int ks = 0; ks < 4; ++ks) { const int o = (16 * wave + r16) * 128 + 32 * ks + 8 * q4; aS[ks] = *(const bf16x8*)(Ms + o); aI[ks] = *(const bf16x8*)(Mi + o); aO[ks] = *(const bf16x8*)(Mo + o); }
    const bf16* ug = (const bf16*)(ws + WS_UG) + (size_t)(b * 64 + g) * 4096 * 16;
    bf16* zb = (bf16*)(ws + WS_Z) + (size_t)b * 4096 * 1024 + g * 16;
    const float* l8 = (const float*)(ws + WS_LAM8) + (g * 64 + lane) * 2; const float l8r = l8[0], l8i = l8[1];
    float sre = 0.f, sim = 0.f;
    bf16x8 bu[4][4];
#define SSM_LOADU(SEG) do { _Pragma("unroll") for (int nt = 0; nt < 4; ++nt) { const int n = 64 * (SEG) + 16 * nt + r16; _Pragma("unroll") for (int ks = 0; ks < 4; ++ks) \
        bu[nt][ks] = *(const bf16x8*)(ug + (size_t)(n * 8 + 2 * ks + (q4 >> 1)) * 16 + 8 * (q4 & 1)); } } while (0)
    SSM_LOADU(0);
    for (int seg = 0; seg < 8; ++seg) {
        f32x4 ay[4];
#pragma unroll
        for (int nt = 0; nt < 4; ++nt) { f32x4 acc = {0.f, 0.f, 0.f, 0.f}, accy = {0.f, 0.f, 0.f, 0.f};
#pragma unroll
            for (int ks = 0; ks < 4; ++ks) { acc = mfma16(aS[ks], bu[nt][ks], acc); accy = mfma16(aI[ks], bu[nt][ks], accy); }
            *(LAS f32x4*)(DL + (16 * nt + r16) * SSM_DROW + 16 * wave + 4 * q4) = acc; ay[nt] = accy; }
        if (seg < 7) SSM_LOADU(seg + 1);
        __syncthreads();
        if (wave == 0) {
            for (int n = 0; n < 64; ++n) { S0[n * SSM_SROW + lane] = (bf16)(cvt_pk_bf16(sre, 0.f) & 0xffffu); S0[n * SSM_SROW + 64 + lane] = (bf16)(cvt_pk_bf16(sim, 0.f) & 0xffffu);
                const float dr = DL[n * SSM_DROW + lane], di = DL[n * SSM_DROW + 64 + lane];
                const float nr = l8r * sre - l8i * sim + dr, ni = l8r * sim + l8i * sre + di; sre = nr; sim = ni; }
        }
        __syncthreads();
#pragma unroll
        for (int nt = 0; nt < 4; ++nt) { const int n = 64 * seg + 16 * nt + r16; f32x4 acc = ay[nt];
#pragma unroll
            for (int ks = 0; ks < 4; ++ks) { const bf16x8 bs = *(const LAS bf16x8*)(S0 + (16 * nt + r16) * SSM_SROW + 32 * ks + 8 * q4); acc = mfma16(aO[ks], bs, acc); }
            f32x4 z;
#pragma unroll
            for (int e = 0; e < 4; ++e) { const float y = acc[e]; const float t = 1.5957691216057308f * (y + 0.044715f * y * y * y); z[e] = y * __builtin_amdgcn_rcpf(1.0f + __builtin_amdgcn_exp2f(-1.4426950408889634f * t)); }
            v2u w; w.x = cvt_pk_bf16(z[0], z[1]); w.y = cvt_pk_bf16(z[2], z[3]);
            *(v2u*)(zb + (size_t)(n * 8 + wave) * 1024 + 4 * q4) = w; }
    }
#undef SSM_LOADU
    __syncthreads();
}

constexpr int AT_KROW = 136, AT_VROW = 152, AT_SROW = 68, AT_PROW = 72;
constexpr int AT_KB = 64 * AT_KROW * 2, AT_VB = 64 * AT_VROW * 2, AT_BUF = AT_KB + AT_VB;
constexpr int AT_S_OFF = 2 * AT_BUF, AT_P_OFF = AT_S_OFF + 8 * 16 * AT_SROW * 4, AT_FLAG_OFF = AT_P_OFF + 8 * 16 * AT_PROW * 2;
static_assert(AT_FLAG_OFF + 64 <= RING_BYTES, "attention LDS");
constexpr float AT_THR = -152.0f;
typedef short s16x4 __attribute__((ext_vector_type(4)));
__device__ __forceinline__ s16x4 lds_tr(const LAS bf16* p) { return __builtin_bit_cast(s16x4, __builtin_amdgcn_ds_read_tr16_b64_v4i16((LAS s16x4*)p)); }
__device__ __forceinline__ void attn_unit(unsigned char* ws, LAS unsigned char* lds, int b, int h, int qb, int tid, int lane, int wave, bool do_ss) {
    const int r16 = lane & 15, q4 = lane >> 4;
    LAS float* Sw = (LAS float*)(lds + AT_S_OFF) + wave * 16 * AT_SROW; LAS bf16* Pw = (LAS bf16*)(lds + AT_P_OFF) + wave * 16 * AT_PROW;
    volatile LAS unsigned* flag = (volatile LAS unsigned*)(lds + AT_FLAG_OFF);
    const bf16* Qg = (const bf16*)(ws + WS_Q) + (size_t)b * SEQ * 1024 + h * 128;
    const bf16* Kg = (const bf16*)(ws + WS_K) + (size_t)b * SEQ * 1024 + h * 128;
    const bf16* Vg = (const bf16*)(ws + WS_V) + (size_t)b * SEQ * 1024 + h * 128;
    const int qw0 = 128 * qb + 16 * wave, qrow = qw0 + r16;
    bf16x8 qf[4];
#pragma unroll
    for (int ks = 0; ks < 4; ++ks) qf[ks] = *(const bf16x8*)(Qg + (size_t)qrow * 1024 + 32 * ks + 8 * q4);
    f32x4 o[8];
#pragma unroll
    for (int i = 0; i < 8; ++i) o[i] = (f32x4){0.f, 0.f, 0.f, 0.f};
    float carry = 0.f; bool done = false;
    const int pr0 = tid >> 4, pc = tid & 15;
    v4u kr[2], vr[2];
    int kt = 2 * qb + 1, buf = 0, it = 0;
#define AT_LOAD(KT) do { _Pragma("unroll") for (int i = 0; i < 2; ++i) { const size_t go = (size_t)(64 * (KT) + pr0 + 32 * i) * 1024 + 8 * pc; kr[i] = *(const v4u*)(Kg + go); vr[i] = *(const v4u*)(Vg + go); } } while (0)
#define AT_STAGE(B) do { _Pragma("unroll") for (int i = 0; i < 2; ++i) { const int row = pr0 + 32 * i; *(LAS v4u*)((LAS bf16*)(lds + (B) * AT_BUF) + row * AT_KROW + 8 * pc) = kr[i]; \
        *(LAS v4u*)((LAS bf16*)(lds + (B) * AT_BUF + AT_KB) + row * AT_VROW + 8 * pc) = vr[i]; } } while (0)
    AT_LOAD(kt); AT_STAGE(0);
    if (kt > 0) AT_LOAD(kt - 1);
    __syncthreads();
    for (;;) {
        const LAS bf16* Ks = (const LAS bf16*)(lds + buf * AT_BUF); const LAS bf16* Vs = (const LAS bf16*)(lds + buf * AT_BUF + AT_KB);
        const int j0 = 64 * kt;
        if (!done && j0 < qw0 + 15) {
#pragma unroll
            for (int t4 = 0; t4 < 4; ++t4) { f32x4 acc = {0.f, 0.f, 0.f, 0.f};
#pragma unroll
                for (int ks = 0; ks < 4; ++ks) { const bf16x8 ak = *(const LAS bf16x8*)(Ks + (16 * t4 + r16) * AT_KROW + 32 * ks + 8 * q4); acc = mfma16(ak, qf[ks], acc); }
                *(LAS f32x4*)(Sw + r16 * AT_SROW + 16 * t4 + 4 * q4) = acc; }
            LDS_WAIT(); __builtin_amdgcn_wave_barrier();
            float lk[16], ls[16];
#pragma unroll
            for (int c = 0; c < 4; ++c) { const f32x4 sv = *(const LAS f32x4*)(Sw + r16 * AT_SROW + 16 * q4 + 4 * c);
#pragma unroll
                for (int e = 0; e < 4; ++e) { const float z2 = sv[e]; const float az = __builtin_fabsf(z2); const float ex = __builtin_amdgcn_exp2f(-az); const float sp = fmaxf(z2, 0.f) + __builtin_amdgcn_logf(1.0f + ex);
                    const bool valid = (j0 + 16 * q4 + 4 * c + e) < qrow; lk[4 * c + e] = valid ? -sp : 0.f; ls[4 * c + e] = valid ? (z2 - sp) : -1.0e30f; } }
            float run = 0.f, ps[16];
#pragma unroll
            for (int i = 15; i >= 0; --i) { ps[i] = run; run += lk[i]; }
            const float t0 = __shfl(run, r16), t1 = __shfl(run, r16 + 16), t2 = __shfl(run, r16 + 32), t3 = __shfl(run, r16 + 48);
            const float offs = (q4 < 1 ? t1 : 0.f) + (q4 < 2 ? t2 : 0.f) + (q4 < 3 ? t3 : 0.f);
            const float base = carry + offs;
            float wv[16];
#pragma unroll
            for (int i = 0; i < 16; ++i) wv[i] = __builtin_amdgcn_exp2f(ls[i] + ps[i] + base);
            carry += (t0 + t1) + (t2 + t3);
            v4u p0, p1;
            p0.x = cvt_pk_bf16(wv[0], wv[1]); p0.y = cvt_pk_bf16(wv[2], wv[3]); p0.z = cvt_pk_bf16(wv[4], wv[5]); p0.w = cvt_pk_bf16(wv[6], wv[7]);
            p1.x = cvt_pk_bf16(wv[8], wv[9]); p1.y = cvt_pk_bf16(wv[10], wv[11]); p1.z = cvt_pk_bf16(wv[12], wv[13]); p1.w = cvt_pk_bf16(wv[14], wv[15]);
            *(LAS v4u*)(Pw + r16 * AT_PROW + 16 * q4) = p0; *(LAS v4u*)(Pw + r16 * AT_PROW + 16 * q4 + 8) = p1;
            LDS_WAIT(); __builtin_amdgcn_wave_barrier();
            bf16x8 bp[2];
#pragma unroll
            for (int ks = 0; ks < 2; ++ks) bp[ks] = *(const LAS bf16x8*)(Pw + r16 * AT_PROW + 32 * ks + 8 * q4);
            const LAS bf16* vb = Vs + (8 * q4 + (r16 >> 2)) * AT_VROW + 4 * (r16 & 3);
#pragma unroll
            for (int dt = 0; dt < 8; ++dt)
#pragma unroll
                for (int ks = 0; ks < 2; ++ks) { const s16x4 lo = lds_tr(vb + 32 * ks * AT_VROW + 16 * dt), hi = lds_tr(vb + (32 * ks + 4) * AT_VROW + 16 * dt);
                    const bf16x8 av = __builtin_shufflevector(lo, hi, 0, 1, 2, 3, 4, 5, 6, 7); o[dt] = mfma16(av, bp[ks], o[dt]); }
            done = __all(carry < AT_THR);
        }
        if (kt > 0) { AT_STAGE(buf ^ 1); if (kt > 1) AT_LOAD(kt - 2); }
        if (lane == 0) flag[(it & 1) * 8 + wave] = (!done && kt > 0) ? 1u : 0u;
        __syncthreads();
        unsigned any = 0;
#pragma unroll
        for (int i = 0; i < 8; ++i) any |= flag[(it & 1) * 8 + i];
        if (!any) break;
        --kt; buf ^= 1; ++it;
    }
#undef AT_LOAD
#undef AT_STAGE
    bf16* Y = (bf16*)(ws + WS_YMIX) + (size_t)(b * SEQ + qrow) * 2048 + 1024 + h * 128 + 4 * q4;
    float q = 0.f;
#pragma unroll
    for (int dt = 0; dt < 8; ++dt) { v2u w; w.x = cvt_pk_bf16(o[dt][0], o[dt][1]); w.y = cvt_pk_bf16(o[dt][2], o[dt][3]); *(v2u*)(Y + 16 * dt) = w; q += (o[dt][0] * o[dt][0] + o[dt][1] * o[dt][1]) + (o[dt][2] * o[dt][2] + o[dt][3] * o[dt][3]); }
    q += __shfl_xor(q, 16); q += __shfl_xor(q, 32);
    if (q4 == 0 && do_ss) atomicAdd((float*)(ws + WS_STAT) + ST_SB * MROWS + b * SEQ + qrow, q);
    __syncthreads();
}

struct Args { const float* in[31]; float* out; unsigned char* ws; };
#ifndef MK_PHASE_MASK
#define MK_PHASE_MASK 0xFFFFFFFFu
#endif
__global__ void __launch_bounds__(NTHREADS, 2) mk_fwd(Args args) {
    extern __shared__ __attribute__((aligned(16))) unsigned char lds_raw[];
    LAS unsigned char* lds = (LAS unsigned char*)lds_raw;
    cg::grid_group grid = cg::this_grid();
    const int wave_s = __builtin_amdgcn_readfirstlane(threadIdx.x >> 6);
#define FRESH_IDS unsigned ones_ = ~0u; asm volatile("" : "+s"(ones_)); const int lane = (int)__builtin_amdgcn_mbcnt_hi(ones_, __builtin_amdgcn_mbcnt_lo(ones_, 0u)), wave = wave_s, tid = wave * 64 + lane; (void)tid; (void)lane; (void)wave;
    const int G = gridDim.x, bx = blockIdx.x;
    unsigned char* ws = args.ws; float* out = args.out;
    In in;
    in.x = args.in[0]; in.p = args.in[1]; in.ffn1_norm = args.in[2]; in.ffn1_wg = args.in[3]; in.ffn1_wu = args.in[4]; in.ffn1_wd = args.in[5]; in.mix_norm = args.in[6]; in.w_in = args.in[7];
    in.lam_re = args.in[8]; in.lam_im = args.in[9]; in.b_re = args.in[10]; in.b_im = args.in[11]; in.c_re = args.in[12]; in.c_im = args.in[13]; in.log_dt = args.in[14]; in.ssm_d = args.in[15];
    in.w_glu = args.in[16]; in.b_glu = args.in[17]; in.q_norm = args.in[18]; in.k_norm = args.in[19]; in.on_ssm = args.in[20]; in.on_sb = args.in[21]; in.w_out = args.in[22];
    in.ffn2_norm = args.in[23]; in.ffn2_wg = args.in[24]; in.ffn2_wu = args.in[25]; in.ffn2_wd = args.in[26]; in.ple_norm = args.in[27]; in.w_pg = args.in[28]; in.w_pp = args.in[29]; in.ple_post = args.in[30];
    float* stat = (float*)(ws + WS_STAT);
    bf16* XB = (bf16*)(ws + WS_XB); bf16* ACT = (bf16*)(ws + WS_ACT); bf16* YMIX = (bf16*)(ws + WS_YMIX);
#define PH(k) ((MK_PHASE_MASK >> (k)) & 1u)
#ifndef MK_DUP
#define MK_DUP 0u
#endif
#define NREP(k) (1 + (int)((MK_DUP >> (k)) & 1u))

    { FRESH_IDS p0_prologue(in, out, ws, lds, tid, lane, wave); }
    grid.sync();
    for (int rep_ = 0; rep_ < NREP(1); ++rep_) { pg8::Gemm g{XB, (const bf16*)(ws + WS_WGU1), MROWS, 2 * FF, DM, DM}; pg8::StaticOrder S; S.init(MROWS, 2 * FF, G, bx);
        pg8::EpiSwiGLU E{ACT, stat + ST_SS1 * MROWS, FF}; pg8::gemm_phase<pg8::EpiSwiGLU, pg8::StaticOrder, true, true>(lds, g, S, E, wave_s); }
    grid.sync();
    for (int rep_ = 0; rep_ < NREP(2); ++rep_) { pg8::Gemm g{ACT, (const bf16*)(ws + WS_WD1), MROWS, DM, FF, FF}; pg8::StaticOrder S; S.init(MROWS, DM, G, bx);
        pg8::EpiResid<0, true> E{in.x, XB, (rep_ + 1 < NREP(2)) ? nullptr : stat + ST_SS2 * MROWS, nullptr, nullptr}; pg8::gemm_phase<pg8::EpiResid<0, true>, pg8::StaticOrder, true, true>(lds, g, S, E, wave_s); }
    grid.sync();
    for (int rep_ = 0; rep_ < NREP(3); ++rep_) { pg8::Gemm g{XB, (const bf16*)(ws + WS_WIN), MROWS, NIN, DM, DM}; pg8::StaticOrder S; S.init(MROWS, NIN, G, bx);
        pg8::EpiWin E{stat + ST_SS2 * MROWS, (bf16*)(ws + WS_UG), (bf16*)(ws + WS_Q), (bf16*)(ws + WS_K), (bf16*)(ws + WS_V), in.q_norm, in.k_norm, (LAS float*)(lds + XCH_OFF)};
        pg8::gemm_phase<pg8::EpiWin, pg8::StaticOrder, true, true>(lds, g, S, E, wave_s); }
    grid.sync();
    { FRESH_IDS
        for (int itt = bx; itt < (512 + 2048) * P4_REP; itt += G) { const int it = itt % (512 + 2048);
            if (it < 512) ssm_unit(ws, lds, it >> 6, it & 63, lane, wave);
            else { const int a = it - 512; attn_unit(ws, lds, a >> 8, (a >> 5) & 7, a & 31, tid, lane, wave, itt >= (512 + 2048) * (P4_REP - 1)); }
        }
    }
    grid.sync();
    if (PH(5)) { pg8::Gemm g{(const bf16*)(ws + WS_Z), (const bf16*)(ws + WS_WGLU), MROWS, SSMW, SSMW, SSMW}; pg8::StaticOrder S; S.init(MROWS, SSMW, G, bx);
        pg8::EpiGlu E{(const bf16*)(ws + WS_Z), in.b_glu, YMIX, stat + ST_SSM * MROWS}; pg8::gemm_phase<pg8::EpiGlu, pg8::StaticOrder, true, true>(lds, g, S, E, wave_s); }
    grid.sync();
    if (PH(6)) { pg8::Gemm g{YMIX, (const bf16*)(ws + WS_WOUT), MROWS, DM, DM, DM / 2}; pg8::SplitOrder S; S.base.init(MROWS, DM, G, bx);
        pg8::EpiResid<1, false> E{nullptr, XB, stat + ST_SS3 * MROWS, stat + ST_SSM * MROWS, stat + ST_SB * MROWS}; pg8::gemm_phase<pg8::EpiResid<1, false>, pg8::SplitOrder, true, true>(lds, g, S, E, wave_s); }
    grid.sync();
    if (PH(7)) { pg8::Gemm g{XB, (const bf16*)(ws + WS_WGU2), MROWS, 2 * FF, DM, DM}; pg8::StaticOrder S; S.init(MROWS, 2 * FF, G, bx);
        pg8::EpiSwiGLU E{ACT, stat + ST_SS3 * MROWS, FF}; pg8::gemm_phase<pg8::EpiSwiGLU, pg8::StaticOrder, true, true>(lds, g, S, E, wave_s); }
    grid.sync();
    if (PH(8)) { pg8::Gemm g{ACT, (const bf16*)(ws + WS_WD2), MROWS, DM, FF, FF}; pg8::StaticOrder S; S.init(MROWS, DM, G, bx);
        pg8::EpiResid<0, false> E{nullptr, XB, stat + ST_SS4 * MROWS, nullptr, nullptr}; pg8::gemm_phase<pg8::EpiResid<0, false>, pg8::StaticOrder, true, true>(lds, g, S, E, wave_s); }
    grid.sync();
    if (PH(9)) { pg8::Gemm g{(const bf16*)(ws + WS_PB), (const bf16*)(ws + WS_WPP), MROWS, DM, PLE, PLE}; pg8::StaticOrder S; S.init(MROWS, DM, G, bx);
        pg8::EpiPlain E{YMIX, DM}; pg8::gemm_phase<pg8::EpiPlain, pg8::StaticOrder, true, true>(lds, g, S, E, wave_s); }
    asm volatile("s_waitcnt vmcnt(0)" ::: "memory"); __syncthreads();
    if (PH(10)) { pg8::Gemm g{XB, (const bf16*)(ws + WS_WPG), MROWS, DM, DM, DM}; pg8::StaticOrder S; S.init(MROWS, DM, G, bx);
        pg8::EpiPle E{YMIX, stat + ST_SS4 * MROWS, (bf16*)(ws + WS_E), stat + ST_SSE * MROWS}; pg8::gemm_phase<pg8::EpiPle, pg8::StaticOrder, true, true>(lds, g, S, E, wave_s); }
    grid.sync();
    if (PH(11)) { FRESH_IDS const bf16* E = (const bf16*)(ws + WS_E); const float* sse = stat + ST_SSE * MROWS; const int gw = bx * NWAVES + wave, NGW = G * NWAVES;
        for (int m = gw; m < MROWS; m += NGW) { const float r = pg8::rstd_of(sse[m], 1.0f / 2048.0f); GAS f32x4* xr = (GAS f32x4*)(out + (size_t)m * DM) + lane; const GAS v2u* xbr = (const GAS v2u*)(XB + (size_t)m * DM) + lane; const GAS v2u* er = (const GAS v2u*)(E + (size_t)m * DM) + lane;
            const GAS f32x4* gp = (const GAS f32x4*)in.ple_post + lane;
#pragma unroll
            for (int j = 0; j < 8; ++j) { const v2u xw = xbr[64 * j]; const v2u w = er[64 * j]; const f32x4 gg = gp[64 * j]; f32x4 v;
                v.x = pg8::bf_lo(xw.x) + pg8::bf_lo(w.x) * r * gg.x; v.y = pg8::bf_hi(xw.x) + pg8::bf_hi(w.x) * r * gg.y; v.z = pg8::bf_lo(xw.y) + pg8::bf_lo(w.y) * r * gg.z; v.w = pg8::bf_hi(xw.y) + pg8::bf_hi(w.y) * r * gg.w; xr[64 * j] = v; } } }
#undef PH
}

extern "C" void kernel_launch(void* const* d_in, const int* in_sizes, int n_in, void* d_out, int out_size, void* d_ws, size_t ws_size, hipStream_t stream) {
    static int grid = 0;
    if (grid == 0) {
        if (n_in != 31 || out_size != MROWS * DM || ws_size < WS_END) { fprintf(stderr, "kernel_launch: unexpected shapes (n_in %d, out %d, ws %zu)\n", n_in, out_size, ws_size); grid = -1; return; }
        int dev = 0, cus = 0, per_cu = 0;
        hipGetDevice(&dev); hipDeviceGetAttribute(&cus, hipDeviceAttributeMultiprocessorCount, dev);
        if (hipFuncSetAttribute((const void*)mk_fwd, hipFuncAttributeMaxDynamicSharedMemorySize, LDS_BYTES) != hipSuccess) { fprintf(stderr, "kernel_launch: hipFuncSetAttribute failed\n"); grid = -1; return; }
        if (hipOccupancyMaxActiveBlocksPerMultiprocessor(&per_cu, (const void*)mk_fwd, NTHREADS, LDS_BYTES) != hipSuccess || per_cu < 1) { fprintf(stderr, "kernel_launch: occupancy query gives %d\n", per_cu); per_cu = 1; }
        (void)hipGetLastError();
        grid = cus * 1;
    }
    if (grid < 0) return;
    Args a{};
    for (int i = 0; i < 31; ++i) a.in[i] = (const float*)d_in[i];
    a.out = (float*)d_out; a.ws = (unsigned char*)d_ws;
    void* kargs[] = {&a};
    hipError_t e = hipLaunchCooperativeKernel((const void*)mk_fwd, dim3(grid), dim3(NTHREADS), kargs, LDS_BYTES, stream);
    if (e != hipSuccess) fprintf(stderr, "kernel_launch: cooperative launch failed: %s (grid %d)\n", hipGetErrorString(e), grid);
}
```

```cpp
#include <hip/hip_runtime.h>
#include <hip/hip_cooperative_groups.h>
#include <cstdio>
#include <cstdint>
namespace cg = cooperative_groups;
namespace pg8 {
#define PG8_LAS __attribute__((address_space(3)))
typedef unsigned short bf16_t;
typedef short bf16x8 __attribute__((ext_vector_type(8)));
typedef float f32x4 __attribute__((ext_vector_type(4)));
typedef unsigned u32x4 __attribute__((ext_vector_type(4)));
constexpr int BM = 256, BK = 64, HALF = 128, HTB = HALF * BK * 2  , STAGE_BYTES = 8 * HTB, NXCD = 8, WGM = 8;

__host__ __device__ __forceinline__ int lds_byte(int r, int c) { const int st = (r >> 4) * 2 + (c >> 5), rr = r & 15, cc = c & 31, ob = rr * 64 + cc * 2; return st * 1024 + (ob ^ (((ob >> 9) & 1) << 5)); }
__host__ __device__ __forceinline__ void stage_rc(int b, int& R, int& C) { const int st = b / 1024, sb = b % 1024, swz = sb ^ (((sb >> 9) & 1) << 5); R = (st >> 1) * 16 + swz / 64; C = (st & 1) * 32 + (swz % 64) / 2; }
__host__ __device__ __forceinline__ int perm32(int rho) { const int n = rho >> 4, i = rho & 15; return 8 * (i >> 2) + 4 * n + (i & 3); }

struct Unit { int pm, pn, kh, par; };
struct Gemm { const bf16_t* A; const bf16_t* Bt; int M, N, K, KU; };

struct StaticOrder {
    int nM, nN, nwg, G, c;
    __host__ __device__ void init(int M, int N, int G_, int c_) { nM = M / BM; nN = N / BM; nwg = nM * nN; G = G_; c = c_; }
    __host__ __device__ bool next(int i, Unit& u) const {
        const long L = (long)i * G + c; if (L >= nwg) return false;
        int wgid = (int)L; { const int q = nwg / NXCD, r = nwg % NXCD, xcd = wgid % NXCD, off = wgid / NXCD; wgid = (xcd < r ? xcd * (q + 1) : r * (q + 1) + (xcd - r) * q) + off; }
        const int nig = WGM * nN, gid = wgid / nig, fm = gid * WGM, gsz = (nM - fm) < WGM ? (nM - fm) : WGM;
        u.pm = fm + ((wgid % nig) % gsz); u.pn = (wgid % nig) / gsz; u.kh = 0; return true;
    }
    __device__ __forceinline__ void a_ready(const Unit&) const {}
    __device__ __forceinline__ void done(const Unit&) const {}
};

__device__ __forceinline__ unsigned cvt_pk_bf16(float lo, float hi) { unsigned r; asm volatile("v_cvt_pk_bf16_f32 %0, %1, %2" : "=v"(r) : "v"(lo), "v"(hi)); return r; }
struct SplitOrder {
    StaticOrder base;
    __device__ bool next(int i, Unit& u) const { const bool r = base.next(i >> 1, u); u.kh = i & 1; return r; }
    __device__ __forceinline__ void a_ready(const Unit&) const {}
    __device__ __forceinline__ void done(const Unit&) const {}
};
typedef float f32x2 __attribute__((ext_vector_type(2)));
__device__ __forceinline__ float rstd_of(float ss, float inv_n) { return __builtin_amdgcn_rsqf(ss * inv_n + 1e-6f); }
__device__ __forceinline__ float sigmoid_f(float v) { return __builtin_amdgcn_rcpf(1.0f + __builtin_amdgcn_exp2f(-1.4426950408889634f * v)); }
__device__ __forceinline__ float bf_lo(unsigned w) { return __uint_as_float(w << 16); }
__device__ __forceinline__ float bf_hi(unsigned w) { return __uint_as_float(w & 0xffff0000u); }
__device__ __forceinline__ u32x4 pack8(const f32x4 a, const f32x4 b) { u32x4 w; w.x = cvt_pk_bf16(a[0], a[1]); w.y = cvt_pk_bf16(a[2], a[3]); w.z = cvt_pk_bf16(b[0], b[1]); w.w = cvt_pk_bf16(b[2], b[3]); return w; }
__device__ __forceinline__ float sumsq4(const f32x4 a) { return (a[0] * a[0] + a[1] * a[1]) + (a[2] * a[2] + a[3] * a[3]); }

struct EpiSwiGLU {
    static constexpr bool PERM = true, AFTER_DRAIN = false, MID = false, PREF = true;
    bf16_t* O; const float* ss; int ldo; PG8_LAS float* sl;
    __device__ __forceinline__ void prefetch(const Unit& u, int wid, int lane) const {
        if (wid < 4) __builtin_amdgcn_global_load_lds((const unsigned*)(ss + u.pm * BM + 64 * wid + lane), (PG8_LAS unsigned*)(sl + u.par * 256 + 64 * wid), 4, 0, 0);
    }
    __device__ __forceinline__ void operator()(f32x4 (&acc)[2][2][4][2], const Unit& u, int wr, int wc, int fr, int fq) const {
        const int row0 = u.pm * BM + wr * 64 + fr, col0 = u.pn * HALF + wc * 32 + 8 * fq;
#pragma unroll
        for (int ai = 0; ai < 2; ++ai)
#pragma unroll
            for (int m = 0; m < 4; ++m) {
                const int row = row0 + ai * HALF + m * 16; const float r = rstd_of(sl[u.par * 256 + ai * HALF + wr * 64 + m * 16 + fr], 1.0f / 2048.0f);
                f32x4 o[2];
#pragma unroll
                for (int n = 0; n < 2; ++n) { const f32x4 g = acc[ai][0][m][n] * r, uu = acc[ai][1][m][n] * r;
#pragma unroll
                    for (int e = 0; e < 4; ++e) o[n][e] = g[e] * uu[e] * sigmoid_f(g[e]); }
                *(u32x4*)(O + (((size_t)u.pm * (ldo / 64) + (col0 >> 6)) * BM + (ai * HALF + wr * 64 + m * 16 + fr)) * 64 + (col0 & 63)) = pack8(o[0], o[1]);
            }
    }
    __device__ __forceinline__ void mid(f32x4 (&)[2][2][4][2], const Unit&, int, int) const {}
};

template <int MODE, bool XF32> struct EpiResid {
    static constexpr bool PERM = true, AFTER_DRAIN = false, MID = (MODE == 1), PREF = false;
    const float* xin; bf16_t* xb; float* ssout; const float* ssa; const float* ssb;
    __device__ __forceinline__ void mid(f32x4 (&acc)[2][2][4][2], const Unit& u, int wr, int fr) const {
        {
            const int row0 = u.pm * BM + wr * 64 + fr;
#pragma unroll
            for (int ai = 0; ai < 2; ++ai)
#pragma unroll
                for (int m = 0; m < 4; ++m) { const int row = row0 + ai * HALF + m * 16;
                    const float ra = rstd_of(ssa[row], 1.0f / 1024.0f), rb = rstd_of(ssb[row], 1.0f / 1024.0f), ratio = ra * __builtin_amdgcn_rcpf(rb);
#pragma unroll
                    for (int bj = 0; bj < 2; ++bj)
#pragma unroll
                        for (int n = 0; n < 2; ++n) acc[ai][bj][m][n] = acc[ai][bj][m][n] * ratio;
                    asm volatile("" ::: "memory"); }
        }
    }
    __device__ __forceinline__ void operator()(f32x4 (&acc)[2][2][4][2], const Unit& u, int wr, int wc, int fr, int fq) const {
        if (MODE == 1 && u.kh == 0) { mid(acc, u, wr, fr); return; }
        const int row0 = u.pm * BM + wr * 64 + fr, col0 = u.pn * BM + wc * 32 + 8 * fq;
        u32x4 xw[2][4][2]; f32x4 xf[XF32 ? 16 : 1][2];
#pragma unroll
        for (int ai = 0; ai < 2; ++ai)
#pragma unroll
            for (int m = 0; m < 4; ++m)
#pragma unroll
                for (int bj = 0; bj < 2; ++bj) { const size_t off = (size_t)(row0 + ai * HALF + m * 16) * 2048 + col0 + bj * HALF;
                    if constexpr (XF32) { xf[(ai * 4 + m) * 2 + bj][0] = *(const f32x4*)(xin + off); xf[(ai * 4 + m) * 2 + bj][1] = *(const f32x4*)(xin + off + 4); }
                    else xw[ai][m][bj] = *(const u32x4*)(xb + off); }
#pragma unroll
        for (int ai = 0; ai < 2; ++ai)
#pragma unroll
            for (int m = 0; m < 4; ++m) {
                const int row = row0 + ai * HALF + m * 16; const size_t off = (size_t)row * 2048 + col0;
                float sc = 0.5f; if constexpr (MODE == 1) sc = rstd_of(ssb[row], 1.0f / 1024.0f);
                float q = 0.f;
#pragma unroll
                for (int bj = 0; bj < 2; ++bj) {
                    f32x4 x0, x1;
                    if constexpr (XF32) { x0 = xf[(ai * 4 + m) * 2 + bj][0]; x1 = xf[(ai * 4 + m) * 2 + bj][1]; }
                    else { const u32x4 w = xw[ai][m][bj]; x0 = (f32x4){bf_lo(w.x), bf_hi(w.x), bf_lo(w.y), bf_hi(w.y)}; x1 = (f32x4){bf_lo(w.z), bf_hi(w.z), bf_lo(w.w), bf_hi(w.w)}; }
                    const f32x4 v0 = x0 + acc[ai][bj][m][0] * sc, v1 = x1 + acc[ai][bj][m][1] * sc;
                    *(u32x4*)(xb + off + bj * HALF) = pack8(v0, v1);
                    q += sumsq4(v0) + sumsq4(v1);
                }
                q += __shfl_xor(q, 16); q += __shfl_xor(q, 32);
                if (fq == 0 && ssout) atomicAdd(ssout + row, q);
            }
    }
};

struct EpiWin {
    static constexpr bool PERM = true, AFTER_DRAIN = false, MID = false, PREF = false;
    const float* ss; bf16_t *UG, *Q, *K, *V; const float *gq, *gk; PG8_LAS float* xch;
    __device__ __forceinline__ void mid(f32x4 (&)[2][2][4][2], const Unit&, int, int) const {}
    __device__ __forceinline__ void operator()(f32x4 (&acc)[2][2][4][2], const Unit& u, int wr, int wc, int fr, int fq) const {
        const int row0 = u.pm * BM + wr * 64 + fr, seg = u.pn >> 2, lc0 = (u.pn & 3) * BM + wc * 32 + 8 * fq; const float* ssr = ss + row0;
        if (seg == 0) {
#pragma unroll
            for (int ai = 0; ai < 2; ++ai)
#pragma unroll
                for (int m = 0; m < 4; ++m) { const float r = rstd_of(ssr[ai * HALF + m * 16], 1.0f / 2048.0f); const int row = row0 + ai * HALF + m * 16, b = row >> 12, t = row & 4095;
#pragma unroll
                    for (int bj = 0; bj < 2; ++bj) { const int col = lc0 + bj * HALF, g = col >> 4, half = (col >> 3) & 1;
                        *(u32x4*)(UG + ((size_t)((b * 64 + g) * 4096 + t) * 16 + 8 * half)) = pack8(acc[ai][bj][m][0] * r, acc[ai][bj][m][1] * r); } }
        } else if (seg == 3) {
#pragma unroll
            for (int ai = 0; ai < 2; ++ai)
#pragma unroll
                for (int m = 0; m < 4; ++m) { const float r = rstd_of(ssr[ai * HALF + m * 16], 1.0f / 2048.0f); const int row = row0 + ai * HALF + m * 16;
#pragma unroll
                    for (int bj = 0; bj < 2; ++bj) *(u32x4*)(V + (size_t)row * 1024 + lc0 + bj * HALF) = pack8(acc[ai][bj][m][0] * r, acc[ai][bj][m][1] * r); }
        } else {
#pragma unroll
            for (int ai = 0; ai < 2; ++ai)
#pragma unroll
                for (int m = 0; m < 4; ++m) { const int rl = ai * HALF + wr * 64 + m * 16 + fr;
#pragma unroll
                    for (int bj = 0; bj < 2; ++bj) { float q = sumsq4(acc[ai][bj][m][0]) + sumsq4(acc[ai][bj][m][1]); q += __shfl_xor(q, 16); q += __shfl_xor(q, 32);
                        if (fq == 0) xch[rl * 8 + bj * 4 + wc] = q; } }
            asm volatile("s_waitcnt lgkmcnt(0)" ::: "memory"); __builtin_amdgcn_s_barrier(); asm volatile("" ::: "memory");
            const float* gain = (seg == 1) ? gq : gk; bf16_t* dst = (seg == 1) ? Q : K;
            const float osc = (seg == 1) ? (0.08838834764831845f * 1.4426950408889634f) : 1.0f;
            const int d0 = wc * 32 + 8 * fq;
            const f32x4 g0 = *(const f32x4*)(gain + d0) * osc, g1 = *(const f32x4*)(gain + d0 + 4) * osc;
#pragma unroll
            for (int ai = 0; ai < 2; ++ai)
#pragma unroll
                for (int m = 0; m < 4; ++m) { const int rl = ai * HALF + wr * 64 + m * 16 + fr, row = u.pm * BM + rl;
                    const float epr = 1e-6f * (ssr[ai * HALF + m * 16] * (1.0f / 2048.0f) + 1e-6f);
#pragma unroll
                    for (int bj = 0; bj < 2; ++bj) { const f32x4 p = *(const PG8_LAS f32x4*)(xch + rl * 8 + bj * 4);
                        const float rq = __builtin_amdgcn_rsqf(((p[0] + p[1]) + (p[2] + p[3])) * (1.0f / 128.0f) + epr);
                        *(u32x4*)(dst + (size_t)row * 1024 + lc0 + bj * HALF) = pack8(acc[ai][bj][m][0] * g0 * rq, acc[ai][bj][m][1] * g1 * rq); } }
        }
    }
};

struct EpiGlu {
    static constexpr bool PERM = true, AFTER_DRAIN = false, MID = false, PREF = false;
    const bf16_t* Z; const float* bias; bf16_t* Y; float* ssout;
    __device__ __forceinline__ void mid(f32x4 (&)[2][2][4][2], const Unit&, int, int) const {}
    __device__ __forceinline__ void operator()(f32x4 (&acc)[2][2][4][2], const Unit& u, int wr, int wc, int fr, int fq) const {
        const int row0 = u.pm * BM + wr * 64 + fr, col0 = u.pn * BM + wc * 32 + 8 * fq;
        f32x4 bv[2][2];
#pragma unroll
        for (int bj = 0; bj < 2; ++bj)
#pragma unroll
            for (int n = 0; n < 2; ++n) bv[bj][n] = *(const f32x4*)(bias + col0 + bj * HALF + 4 * n);
        u32x4 zw[2][4][2];
#pragma unroll
        for (int ai = 0; ai < 2; ++ai)
#pragma unroll
            for (int m = 0; m < 4; ++m)
#pragma unroll
                for (int bj = 0; bj < 2; ++bj) zw[ai][m][bj] = *(const u32x4*)(Z + (size_t)(row0 + ai * HALF + m * 16) * 1024 + col0 + bj * HALF);
#pragma unroll
        for (int ai = 0; ai < 2; ++ai)
#pragma unroll
            for (int m = 0; m < 4; ++m) { const int row = row0 + ai * HALF + m * 16; float q = 0.f;
#pragma unroll
                for (int bj = 0; bj < 2; ++bj) { const u32x4 zb = zw[ai][m][bj];
                    const f32x4 z0 = {bf_lo(zb.x), bf_hi(zb.x), bf_lo(zb.y), bf_hi(zb.y)}, z1 = {bf_lo(zb.z), bf_hi(zb.z), bf_lo(zb.w), bf_hi(zb.w)};
                    const f32x4 a0 = acc[ai][bj][m][0] + bv[bj][0], a1 = acc[ai][bj][m][1] + bv[bj][1]; f32x4 y0, y1;
#pragma unroll
                    for (int e = 0; e < 4; ++e) { y0[e] = z0[e] * sigmoid_f(a0[e]); y1[e] = z1[e] * sigmoid_f(a1[e]); }
                    *(u32x4*)(Y + (size_t)row * 2048 + col0 + bj * HALF) = pack8(y0, y1); q += sumsq4(y0) + sumsq4(y1); }
                q += __shfl_xor(q, 16); q += __shfl_xor(q, 32);
                if (fq == 0) atomicAdd(ssout + row, q); }
    }
};

struct EpiPle {
    static constexpr bool PERM = true, AFTER_DRAIN = false, MID = false, PREF = false;
    const bf16_t* PP; const float* ss; bf16_t* E; float* ssout;
    __device__ __forceinline__ void mid(f32x4 (&)[2][2][4][2], const Unit&, int, int) const {}
    __device__ __forceinline__ void operator()(f32x4 (&acc)[2][2][4][2], const Unit& u, int wr, int wc, int fr, int fq) const {
        const int row0 = u.pm * BM + wr * 64 + fr, col0 = u.pn * BM + wc * 32 + 8 * fq;
        u32x4 pw[2][4][2];
#pragma unroll
        for (int ai = 0; ai < 2; ++ai)
#pragma unroll
            for (int m = 0; m < 4; ++m)
#pragma unroll
                for (int bj = 0; bj < 2; ++bj) pw[ai][m][bj] = *(const u32x4*)(PP + (size_t)(row0 + ai * HALF + m * 16) * 2048 + col0 + bj * HALF);
#pragma unroll
        for (int ai = 0; ai < 2; ++ai)
#pragma unroll
            for (int m = 0; m < 4; ++m) { const int row = row0 + ai * HALF + m * 16; const float r = rstd_of(ss[row], 1.0f / 2048.0f); float q = 0.f;
#pragma unroll
                for (int bj = 0; bj < 2; ++bj) { const u32x4 pb = pw[ai][m][bj];
                    const f32x4 p0 = {bf_lo(pb.x), bf_hi(pb.x), bf_lo(pb.y), bf_hi(pb.y)}, p1 = {bf_lo(pb.z), bf_hi(pb.z), bf_lo(pb.w), bf_hi(pb.w)};
                    const f32x4 a0 = acc[ai][bj][m][0] * r, a1 = acc[ai][bj][m][1] * r; f32x4 y0, y1;
#pragma unroll
                    for (int e = 0; e < 4; ++e) { y0[e] = p0[e] * sigmoid_f(a0[e]); y1[e] = p1[e] * sigmoid_f(a1[e]); }
                    *(u32x4*)(E + (size_t)row * 2048 + col0 + bj * HALF) = pack8(y0, y1); q += sumsq4(y0) + sumsq4(y1); }
                q += __shfl_xor(q, 16); q += __shfl_xor(q, 32);
                if (fq == 0) atomicAdd(ssout + row, q); }
    }
};

struct EpiPlain {
    static constexpr bool PERM = true, AFTER_DRAIN = false, MID = false, PREF = false;
    bf16_t* O; int ldo;
    __device__ __forceinline__ void mid(f32x4 (&)[2][2][4][2], const Unit&, int, int) const {}
    __device__ __forceinline__ void operator()(f32x4 (&acc)[2][2][4][2], const Unit& u, int wr, int wc, int fr, int fq) const {
        const int row0 = u.pm * BM + wr * 64 + fr, col0 = u.pn * BM + wc * 32 + 8 * fq;
#pragma unroll
        for (int ai = 0; ai < 2; ++ai)
#pragma unroll
            for (int m = 0; m < 4; ++m) { const int row = row0 + ai * HALF + m * 16;
#pragma unroll
                for (int bj = 0; bj < 2; ++bj) *(u32x4*)(O + (size_t)row * ldo + col0 + bj * HALF) = pack8(acc[ai][bj][m][0], acc[ai][bj][m][1]); }
    }
};
template <class Epi, class Sched, bool ALIGN_EPI = false, bool SP2 = false, bool ABLK = false>
__device__ __forceinline__ void gemm_phase(PG8_LAS unsigned char* lds, const Gemm g, const Sched& S, const Epi& E, const int wave_s) {
    unsigned ones_ = ~0u; asm volatile("" : "+s"(ones_));
    const int lane = (int)__builtin_amdgcn_mbcnt_hi(ones_, __builtin_amdgcn_mbcnt_lo(ones_, 0u)), wid = wave_s, tid = wid * 64 + lane, wr = wid >> 2, wc = wid & 3, fr = lane & 15, fq = lane >> 4;
    const int K = g.K, nt = g.KU / BK;
    unsigned voffA[2], voffB[2];
#pragma unroll
    for (int i = 0; i < 2; ++i) { int R, C; stage_rc(tid * 16 + i * 8192, R, C); const int Rb = Epi::PERM ? ((R & ~31) + perm32(R & 31)) : R;
        voffA[i] = ABLK ? (unsigned)(R * BK + C) * 2u : (unsigned)(R * K + C) * 2u; voffB[i] = (unsigned)(Rb * K + C) * 2u; }
    const size_t kstep = (size_t)(BK * 2);
    const size_t hstep = (size_t)HALF * K * 2;
    const size_t tstep = 2 * hstep;
    const size_t kstepA = ABLK ? (size_t)(BM * BK * 2) : kstep, hstepA = ABLK ? (size_t)(HALF * BK * 2) : hstep;
    const unsigned ldsw = (unsigned)wid * 1024u;
    const int aoff = lds_byte(wr * 64 + fr, fq * 8), boff = lds_byte(wc * 32 + fr, fq * 8);
#define PG8_SA(b, h) (((b) * 2 + (h)) * HTB)
#define PG8_SB(b, h) ((4 + (b) * 2 + (h)) * HTB)
#define PG8_STAGE(bufoff, gbase, voff) do { _Pragma("unroll") for (int _i = 0; _i < 2; ++_i) \
        __builtin_amdgcn_global_load_lds((const unsigned*)((const char*)(gbase) + (voff)[_i]), (PG8_LAS unsigned*)(lds + (bufoff) + ldsw + _i * 8192), 16, 0, 0); } while (0)
#define PG8_LDA(dst, b, h) do { _Pragma("unroll") for (int m = 0; m < 4; ++m) _Pragma("unroll") for (int k = 0; k < 2; ++k) dst[m][k] = *(const PG8_LAS bf16x8*)(lds + PG8_SA(b, h) + aoff + m * 2048 + k * 1024); } while (0)
#define PG8_LDB(dst, b, h) do { _Pragma("unroll") for (int n = 0; n < 2; ++n) _Pragma("unroll") for (int k = 0; k < 2; ++k) dst[n][k] = *(const PG8_LAS bf16x8*)(lds + PG8_SB(b, h) + boff + n * 2048 + k * 1024); } while (0)
#define PG8_MMA(ai, bj, At, Bt) do { __builtin_amdgcn_s_setprio(1); _Pragma("unroll") for (int m = 0; m < 4; ++m) _Pragma("unroll") for (int n = 0; n < 2; ++n) _Pragma("unroll") for (int k = 0; k < 2; ++k) \
        acc[ai][bj][m][n] = __builtin_amdgcn_mfma_f32_16x16x32_bf16(Bt[n][k], At[m][k], acc[ai][bj][m][n], 0, 0, 0); __builtin_amdgcn_s_setprio(0); } while (0)
#define PG8_WAIT_V(n) asm volatile("s_waitcnt vmcnt(" #n ")" ::: "memory")
#define PG8_WAIT_L(n) asm volatile("s_waitcnt lgkmcnt(" #n ")" ::: "memory")
#define PG8_BAR __builtin_amdgcn_s_barrier()
#define PG8_SCHED __builtin_amdgcn_sched_barrier(0)
    Unit cur, nxt; int ui = 0;
    if (!S.next(0, cur)) return;
    cur.par = 0;
    if constexpr (Epi::PREF) E.prefetch(cur, wid, lane);
    f32x4 acc[2][2][4][2];
#pragma unroll
    for (int a = 0; a < 2; ++a)
#pragma unroll
        for (int b = 0; b < 2; ++b)
#pragma unroll
            for (int m = 0; m < 4; ++m)
#pragma unroll
                for (int n = 0; n < 2; ++n) acc[a][b][m][n] = (f32x4){0.f, 0.f, 0.f, 0.f};
    bf16x8 At[4][2], B0[2][2], B1[2][2];
    const size_t khb = (size_t)g.KU * 2, khbA = ABLK ? (size_t)(g.KU / BK) * kstepA : khb; const char* cA = (const char*)g.A + (size_t)cur.pm * tstep + cur.kh * khbA; const char* cB = (const char*)g.Bt + (size_t)cur.pn * tstep + cur.kh * khb;
    S.a_ready(cur);
    if constexpr (SP2) {
        PG8_STAGE(PG8_SB(0, 0), cB, voffB); PG8_STAGE(PG8_SB(0, 1), cB + hstep, voffB); PG8_STAGE(PG8_SA(0, 0), cA, voffA); PG8_STAGE(PG8_SA(0, 1), cA + hstepA, voffA);
        if (wr == 1) PG8_BAR;
        PG8_WAIT_V(2); PG8_BAR;
        PG8_STAGE(PG8_SB(1, 0), cB + kstep, voffB); PG8_STAGE(PG8_SA(1, 0), cA + kstepA, voffA); PG8_STAGE(PG8_SB(1, 1), cB + hstep + kstep, voffB);
        PG8_WAIT_V(6); PG8_BAR;
    } else {
        PG8_STAGE(PG8_SB(0, 0), cB, voffB); PG8_STAGE(PG8_SA(0, 0), cA, voffA); PG8_STAGE(PG8_SB(0, 1), cB + hstep, voffB); PG8_STAGE(PG8_SA(0, 1), cA + hstepA, voffA);
        if (wr == 1) PG8_BAR;
        PG8_WAIT_V(4); PG8_BAR;
        PG8_STAGE(PG8_SB(1, 0), cB + kstep, voffB); PG8_STAGE(PG8_SA(1, 0), cA + kstepA, voffA); PG8_STAGE(PG8_SB(1, 1), cB + hstep + kstep, voffB);
        PG8_WAIT_V(6); PG8_BAR;
    }
    for (;;) {
        const bool has_next = S.next(ui + 1, nxt); nxt.par = (ui + 1) & 1;
        const char* nA = has_next ? (const char*)g.A + (size_t)nxt.pm * tstep + nxt.kh * khbA : cA; const char* nB = has_next ? (const char*)g.Bt + (size_t)nxt.pn * tstep + nxt.kh * khb : cB;
        for (int t = 0; t < nt; t += 2) {
            const bool last = (t == nt - 2);
            const char* a1 = cA + (size_t)(t + 1) * kstepA;
            const char* a2 = last ? nA : cA + (size_t)(t + 2) * kstepA; const char* b2 = last ? nB : cB + (size_t)(t + 2) * kstep;
            const char* a3 = a2 + kstepA; const char* b3 = b2 + kstep;
            if (last && has_next) { S.a_ready(nxt); if constexpr (Epi::PREF) E.prefetch(nxt, wid, lane); }
            if constexpr (SP2) {
            PG8_LDB(B0, 0, 0); PG8_LDB(B1, 0, 1); PG8_SCHED; PG8_LDA(At, 0, 0); PG8_STAGE(PG8_SA(1, 1), a1 + hstepA, voffA);
            PG8_WAIT_V(8); PG8_WAIT_L(0); PG8_BAR; PG8_MMA(0, 0, At, B0); PG8_MMA(0, 1, At, B1); PG8_BAR; PG8_SCHED;
            PG8_LDA(At, 0, 1); PG8_STAGE(PG8_SB(0, 0), b2, voffB); PG8_STAGE(PG8_SB(0, 1), b2 + hstep, voffB); PG8_STAGE(PG8_SA(0, 0), a2, voffA);
            PG8_WAIT_V(8); PG8_WAIT_L(0); PG8_BAR; PG8_MMA(1, 0, At, B0); PG8_MMA(1, 1, At, B1); PG8_BAR; PG8_SCHED;
            PG8_LDB(B0, 1, 0); PG8_LDB(B1, 1, 1); PG8_SCHED; PG8_LDA(At, 1, 0); PG8_STAGE(PG8_SA(0, 1), a2 + hstepA, voffA);
            PG8_WAIT_V(8); PG8_WAIT_L(0); PG8_BAR; PG8_MMA(0, 0, At, B0); PG8_MMA(0, 1, At, B1); PG8_BAR; PG8_SCHED;
            PG8_LDA(At, 1, 1); PG8_STAGE(PG8_SB(1, 0), b3, voffB); PG8_STAGE(PG8_SB(1, 1), b3 + hstep, voffB); PG8_STAGE(PG8_SA(1, 0), a3, voffA);
            PG8_WAIT_V(8); PG8_WAIT_L(0); PG8_BAR; PG8_MMA(1, 0, At, B0); PG8_MMA(1, 1, At, B1); PG8_BAR; PG8_SCHED;
            } else {
            PG8_LDB(B0, 0, 0); PG8_SCHED; PG8_LDA(At, 0, 0); PG8_STAGE(PG8_SA(1, 1), a1 + hstepA, voffA);
            PG8_WAIT_L(8); PG8_BAR; PG8_WAIT_L(0); PG8_MMA(0, 0, At, B0); PG8_BAR; PG8_SCHED;
            PG8_LDB(B1, 0, 1); PG8_STAGE(PG8_SB(0, 0), b2, voffB);
            PG8_BAR; PG8_WAIT_L(0); PG8_MMA(0, 1, At, B1); PG8_BAR;
            PG8_LDA(At, 0, 1); PG8_STAGE(PG8_SA(0, 0), a2, voffA);
            PG8_BAR; PG8_WAIT_L(0); PG8_MMA(1, 0, At, B0); PG8_BAR; PG8_SCHED;
            PG8_STAGE(PG8_SB(0, 1), b2 + hstep, voffB);
            PG8_WAIT_V(6); PG8_BAR; PG8_MMA(1, 1, At, B1); PG8_BAR;
            PG8_LDB(B0, 1, 0); PG8_SCHED; PG8_LDA(At, 1, 0); PG8_STAGE(PG8_SA(0, 1), a2 + hstepA, voffA);
            PG8_WAIT_L(8); PG8_BAR; PG8_WAIT_L(0); PG8_MMA(0, 0, At, B0); PG8_BAR; PG8_SCHED;
            PG8_LDB(B1, 1, 1); PG8_STAGE(PG8_SB(1, 0), b3, voffB);
            PG8_BAR; PG8_WAIT_L(0); PG8_MMA(0, 1, At, B1); PG8_BAR;
            PG8_LDA(At, 1, 1); PG8_STAGE(PG8_SA(1, 0), a3, voffA);
            PG8_BAR; PG8_WAIT_L(0); PG8_MMA(1, 0, At, B0); PG8_BAR; PG8_SCHED;
            PG8_STAGE(PG8_SB(1, 1), b3 + hstep, voffB);
            PG8_WAIT_V(6); PG8_BAR; PG8_MMA(1, 1, At, B1); PG8_BAR;
            }
        }
        if constexpr (ALIGN_EPI) { if (wr == 0) PG8_BAR; }
        if constexpr (!Epi::AFTER_DRAIN) { E(acc, cur, wr, wc, fr, fq); S.done(cur); }
        if (!has_next) break;
        if (!(Epi::MID && cur.kh == 0))
#pragma unroll
        for (int a = 0; a < 2; ++a)
#pragma unroll
            for (int b = 0; b < 2; ++b)
#pragma unroll
                for (int m = 0; m < 4; ++m)
#pragma unroll
                    for (int n = 0; n < 2; ++n) acc[a][b][m][n] = (f32x4){0.f, 0.f, 0.f, 0.f};
        cur = nxt; cA = nA; cB = nB; ++ui;
        if constexpr (ALIGN_EPI) { if (wr == 1) PG8_BAR; }
    }
    PG8_WAIT_V(0);
    if constexpr (!ALIGN_EPI) { if (wr == 0) PG8_BAR; }
    PG8_BAR;
    if constexpr (Epi::AFTER_DRAIN) { E.fused(acc, cur, wr, wc, fr, fq, lds, wid, lane); S.done(cur); }
#undef PG8_SA
#undef PG8_SB
#undef PG8_STAGE
#undef PG8_LDA
#undef PG8_LDB
#undef PG8_MMA
#undef PG8_WAIT_V
#undef PG8_WAIT_L
#undef PG8_BAR
#undef PG8_SCHED
}
}
constexpr int NWAVES = 8, NTHREADS = 512;
constexpr int DM = 2048, NB = 8, SEQ = 4096, MROWS = NB * SEQ, FF = 5632, PLE = 256;
constexpr int SSMW = 1024, NG = 64, GH = 16, NP = 64, SBW = 1024, NHEAD = 8, HD = 128, NIN = 4096;
constexpr size_t MiB = 1u << 20;
constexpr size_t WS_STAT = 0;
constexpr size_t WS_BAR = 960 * 1024;
constexpr int BAR_WORDS = 3456;
constexpr size_t WS_LAM8 = 1 * MiB;
constexpr size_t WS_SSMMAT = 2 * MiB;
constexpr size_t WS_WGU1 = 8 * MiB, WS_WD1 = 52 * MiB, WS_WIN = 74 * MiB, WS_WGLU = 90 * MiB, WS_WOUT = 92 * MiB, WS_WGU2 = 100 * MiB, WS_WD2 = 144 * MiB, WS_WPG = 166 * MiB, WS_WPP = 174 * MiB;
constexpr size_t WS_PB = 176 * MiB;
constexpr size_t WS_XB = 192 * MiB;
constexpr size_t WS_YMIX = 320 * MiB;
constexpr size_t WS_ACT = 448 * MiB;
constexpr size_t WS_UG = WS_ACT, WS_Q = WS_ACT + 64 * MiB, WS_K = WS_ACT + 128 * MiB, WS_V = WS_ACT + 192 * MiB, WS_Z = WS_ACT + 256 * MiB, WS_E = WS_ACT;
constexpr size_t WS_END = 800 * MiB;
enum { ST_SS1 = 0, ST_SS2, ST_SSM, ST_SB, ST_SS3, ST_SS4, ST_SSE, ST_N };
constexpr int RING_BYTES = 131072, XCH_OFF = RING_BYTES, LDS_BYTES = 147456;

#define GAS __attribute__((address_space(1)))
#define LAS __attribute__((address_space(3)))
typedef unsigned short bf16;
typedef unsigned v4u __attribute__((ext_vector_type(4)));
typedef unsigned v2u __attribute__((ext_vector_type(2)));
typedef float f32x4 __attribute__((ext_vector_type(4)));
typedef short bf16x8 __attribute__((ext_vector_type(8)));
#define LDS_WAIT() asm volatile("s_waitcnt lgkmcnt(0)" ::: "memory")
using pg8::cvt_pk_bf16;
__device__ __forceinline__ float wave_sum(float v) {
#pragma unroll
    for (int o = 1; o < 64; o <<= 1) v += __shfl_xor(v, o);
    return v;
}
__device__ __forceinline__ f32x4 mfma16(bf16x8 a, bf16x8 b, f32x4 c) { return __builtin_amdgcn_mfma_f32_16x16x32_bf16(a, b, c, 0, 0, 0); }

#ifndef MK_DUP
#define MK_DUP 0u
#endif
constexpr int P0_REP = 1 + (int)(MK_DUP & 1u), P4_REP = 1 + (int)((MK_DUP >> 4) & 1u);
__device__ __forceinline__ void tr_item(const float* W, int K, int N, const float* gain, bf16* WT, int k0, int n0, int dstrow, LAS float* scr, int lane) {
    const int c4 = lane & 15, r0 = lane >> 4;
#pragma unroll 4
    for (int i = 0; i < 16; ++i) { const int kk = 4 * i + r0; f32x4 v = *(const GAS f32x4*)(W + (size_t)(k0 + kk) * N + n0 + 4 * c4); if (gain) v = v * gain[k0 + kk];
        *(LAS f32x4*)(scr + kk * 64 + 4 * (c4 ^ (2 * ((kk >> 3) & 7)))) = v; }
    LDS_WAIT(); asm volatile("" ::: "memory");
    const int c = lane & 7;
#pragma unroll
    for (int ps = 0; ps < 2; ++ps) { const int ng = (lane >> 3) + 8 * ps; f32x4 v[8];
#pragma unroll
        for (int j = 0; j < 8; ++j) v[j] = *(const LAS f32x4*)(scr + (8 * c + j) * 64 + 4 * (ng ^ (2 * c)));
#pragma unroll
        for (int i = 0; i < 4; ++i) { v4u o; o.x = cvt_pk_bf16(v[0][i], v[1][i]); o.y = cvt_pk_bf16(v[2][i], v[3][i]); o.z = cvt_pk_bf16(v[4][i], v[5][i]); o.w = cvt_pk_bf16(v[6][i], v[7][i]);
            *(GAS v4u*)(WT + (size_t)(dstrow + 4 * ng + i) * K + k0 + 8 * c) = o; } }
    LDS_WAIT(); asm volatile("" ::: "memory");
}

struct In {
    const float *x, *p, *ffn1_norm, *ffn1_wg, *ffn1_wu, *ffn1_wd, *mix_norm, *w_in, *lam_re, *lam_im, *b_re, *b_im, *c_re, *c_im, *log_dt, *ssm_d, *w_glu, *b_glu, *q_norm, *k_norm,
        *on_ssm, *on_sb, *w_out, *ffn2_norm, *ffn2_wg, *ffn2_wu, *ffn2_wd, *ple_norm, *w_pg, *w_pp, *ple_post;
};

__device__ __forceinline__ void ssm_build(const In& in, unsigned char* ws, LAS unsigned char* lds, int g, int tid) {
    LAS float* PW = (LAS float*)lds;
    LAS float* CO = PW + 9 * 64 * 2;
    LAS float* CB = CO + 64 * 2;
    LAS float* KT = CB + 64 * 16 * 2;
    LAS float* CR = KT + 2048; LAS float* CI = CR + 1024;
    for (int i = tid; i < 1024; i += NTHREADS) { CR[i] = in.c_re[g * 1024 + i]; CI[i] = in.c_im[g * 1024 + i]; }
    if (tid < 64) {
        const int p = tid; const float dt = expf(in.log_dt[g]); const float lr = fminf(in.lam_re[g * 64 + p], -1e-4f), li = in.lam_im[g * 64 + p];
        const float a = lr * dt, th = li * dt; float s1, c1; sincosf(th, &s1, &c1); const float ea = expf(a);
        const float l1r = ea * c1, l1i = ea * s1;
        float pr = 1.f, pi = 0.f;
#pragma unroll
        for (int t = 0; t <= 8; ++t) { PW[(t * 64 + p) * 2] = pr; PW[(t * 64 + p) * 2 + 1] = pi; const float nr = pr * l1r - pi * l1i, ni = pr * l1i + pi * l1r; pr = nr; pi = ni; }
        float* l8 = (float*)(ws + WS_LAM8) + (g * 64 + p) * 2; l8[0] = PW[(8 * 64 + p) * 2]; l8[1] = PW[(8 * 64 + p) * 2 + 1];
        const float sh = sinf(0.5f * th); const float nr = expm1f(a) * c1 - 2.f * sh * sh, ni = l1i;
        const float den = 1.f / (lr * lr + li * li);
        CO[p * 2] = (nr * lr + ni * li) * den; CO[p * 2 + 1] = (ni * lr - nr * li) * den;
    }
    __syncthreads();
    for (int i = tid; i < 1024; i += NTHREADS) { const int p = i >> 4; const float br = in.b_re[g * 1024 + i], bi = in.b_im[g * 1024 + i], cr = CO[p * 2], ci = CO[p * 2 + 1];
        CB[i * 2] = cr * br - ci * bi; CB[i * 2 + 1] = cr * bi + ci * br; }
    __syncthreads();
    for (int i = tid; i < 2048; i += NTHREADS) { const int tau = i >> 8, h = (i >> 4) & 15, h2 = i & 15; float s = 0.f;
        for (int p = 0; p < 64; ++p) { const float cr = CR[h * 64 + p], ci = CI[h * 64 + p], pr = PW[(tau * 64 + p) * 2], pi = PW[(tau * 64 + p) * 2 + 1];
            const float wr = cr * pr - ci * pi, wi = cr * pi + ci * pr; s += wr * CB[(p * 16 + h2) * 2] - wi * CB[(p * 16 + h2) * 2 + 1]; }
        KT[i] = s; }
    __syncthreads();
    bf16* Ms = (bf16*)(ws + WS_SSMMAT) + (size_t)g * 3 * 16384; bf16* Mi = Ms + 16384; bf16* Mo = Mi + 16384;
    for (int i = tid; i < 16384; i += NTHREADS) { const int r = i >> 7, c = i & 127;
        { const int p = r & 63, s = c >> 4, h2 = c & 15; const float pr = PW[((7 - s) * 64 + p) * 2], pi = PW[((7 - s) * 64 + p) * 2 + 1], br = CB[(p * 16 + h2) * 2], bi = CB[(p * 16 + h2) * 2 + 1];
          const float v = (r < 64) ? (pr * br - pi * bi) : (pr * bi + pi * br); Ms[i] = (bf16)(cvt_pk_bf16(v, 0.f) & 0xffffu); }
        { const int t = r >> 4, h = r & 15, s = c >> 4, h2 = c & 15; float v = 0.f; if (s <= t) { v = KT[((t - s) * 16 + h) * 16 + h2]; if (r == c) v += in.ssm_d[g * 16 + h]; } Mi[i] = (bf16)(cvt_pk_bf16(v, 0.f) & 0xffffu); }
        { const int t = r >> 4, h = r & 15, p = c & 63; const float cr = CR[h * 64 + p], ci = CI[h * 64 + p], pr = PW[((t + 1) * 64 + p) * 2], pi = PW[((t + 1) * 64 + p) * 2 + 1];
          const float v = (c < 64) ? (cr * pr - ci * pi) : -(cr * pi + ci * pr); Mo[i] = (bf16)(cvt_pk_bf16(v, 0.f) & 0xffffu); }
    }
    __syncthreads();
}

__device__ __forceinline__ void p0_prologue(const In& in, float* out, unsigned char* ws, LAS unsigned char* lds, int tid, int lane, int wave) {
    const int G = gridDim.x, bx = blockIdx.x;
    if (bx == 0) { unsigned* bw = (unsigned*)(ws + WS_BAR); for (int i = tid; i < BAR_WORDS; i += NTHREADS) bw[i] = 0u; }
    for (int g = bx; g < NG; g += G) ssm_build(in, ws, lds, g, tid);
    { float* st = (float*)(ws + WS_STAT) + MROWS; for (int i = bx * NTHREADS + tid; i < (ST_N - 1) * MROWS; i += G * NTHREADS) st[i] = 0.f; }
    LAS float* scr = (LAS float*)(lds + wave * 16384);
    const int gw = bx * NWAVES + wave, NGW = G * NWAVES;
    constexpr int I_GU = (DM / 64) * (FF / 64), I_D = (FF / 64) * (DM / 64), I_IN = (DM / 64) * (NIN / 64), I_GLU = (SSMW / 64) * (SSMW / 64), I_SQ = (DM / 64) * (DM / 64), I_PP = (PLE / 64) * (DM / 64);
    constexpr int NITEMS = 4 * I_GU + 2 * I_D + I_IN + I_GLU + 2 * I_SQ + I_PP;
#define TR_ITEM(NI, Wp, Kd, Nd, gainp, dstoff, MODE) \
        if (r < (NI)) { const int nbk = (Nd) / 64, kb = r / nbk, nb = r % nbk, k0 = 64 * kb, n0 = 64 * nb; \
            const int dr = (MODE) == 0 ? n0 : (n0 / 128) * 256 + (n0 % 128) + ((MODE) == 2 ? 128 : 0); \
            tr_item((Wp), (Kd), (Nd), (gainp), (bf16*)(ws + (dstoff)), k0, n0, dr, scr, lane); continue; } r -= (NI);
    for (int it = gw; it < NITEMS * P0_REP; it += NGW) {
        int r = it % NITEMS;
        TR_ITEM(I_GU, in.ffn1_wg, DM, FF, in.ffn1_norm, WS_WGU1, 1)
        TR_ITEM(I_GU, in.ffn1_wu, DM, FF, in.ffn1_norm, WS_WGU1, 2)
        TR_ITEM(I_D, in.ffn1_wd, FF, DM, (const float*)nullptr, WS_WD1, 0)
        TR_ITEM(I_IN, in.w_in, DM, NIN, in.mix_norm, WS_WIN, 0)
        TR_ITEM(I_GLU, in.w_glu, SSMW, SSMW, (const float*)nullptr, WS_WGLU, 0)
        TR_ITEM(I_SQ, in.w_out, DM, DM, (k0 < 1024 ? in.on_ssm : in.on_sb - 1024), WS_WOUT, 0)
        TR_ITEM(I_GU, in.ffn2_wg, DM, FF, in.ffn2_norm, WS_WGU2, 1)
        TR_ITEM(I_GU, in.ffn2_wu, DM, FF, in.ffn2_norm, WS_WGU2, 2)
        TR_ITEM(I_D, in.ffn2_wd, FF, DM, (const float*)nullptr, WS_WD2, 0)
        TR_ITEM(I_SQ, in.w_pg, DM, DM, in.ple_norm, WS_WPG, 0)
        TR_ITEM(I_PP, in.w_pp, PLE, DM, (const float*)nullptr, WS_WPP, 0)
    }
#undef TR_ITEM
    { bf16* XB = (bf16*)(ws + WS_XB); float* ss1 = (float*)(ws + WS_STAT) + ST_SS1 * MROWS;
      for (int mm = gw; mm < MROWS * P0_REP; mm += NGW) { const int m = mm % MROWS; const GAS f32x4* xr = (const GAS f32x4*)(in.x + (size_t)m * DM) + lane; GAS v2u* o = (GAS v2u*)(XB + (size_t)m * DM) + lane; float s = 0.f;
#pragma unroll
          for (int j = 0; j < 8; ++j) { const f32x4 v = xr[64 * j]; s += (v.x * v.x + v.y * v.y) + (v.z * v.z + v.w * v.w); v2u w; w.x = cvt_pk_bf16(v.x, v.y); w.y = cvt_pk_bf16(v.z, v.w); o[64 * j] = w; }
          s = wave_sum(s); if (lane == 0) ss1[m] = s; } }
    { const GAS f32x4* ps = (const GAS f32x4*)in.p; GAS v2u* o = (GAS v2u*)(ws + WS_PB);
      for (int i = bx * NTHREADS + tid; i < MROWS * PLE / 4; i += G * NTHREADS) { const f32x4 v = ps[i]; v2u w; w.x = cvt_pk_bf16(v.x, v.y); w.y = cvt_pk_bf16(v.z, v.w); o[i] = w; } }
}

constexpr int SSM_DROW = 132, SSM_SROW = 136;
__device__ __forceinline__ void ssm_unit(unsigned char* ws, LAS unsigned char* lds, int b, int g, int lane, int wave) {
    const int r16 = lane & 15, q4 = lane >> 4;
    LAS float* DL = (LAS float*)lds; LAS bf16* S0 = (LAS bf16*)(lds + 64 * SSM_DROW * 4);
    const bf16* Ms = (const bf16*)(ws + WS_SSMMAT) + (size_t)g * 3 * 16384; const bf16* Mi = Ms + 16384; const bf16* Mo = Mi + 16384;
    bf16x8 aS[4], aI[4], aO[4];
#pragma unroll
    for (int ks = 0; ks < 4; ++ks) { const int o = (16 * wave + r16) * 128 + 32 * ks + 8 * q4; aS[ks] = *(const bf16x8*)(Ms + o); aI[ks] = *(const bf16x8*)(Mi + o); aO[ks] = *(const bf16x8*)(Mo + o); }
    const bf16* ug = (const bf16*)(ws + WS_UG) + (size_t)(b * 64 + g) * 4096 * 16;
    bf16* zb = (bf16*)(ws + WS_Z) + (size_t)b * 4096 * 1024 + g * 16;
    const float* l8 = (const float*)(ws + WS_LAM8) + (g * 64 + lane) * 2; const float l8r = l8[0], l8i = l8[1];
    float sre = 0.f, sim = 0.f;
    bf16x8 bu[4][4];
#define SSM_LOADU(SEG) do { _Pragma("unroll") for (int nt = 0; nt < 4; ++nt) { const int n = 64 * (SEG) + 16 * nt + r16; _Pragma("unroll") for (int ks = 0; ks < 4; ++ks) \
        bu[nt][ks] = *(const bf16x8*)(ug + (size_t)(n * 8 + 2 * ks + (q4 >> 1)) * 16 + 8 * (q4 & 1)); } } while (0)
    SSM_LOADU(0);
    for (int seg = 0; seg < 8; ++seg) {
        f32x4 ay[4];
#pragma unroll
        for (int nt = 0; nt < 4; ++nt) { f32x4 acc = {0.f, 0.f, 0.f, 0.f}, accy = {0.f, 0.f, 0.f, 0.f};
#pragma unroll
            for (int ks = 0; ks < 4; ++ks) { acc = mfma16(aS[ks], bu[nt][ks], acc); accy = mfma16(aI[ks], bu[nt][ks], accy); }
            *(LAS f32x4*)(DL + (16 * nt + r16) * SSM_DROW + 16 * wave + 4 * q4) = acc; ay[nt] = accy; }
        if (seg < 7) SSM_LOADU(seg + 1);
        __syncthreads();
        if (wave == 0) {
            for (int n = 0; n < 64; ++n) { S0[n * SSM_SROW + lane] = (bf16)(cvt_pk_bf16(sre, 0.f) & 0xffffu); S0[n * SSM_SROW + 64 + lane] = (bf16)(cvt_pk_bf16(sim, 0.f) & 0xffffu);
                const float dr = DL[n * SSM_DROW + lane], di = DL[n * SSM_DROW + 64 + lane];
                const float nr = l8r * sre - l8i * sim + dr, ni = l8r * sim + l8i * sre + di; sre = nr; sim = ni; }
        }
        __syncthreads();
#pragma unroll
        for (int nt = 0; nt < 4; ++nt) { const int n = 64 * seg + 16 * nt + r16; f32x4 acc = ay[nt];
#pragma unroll
            for (int ks = 0; ks < 4; ++ks) { const bf16x8 bs = *(const LAS bf16x8*)(S0 + (16 * nt + r16) * SSM_SROW + 32 * ks + 8 * q4); acc = mfma16(aO[ks], bs, acc); }
            f32x4 z;
#pragma unroll
            for (int e = 0; e < 4; ++e) { const float y = acc[e]; const float t = 1.5957691216057308f * (y + 0.044715f * y * y * y); z[e] = y * __builtin_amdgcn_rcpf(1.0f + __builtin_amdgcn_exp2f(-1.4426950408889634f * t)); }
            v2u w; w.x = cvt_pk_bf16(z[0], z[1]); w.y = cvt_pk_bf16(z[2], z[3]);
            *(v2u*)(zb + (size_t)(n * 8 + wave) * 1024 + 4 * q4) = w; }
    }
#undef SSM_LOADU
    __syncthreads();
}

constexpr int AT_KROW = 136, AT_VROW = 152, AT_SROW = 68, AT_PROW = 72;
constexpr int AT_KB = 64 * AT_KROW * 2, AT_VB = 64 * AT_VROW * 2, AT_BUF = AT_KB + AT_VB;
constexpr int AT_S_OFF = 2 * AT_BUF, AT_P_OFF = AT_S_OFF + 8 * 16 * AT_SROW * 4, AT_FLAG_OFF = AT_P_OFF + 8 * 16 * AT_PROW * 2;
static_assert(AT_FLAG_OFF + 64 <= RING_BYTES, "attention LDS");
constexpr float AT_THR = -152.0f;
typedef short s16x4 __attribute__((ext_vector_type(4)));
__device__ __forceinline__ s16x4 lds_tr(const LAS bf16* p) { return __builtin_bit_cast(s16x4, __builtin_amdgcn_ds_read_tr16_b64_v4i16((LAS s16x4*)p)); }
__device__ __forceinline__ void attn_unit(unsigned char* ws, LAS unsigned char* lds, int b, int h, int qb, int tid, int lane, int wave, bool do_ss) {
    const int r16 = lane & 15, q4 = lane >> 4;
    LAS float* Sw = (LAS float*)(lds + AT_S_OFF) + wave * 16 * AT_SROW; LAS bf16* Pw = (LAS bf16*)(lds + AT_P_OFF) + wave * 16 * AT_PROW;
    volatile LAS unsigned* flag = (volatile LAS unsigned*)(lds + AT_FLAG_OFF);
    const bf16* Qg = (const bf16*)(ws + WS_Q) + (size_t)b * SEQ * 1024 + h * 128;
    const bf16* Kg = (const bf16*)(ws + WS_K) + (size_t)b * SEQ * 1024 + h * 128;
    const bf16* Vg = (const bf16*)(ws + WS_V) + (size_t)b * SEQ * 1024 + h * 128;
    const int qw0 = 128 * qb + 16 * wave, qrow = qw0 + r16;
    bf16x8 qf[4];
#pragma unroll
    for (int ks = 0; ks < 4; ++ks) qf[ks] = *(const bf16x8*)(Qg + (size_t)qrow * 1024 + 32 * ks + 8 * q4);
    f32x4 o[8];
#pragma unroll
    for (int i = 0; i < 8; ++i) o[i] = (f32x4){0.f, 0.f, 0.f, 0.f};
    float carry = 0.f; bool done = false;
    const int pr0 = tid >> 4, pc = tid & 15;
    v4u kr[2], vr[2];
    int kt = 2 * qb + 1, buf = 0, it = 0;
#define AT_LOAD(KT) do { _Pragma("unroll") for (int i = 0; i < 2; ++i) { const size_t go = (size_t)(64 * (KT) + pr0 + 32 * i) * 1024 + 8 * pc; kr[i] = *(const v4u*)(Kg + go); vr[i] = *(const v4u*)(Vg + go); } } while (0)
#define AT_STAGE(B) do { _Pragma("unroll") for (int i = 0; i < 2; ++i) { const int row = pr0 + 32 * i; *(LAS v4u*)((LAS bf16*)(lds + (B) * AT_BUF) + row * AT_KROW + 8 * pc) = kr[i]; \
        *(LAS v4u*)((LAS bf16*)(lds + (B) * AT_BUF + AT_KB) + row * AT_VROW + 8 * pc) = vr[i]; } } while (0)
    AT_LOAD(kt); AT_STAGE(0);
    if (kt > 0) AT_LOAD(kt - 1);
    __syncthreads();
    for (;;) {
        const LAS bf16* Ks = (const LAS bf16*)(lds + buf * AT_BUF); const LAS bf16* Vs = (const LAS bf16*)(lds + buf * AT_BUF + AT_KB);
        const int j0 = 64 * kt;
        if (!done && j0 < qw0 + 15) {
#pragma unroll
            for (int t4 = 0; t4 < 4; ++t4) { f32x4 acc = {0.f, 0.f, 0.f, 0.f};
#pragma unroll
                for (int ks = 0; ks < 4; ++ks) { const bf16x8 ak = *(const LAS bf16x8*)(Ks + (16 * t4 + r16) * AT_KROW + 32 * ks + 8 * q4); acc = mfma16(ak, qf[ks], acc); }
                *(LAS f32x4*)(Sw + r16 * AT_SROW + 16 * t4 + 4 * q4) = acc; }
            LDS_WAIT(); __builtin_amdgcn_wave_barrier();
            float lk[16], ls[16];
#pragma unroll
            for (int c = 0; c < 4; ++c) { const f32x4 sv = *(const LAS f32x4*)(Sw + r16 * AT_SROW + 16 * q4 + 4 * c);
#pragma unroll
                for (int e = 0; e < 4; ++e) { const float z2 = sv[e]; const float az = __builtin_fabsf(z2); const float ex = __builtin_amdgcn_exp2f(-az); const float sp = fmaxf(z2, 0.f) + __builtin_amdgcn_logf(1.0f + ex);
                    const bool valid = (j0 + 16 * q4 + 4 * c + e) < qrow; lk[4 * c + e] = valid ? -sp : 0.f; ls[4 * c + e] = valid ? (z2 - sp) : -1.0e30f; } }
            float run = 0.f, ps[16];
#pragma unroll
            for (int i = 15; i >= 0; --i) { ps[i] = run; run += lk[i]; }
            const float t0 = __shfl(run, r16), t1 = __shfl(run, r16 + 16), t2 = __shfl(run, r16 + 32), t3 = __shfl(run, r16 + 48);
            const float offs = (q4 < 1 ? t1 : 0.f) + (q4 < 2 ? t2 : 0.f) + (q4 < 3 ? t3 : 0.f);
            const float base = carry + offs;
            float wv[16];
#pragma unroll
            for (int i = 0; i < 16; ++i) wv[i] = __builtin_amdgcn_exp2f(ls[i] + ps[i] + base);
            carry += (t0 + t1) + (t2 + t3);
            v4u p0, p1;
            p0.x = cvt_pk_bf16(wv[0], wv[1]); p0.y = cvt_pk_bf16(wv[2], wv[3]); p0.z = cvt_pk_bf16(wv[4], wv[5]); p0.w = cvt_pk_bf16(wv[6], wv[7]);
            p1.x = cvt_pk_bf16(wv[8], wv[9]); p1.y = cvt_pk_bf16(wv[10], wv[11]); p1.z = cvt_pk_bf16(wv[12], wv[13]); p1.w = cvt_pk_bf16(wv[14], wv[15]);
            *(LAS v4u*)(Pw + r16 * AT_PROW + 16 * q4) = p0; *(LAS v4u*)(Pw + r16 * AT_PROW + 16 * q4 + 8) = p1;
            LDS_WAIT(); __builtin_amdgcn_wave_barrier();
            bf16x8 bp[2];
#pragma unroll
            for (int ks = 0; ks < 2; ++ks) bp[ks] = *(const LAS bf16x8*)(Pw + r16 * AT_PROW + 32 * ks + 8 * q4);
            const LAS bf16* vb = Vs + (8 * q4 + (r16 >> 2)) * AT_VROW + 4 * (r16 & 3);
#pragma unroll
            for (int dt = 0; dt < 8; ++dt)
#pragma unroll
                for (int ks = 0; ks < 2; ++ks) { const s16x4 lo = lds_tr(vb + 32 * ks * AT_VROW + 16 * dt), hi = lds_tr(vb + (32 * ks + 4) * AT_VROW + 16 * dt);
                    const bf16x8 av = __builtin_shufflevector(lo, hi, 0, 1, 2, 3, 4, 5, 6, 7); o[dt] = mfma16(av, bp[ks], o[dt]); }
            done = __all(carry < AT_THR);
        }
        if (kt > 0) { AT_STAGE(buf ^ 1); if (kt > 1) AT_LOAD(kt - 2); }
        if (lane == 0) flag[(it & 1) * 8 + wave] = (!done && kt > 0) ? 1u : 0u;
        __syncthreads();
        unsigned any = 0;
#pragma unroll
        for (int i = 0; i < 8; ++i) any |= flag[(it & 1) * 8 + i];
        if (!any) break;
        --kt; buf ^= 1; ++it;
    }
#undef AT_LOAD
#undef AT_STAGE
    bf16* Y = (bf16*)(ws + WS_YMIX) + (size_t)(b * SEQ + qrow) * 2048 + 1024 + h * 128 + 4 * q4;
    float q = 0.f;
#pragma unroll
    for (int dt = 0; dt < 8; ++dt) { v2u w; w.x = cvt_pk_bf16(o[dt][0], o[dt][1]); w.y = cvt_pk_bf16(o[dt][2], o[dt][3]); *(v2u*)(Y + 16 * dt) = w; q += (o[dt][0] * o[dt][0] + o[dt][1] * o[dt][1]) + (o[dt][2] * o[dt][2] + o[dt][3] * o[dt][3]); }
    q += __shfl_xor(q, 16); q += __shfl_xor(q, 32);
    if (q4 == 0 && do_ss) atomicAdd((float*)(ws + WS_STAT) + ST_SB * MROWS + b * SEQ + qrow, q);
    __syncthreads();
}

#define XB_TMO      128
#define XB_XCNT(j)  (256  + 64 * (j))
#define XB_XSUB(j)  (1280 + 64 * (j))
#define XB_XGEN(j)  (2304 + 64 * (j))
#define XB_TOP      3328
#define XB_TOPGEN   3392
#define XCD_BAR_WORDS 3456
#define XB_SPIN_CAP (1u << 18)

__device__ __forceinline__ unsigned xb_ld(unsigned* p)              { return __hip_atomic_load(p, __ATOMIC_RELAXED, __HIP_MEMORY_SCOPE_AGENT); }
__device__ __forceinline__ unsigned xb_add(unsigned* p, unsigned v) { return __hip_atomic_fetch_add(p, v, __ATOMIC_RELAXED, __HIP_MEMORY_SCOPE_AGENT); }
__device__ __forceinline__ unsigned xb_xcc_id() { return (unsigned)__builtin_amdgcn_s_getreg((3 << 11) | 20) & 0xFu; }
#define XB_SPIN(cond, bar) do { unsigned _sp = 0; while (cond) { __builtin_amdgcn_s_sleep(1); \
    if ((++_sp & 255u) == 0u) { if (xb_ld(&(bar)[XB_TMO])) break; if (_sp > XB_SPIN_CAP) { atomicAdd(&(bar)[XB_TMO], 1u); break; } } } } while (0)

struct XcdBarrier {
    unsigned* bar; unsigned x;
    volatile LAS unsigned* st;
};

__device__ __forceinline__ XcdBarrier xcd_barrier_post(unsigned* bar, volatile LAS unsigned* st) {
    XcdBarrier b; b.bar = bar; b.x = xb_xcc_id(); b.st = st;
    if (threadIdx.x == 0) (void)xb_add(&bar[XB_XCNT(b.x)], 1u);
    return b;
}
__device__ __forceinline__ void xcd_barrier_complete(unsigned* bar, unsigned x, unsigned& nloc, unsigned& nx) {
    const unsigned G = gridDim.x * gridDim.y * gridDim.z;
    unsigned sum, cnt, mine, sp = 0u;
    for (;;) {
        sum = 0u; cnt = 0u; mine = 0u;
#pragma unroll
        for (unsigned j = 0; j < 16; ++j) { const unsigned c = xb_ld(&bar[XB_XCNT(j)]); sum += c; cnt += (c > 0u) ? 1u : 0u; mine = (j == x) ? c : mine; }
        if (sum == G) break;
        __builtin_amdgcn_s_sleep(1);
        if ((++sp & 255u) == 0u) { if (xb_ld(&bar[XB_TMO])) break; if (sp > XB_SPIN_CAP) { atomicAdd(&bar[XB_TMO], 1u); break; } }
    }
    nloc = mine > 0u ? mine : 1u; nx = cnt > 0u ? cnt : 1u;
}

__device__ __forceinline__ void xcd_barrier(const XcdBarrier& b) {
    asm volatile("s_waitcnt vmcnt(0)" ::: "memory");
    __syncthreads();
    if (threadIdx.x == 0) {
        unsigned* bar = b.bar;
        __builtin_amdgcn_s_waitcnt(0);
        unsigned nloc = b.st[0], nx = b.st[1];
        if (nloc == 0u) { xcd_barrier_complete(bar, b.x, nloc, nx); b.st[0] = nloc; b.st[1] = nx; }
        const unsigned old = xb_add(&bar[XB_XSUB(b.x)], 1u);
        const unsigned gen = old / nloc;
        if (old + 1u == (gen + 1u) * nloc) {
            __builtin_amdgcn_fence(__ATOMIC_RELEASE, "agent");
            asm volatile("s_waitcnt vmcnt(0)" ::: "memory");
            const unsigned og = xb_add(&bar[XB_TOP], 1u);
            const unsigned tg = og / nx;
            if (og + 1u == (tg + 1u) * nx) xb_add(&bar[XB_TOPGEN], 1u);
            else XB_SPIN(xb_ld(&bar[XB_TOPGEN]) == tg, bar);
            __builtin_amdgcn_fence(__ATOMIC_ACQUIRE, "agent");
            xb_add(&bar[XB_XGEN(b.x)], 1u);
            asm volatile("s_waitcnt vmcnt(0)" ::: "memory");
        } else {
            XB_SPIN(xb_ld(&bar[XB_XGEN(b.x)]) == gen, bar);
            __builtin_amdgcn_fence(__ATOMIC_ACQUIRE, "agent");
            asm volatile("s_waitcnt vmcnt(0)" ::: "memory");
        }
    }
    __syncthreads();
}

static_assert(BAR_WORDS == XCD_BAR_WORDS, "barrier words");
struct Args { const float* in[31]; float* out; unsigned char* ws; };
#ifndef MK_PHASE_MASK
#define MK_PHASE_MASK 0xFFFFFFFFu
#endif
__global__ void __launch_bounds__(NTHREADS, 2) mk_fwd(Args args) {
    extern __shared__ __attribute__((aligned(16))) unsigned char lds_raw[];
    LAS unsigned char* lds = (LAS unsigned char*)lds_raw;
    cg::grid_group grid = cg::this_grid();
    volatile LAS unsigned* bar_st = (volatile LAS unsigned*)(lds + XCH_OFF + 12288);
    if (threadIdx.x < 2) bar_st[threadIdx.x] = 0u;
    __syncthreads();
    const int wave_s = __builtin_amdgcn_readfirstlane(threadIdx.x >> 6);
#define FRESH_IDS unsigned ones_ = ~0u; asm volatile("" : "+s"(ones_)); const int lane = (int)__builtin_amdgcn_mbcnt_hi(ones_, __builtin_amdgcn_mbcnt_lo(ones_, 0u)), wave = wave_s, tid = wave * 64 + lane; (void)tid; (void)lane; (void)wave;
    const int G = gridDim.x, bx = blockIdx.x;
    unsigned char* ws = args.ws; float* out = args.out;
    In in;
    in.x = args.in[0]; in.p = args.in[1]; in.ffn1_norm = args.in[2]; in.ffn1_wg = args.in[3]; in.ffn1_wu = args.in[4]; in.ffn1_wd = args.in[5]; in.mix_norm = args.in[6]; in.w_in = args.in[7];
    in.lam_re = args.in[8]; in.lam_im = args.in[9]; in.b_re = args.in[10]; in.b_im = args.in[11]; in.c_re = args.in[12]; in.c_im = args.in[13]; in.log_dt = args.in[14]; in.ssm_d = args.in[15];
    in.w_glu = args.in[16]; in.b_glu = args.in[17]; in.q_norm = args.in[18]; in.k_norm = args.in[19]; in.on_ssm = args.in[20]; in.on_sb = args.in[21]; in.w_out = args.in[22];
    in.ffn2_norm = args.in[23]; in.ffn2_wg = args.in[24]; in.ffn2_wu = args.in[25]; in.ffn2_wd = args.in[26]; in.ple_norm = args.in[27]; in.w_pg = args.in[28]; in.w_pp = args.in[29]; in.ple_post = args.in[30];
    float* stat = (float*)(ws + WS_STAT);
    bf16* XB = (bf16*)(ws + WS_XB); bf16* ACT = (bf16*)(ws + WS_ACT); bf16* YMIX = (bf16*)(ws + WS_YMIX);
#define PH(k) ((MK_PHASE_MASK >> (k)) & 1u)
#ifndef MK_DUP
#define MK_DUP 0u
#endif
#define NREP(k) (1 + (int)((MK_DUP >> (k)) & 1u))

    { FRESH_IDS p0_prologue(in, out, ws, lds, tid, lane, wave); }
    grid.sync();
    const XcdBarrier xbar = xcd_barrier_post((unsigned*)(ws + WS_BAR), bar_st);
    for (int rep_ = 0; rep_ < NREP(1); ++rep_) { pg8::Gemm g{XB, (const bf16*)(ws + WS_WGU1), MROWS, 2 * FF, DM, DM}; pg8::StaticOrder S; S.init(MROWS, 2 * FF, G, bx);
        pg8::EpiSwiGLU E{ACT, stat + ST_SS1 * MROWS, FF, (LAS float*)(lds + XCH_OFF)}; pg8::gemm_phase<pg8::EpiSwiGLU, pg8::StaticOrder, true, true>(lds, g, S, E, wave_s); }
    xcd_barrier(xbar);
    for (int rep_ = 0; rep_ < NREP(2); ++rep_) { pg8::Gemm g{ACT, (const bf16*)(ws + WS_WD1), MROWS, DM, FF, FF}; pg8::StaticOrder S; S.init(MROWS, DM, G, bx);
        pg8::EpiResid<0, false> E{nullptr, XB, (rep_ + 1 < NREP(2)) ? nullptr : stat + ST_SS2 * MROWS, nullptr, nullptr}; pg8::gemm_phase<pg8::EpiResid<0, false>, pg8::StaticOrder, true, true, true>(lds, g, S, E, wave_s); }
    xcd_barrier(xbar);
    for (int rep_ = 0; rep_ < NREP(3); ++rep_) { pg8::Gemm g{XB, (const bf16*)(ws + WS_WIN), MROWS, NIN, DM, DM}; pg8::StaticOrder S; S.init(MROWS, NIN, G, bx);
        pg8::EpiWin E{stat + ST_SS2 * MROWS, (bf16*)(ws + WS_UG), (bf16*)(ws + WS_Q), (bf16*)(ws + WS_K), (bf16*)(ws + WS_V), in.q_norm, in.k_norm, (LAS float*)(lds + XCH_OFF)};
        pg8::gemm_phase<pg8::EpiWin, pg8::StaticOrder, true, true>(lds, g, S, E, wave_s); }
    xcd_barrier(xbar);
    { FRESH_IDS
        for (int itt = bx; itt < (512 + 2048) * P4_REP; itt += G) { const int it = itt % (512 + 2048);
            if (it < 512) ssm_unit(ws, lds, it >> 6, it & 63, lane, wave);
            else { const int a = it - 512; attn_unit(ws, lds, a >> 8, (a >> 5) & 7, a & 31, tid, lane, wave, itt >= (512 + 2048) * (P4_REP - 1)); }
        }
    }
    xcd_barrier(xbar);
    if (PH(5)) { pg8::Gemm g{(const bf16*)(ws + WS_Z), (const bf16*)(ws + WS_WGLU), MROWS, SSMW, SSMW, SSMW}; pg8::StaticOrder S; S.init(MROWS, SSMW, G, bx);
        pg8::EpiGlu E{(const bf16*)(ws + WS_Z), in.b_glu, YMIX, stat + ST_SSM * MROWS}; pg8::gemm_phase<pg8::EpiGlu, pg8::StaticOrder, true, true>(lds, g, S, E, wave_s); }
    xcd_barrier(xbar);
    if (PH(6)) { pg8::Gemm g{YMIX, (const bf16*)(ws + WS_WOUT), MROWS, DM, DM, DM / 2}; pg8::SplitOrder S; S.base.init(MROWS, DM, G, bx);
        pg8::EpiResid<1, false> E{nullptr, XB, stat + ST_SS3 * MROWS, stat + ST_SSM * MROWS, stat + ST_SB * MROWS}; pg8::gemm_phase<pg8::EpiResid<1, false>, pg8::SplitOrder, true, true>(lds, g, S, E, wave_s); }
    xcd_barrier(xbar);
    if (PH(7)) { pg8::Gemm g{XB, (const bf16*)(ws + WS_WGU2), MROWS, 2 * FF, DM, DM}; pg8::StaticOrder S; S.init(MROWS, 2 * FF, G, bx);
        pg8::EpiSwiGLU E{ACT, stat + ST_SS3 * MROWS, FF, (LAS float*)(lds + XCH_OFF)}; pg8::gemm_phase<pg8::EpiSwiGLU, pg8::StaticOrder, true, true>(lds, g, S, E, wave_s); }
    xcd_barrier(xbar);
    if (PH(8)) { pg8::Gemm g{ACT, (const bf16*)(ws + WS_WD2), MROWS, DM, FF, FF}; pg8::StaticOrder S; S.init(MROWS, DM, G, bx);
        pg8::EpiResid<0, false> E{nullptr, XB, stat + ST_SS4 * MROWS, nullptr, nullptr}; pg8::gemm_phase<pg8::EpiResid<0, false>, pg8::StaticOrder, true, true, true>(lds, g, S, E, wave_s); }
    xcd_barrier(xbar);
    if (PH(9)) { pg8::Gemm g{(const bf16*)(ws + WS_PB), (const bf16*)(ws + WS_WPP), MROWS, DM, PLE, PLE}; pg8::StaticOrder S; S.init(MROWS, DM, G, bx);
        pg8::EpiPlain E{YMIX, DM}; pg8::gemm_phase<pg8::EpiPlain, pg8::StaticOrder, true, true>(lds, g, S, E, wave_s); }
    asm volatile("s_waitcnt vmcnt(0)" ::: "memory"); __syncthreads();
    if (PH(10)) { pg8::Gemm g{XB, (const bf16*)(ws + WS_WPG), MROWS, DM, DM, DM}; pg8::StaticOrder S; S.init(MROWS, DM, G, bx);
        pg8::EpiPle E{YMIX, stat + ST_SS4 * MROWS, (bf16*)(ws + WS_E), stat + ST_SSE * MROWS}; pg8::gemm_phase<pg8::EpiPle, pg8::StaticOrder, true, true>(lds, g, S, E, wave_s); }
    xcd_barrier(xbar);
    if (PH(11)) { FRESH_IDS const bf16* E = (const bf16*)(ws + WS_E); const float* sse = stat + ST_SSE * MROWS; const int gw = bx * NWAVES + wave, NGW = G * NWAVES;
        for (int m = gw; m < MROWS; m += NGW) { const float r = pg8::rstd_of(sse[m], 1.0f / 2048.0f); GAS f32x4* xr = (GAS f32x4*)(out + (size_t)m * DM) + lane; const GAS v2u* xbr = (const GAS v2u*)(XB + (size_t)m * DM) + lane; const GAS v2u* er = (const GAS v2u*)(E + (size_t)m * DM) + lane;
            const GAS f32x4* gp = (const GAS f32x4*)in.ple_post + lane;
#pragma unroll
            for (int j = 0; j < 8; ++j) { const v2u xw = xbr[64 * j]; const v2u w = er[64 * j]; const f32x4 gg = gp[64 * j]; f32x4 v;
                v.x = pg8::bf_lo(xw.x) + pg8::bf_lo(w.x) * r * gg.x; v.y = pg8::bf_hi(xw.x) + pg8::bf_hi(w.x) * r * gg.y; v.z = pg8::bf_lo(xw.y) + pg8::bf_lo(w.y) * r * gg.z; v.w = pg8::bf_hi(xw.y) + pg8::bf_hi(w.y) * r * gg.w; xr[64 * j] = v; } } }
#undef PH
}

extern "C" void kernel_launch(void* const* d_in, const int* in_sizes, int n_in, void* d_out, int out_size, void* d_ws, size_t ws_size, hipStream_t stream) {
    static int grid = 0;
    if (grid == 0) {
        if (n_in != 31 || out_size != MROWS * DM || ws_size < WS_END) { fprintf(stderr, "kernel_launch: unexpected shapes (n_in %d, out %d, ws %zu)\n", n_in, out_size, ws_size); grid = -1; return; }
        int dev = 0, cus = 0, per_cu = 0;
        hipGetDevice(&dev); hipDeviceGetAttribute(&cus, hipDeviceAttributeMultiprocessorCount, dev);
        if (hipFuncSetAttribute((const void*)mk_fwd, hipFuncAttributeMaxDynamicSharedMemorySize, LDS_BYTES) != hipSuccess) { fprintf(stderr, "kernel_launch: hipFuncSetAttribute failed\n"); grid = -1; return; }
        if (hipOccupancyMaxActiveBlocksPerMultiprocessor(&per_cu, (const void*)mk_fwd, NTHREADS, LDS_BYTES) != hipSuccess || per_cu < 1) { fprintf(stderr, "kernel_launch: occupancy query gives %d\n", per_cu); per_cu = 1; }
        (void)hipGetLastError();
        grid = cus * 1;
    }
    if (grid < 0) return;
    Args a{};
    for (int i = 0; i < 31; ++i) a.in[i] = (const float*)d_in[i];
    a.out = (float*)d_out; a.ws = (unsigned char*)d_ws;
    void* kargs[] = {&a};
    hipError_t e = hipLaunchCooperativeKernel((const void*)mk_fwd, dim3(grid), dim3(NTHREADS), kargs, LDS_BYTES, stream);
    if (e != hipSuccess) fprintf(stderr, "kernel_launch: cooperative launch failed: %s (grid %d)\n", hipGetErrorString(e), grid);
}
```

```cpp
#include <hip/hip_runtime.h>
#include <hip/hip_cooperative_groups.h>
#include <cstdio>
#include <cstdint>
namespace cg = cooperative_groups;
namespace pg8 {
#define PG8_LAS __attribute__((address_space(3)))
typedef unsigned short bf16_t;
typedef short bf16x8 __attribute__((ext_vector_type(8)));
typedef float f32x4 __attribute__((ext_vector_type(4)));
typedef unsigned u32x4 __attribute__((ext_vector_type(4)));
constexpr int BM = 256, BK = 64, HALF = 128, HTB = HALF * BK * 2  , STAGE_BYTES = 8 * HTB, NXCD = 8, WGM = 8;

__host__ __device__ __forceinline__ int lds_byte(int r, int c) { const int st = (r >> 4) * 2 + (c >> 5), rr = r & 15, cc = c & 31, ob = rr * 64 + cc * 2; return st * 1024 + (ob ^ (((ob >> 9) & 1) << 5)); }
__host__ __device__ __forceinline__ void stage_rc(int b, int& R, int& C) { const int st = b / 1024, sb = b % 1024, swz = sb ^ (((sb >> 9) & 1) << 5); R = (st >> 1) * 16 + swz / 64; C = (st & 1) * 32 + (swz % 64) / 2; }
__host__ __device__ __forceinline__ int perm32(int rho) { const int n = rho >> 4, i = rho & 15; return 8 * (i >> 2) + 4 * n + (i & 3); }

struct Unit { int pm, pn, kh, par; };
struct Gemm { const bf16_t* A; const bf16_t* Bt; int M, N, K, KU; };

struct StaticOrder {
    int nM, nN, nwg, G, c;
    __host__ __device__ void init(int M, int N, int G_, int c_) { nM = M / BM; nN = N / BM; nwg = nM * nN; G = G_; c = c_; }
    __host__ __device__ bool next(int i, Unit& u) const {
        const long L = (long)i * G + c; if (L >= nwg) return false;
        int wgid = (int)L; { const int q = nwg / NXCD, r = nwg % NXCD, xcd = wgid % NXCD, off = wgid / NXCD; wgid = (xcd < r ? xcd * (q + 1) : r * (q + 1) + (xcd - r) * q) + off; }
        const int nig = WGM * nN, gid = wgid / nig, fm = gid * WGM, gsz = (nM - fm) < WGM ? (nM - fm) : WGM;
        u.pm = fm + ((wgid % nig) % gsz); u.pn = (wgid % nig) / gsz; u.kh = 0; return true;
    }
    __device__ __forceinline__ void a_ready(const Unit&) const {}
    __device__ __forceinline__ void done(const Unit&) const {}
};

__device__ __forceinline__ unsigned cvt_pk_bf16(float lo, float hi) { unsigned r; asm volatile("v_cvt_pk_bf16_f32 %0, %1, %2" : "=v"(r) : "v"(lo), "v"(hi)); return r; }
struct SplitOrder {
    StaticOrder base;
    __device__ bool next(int i, Unit& u) const { const bool r = base.next(i >> 1, u); u.kh = i & 1; return r; }
    __device__ __forceinline__ void a_ready(const Unit&) const {}
    __device__ __forceinline__ void done(const Unit&) const {}
};
typedef float f32x2 __attribute__((ext_vector_type(2)));
__device__ __forceinline__ float rstd_of(float ss, float inv_n) { return __builtin_amdgcn_rsqf(ss * inv_n + 1e-6f); }
__device__ __forceinline__ float sigmoid_f(float v) { return __builtin_amdgcn_rcpf(1.0f + __builtin_amdgcn_exp2f(-1.4426950408889634f * v)); }
__device__ __forceinline__ float bf_lo(unsigned w) { return __uint_as_float(w << 16); }
__device__ __forceinline__ float bf_hi(unsigned w) { return __uint_as_float(w & 0xffff0000u); }
__device__ __forceinline__ u32x4 pack8(const f32x4 a, const f32x4 b) { u32x4 w; w.x = cvt_pk_bf16(a[0], a[1]); w.y = cvt_pk_bf16(a[2], a[3]); w.z = cvt_pk_bf16(b[0], b[1]); w.w = cvt_pk_bf16(b[2], b[3]); return w; }
__device__ __forceinline__ float sumsq4(const f32x4 a) { return (a[0] * a[0] + a[1] * a[1]) + (a[2] * a[2] + a[3] * a[3]); }

struct EpiSwiGLU {
    static constexpr bool PERM = true, AFTER_DRAIN = false, MID = false, PREF = true;
    bf16_t* O; const float* ss; int ldo; PG8_LAS float* sl;
    __device__ __forceinline__ void prefetch(const Unit& u, int wid, int lane) const {
        if (wid < 4) __builtin_amdgcn_global_load_lds((const unsigned*)(ss + u.pm * BM + 64 * wid + lane), (PG8_LAS unsigned*)(sl + u.par * 256 + 64 * wid), 4, 0, 0);
    }
    __device__ __forceinline__ void operator()(f32x4 (&acc)[2][2][4][2], const Unit& u, int wr, int wc, int fr, int fq) const {
        const int row0 = u.pm * BM + wr * 64 + fr, col0 = u.pn * HALF + wc * 32 + 8 * fq;
#pragma unroll
        for (int ai = 0; ai < 2; ++ai)
#pragma unroll
            for (int m = 0; m < 4; ++m) {
                const int row = row0 + ai * HALF + m * 16; const float r = rstd_of(sl[u.par * 256 + ai * HALF + wr * 64 + m * 16 + fr], 1.0f / 2048.0f);
                f32x4 o[2];
#pragma unroll
                for (int n = 0; n < 2; ++n) { const f32x4 g = acc[ai][0][m][n] * r, uu = acc[ai][1][m][n] * r;
#pragma unroll
                    for (int e = 0; e < 4; ++e) o[n][e] = g[e] * uu[e] * sigmoid_f(g[e]); }
                *(u32x4*)(O + (((size_t)u.pm * (ldo / 64) + (col0 >> 6)) * BM + (ai * HALF + wr * 64 + m * 16 + fr)) * 64 + (col0 & 63)) = pack8(o[0], o[1]);
            }
    }
    __device__ __forceinline__ void mid(f32x4 (&)[2][2][4][2], const Unit&, int, int) const {}
};

template <int MODE, bool XF32> struct EpiResid {
    static constexpr bool PERM = true, AFTER_DRAIN = false, MID = (MODE == 1), PREF = false;
    const float* xin; bf16_t* xb; float* ssout; const float* ssa; const float* ssb;
    __device__ __forceinline__ void mid(f32x4 (&acc)[2][2][4][2], const Unit& u, int wr, int fr) const {
        {
            const int row0 = u.pm * BM + wr * 64 + fr;
#pragma unroll
            for (int ai = 0; ai < 2; ++ai)
#pragma unroll
                for (int m = 0; m < 4; ++m) { const int row = row0 + ai * HALF + m * 16;
                    const float ra = rstd_of(ssa[row], 1.0f / 1024.0f), rb = rstd_of(ssb[row], 1.0f / 1024.0f), ratio = ra * __builtin_amdgcn_rcpf(rb);
#pragma unroll
                    for (int bj = 0; bj < 2; ++bj)
#pragma unroll
                        for (int n = 0; n < 2; ++n) acc[ai][bj][m][n] = acc[ai][bj][m][n] * ratio;
                    asm volatile("" ::: "memory"); }
        }
    }
    __device__ __forceinline__ void operator()(f32x4 (&acc)[2][2][4][2], const Unit& u, int wr, int wc, int fr, int fq) const {
        if (MODE == 1 && u.kh == 0) { mid(acc, u, wr, fr); return; }
        const int row0 = u.pm * BM + wr * 64 + fr, col0 = u.pn * BM + wc * 32 + 8 * fq;
        u32x4 xw[2][4][2]; f32x4 xf[XF32 ? 16 : 1][2];
#pragma unroll
        for (int ai = 0; ai < 2; ++ai)
#pragma unroll
            for (int m = 0; m < 4; ++m)
#pragma unroll
                for (int bj = 0; bj < 2; ++bj) { const size_t off = (size_t)(row0 + ai * HALF + m * 16) * 2048 + col0 + bj * HALF;
                    if constexpr (XF32) { xf[(ai * 4 + m) * 2 + bj][0] = *(const f32x4*)(xin + off); xf[(ai * 4 + m) * 2 + bj][1] = *(const f32x4*)(xin + off + 4); }
                    else xw[ai][m][bj] = *(const u32x4*)(xb + off); }
#pragma unroll
        for (int ai = 0; ai < 2; ++ai)
#pragma unroll
            for (int m = 0; m < 4; ++m) {
                const int row = row0 + ai * HALF + m * 16; const size_t off = (size_t)row * 2048 + col0;
                float sc = 0.5f; if constexpr (MODE == 1) sc = rstd_of(ssb[row], 1.0f / 1024.0f);
                float q = 0.f;
#pragma unroll
                for (int bj = 0; bj < 2; ++bj) {
                    f32x4 x0, x1;
                    if constexpr (XF32) { x0 = xf[(ai * 4 + m) * 2 + bj][0]; x1 = xf[(ai * 4 + m) * 2 + bj][1]; }
                    else { const u32x4 w = xw[ai][m][bj]; x0 = (f32x4){bf_lo(w.x), bf_hi(w.x), bf_lo(w.y), bf_hi(w.y)}; x1 = (f32x4){bf_lo(w.z), bf_hi(w.z), bf_lo(w.w), bf_hi(w.w)}; }
                    const f32x4 v0 = x0 + acc[ai][bj][m][0] * sc, v1 = x1 + acc[ai][bj][m][1] * sc;
                    *(u32x4*)(xb + off + bj * HALF) = pack8(v0, v1);
                    q += sumsq4(v0) + sumsq4(v1);
                }
                q += __shfl_xor(q, 16); q += __shfl_xor(q, 32);
                if (fq == 0 && ssout) atomicAdd(ssout + row, q);
            }
    }
};

struct EpiWin {
    static constexpr bool PERM = true, AFTER_DRAIN = false, MID = false, PREF = false;
    const float* ss; bf16_t *UG, *Q, *K, *V; const float *gq, *gk; PG8_LAS float* xch;
    __device__ __forceinline__ void mid(f32x4 (&)[2][2][4][2], const Unit&, int, int) const {}
    __device__ __forceinline__ void operator()(f32x4 (&acc)[2][2][4][2], const Unit& u, int wr, int wc, int fr, int fq) const {
        const int row0 = u.pm * BM + wr * 64 + fr, seg = u.pn >> 2, lc0 = (u.pn & 3) * BM + wc * 32 + 8 * fq; const float* ssr = ss + row0;
        if (seg == 0) {
#pragma unroll
            for (int ai = 0; ai < 2; ++ai)
#pragma unroll
                for (int m = 0; m < 4; ++m) { const float r = rstd_of(ssr[ai * HALF + m * 16], 1.0f / 2048.0f); const int row = row0 + ai * HALF + m * 16, b = row >> 12, t = row & 4095;
#pragma unroll
                    for (int bj = 0; bj < 2; ++bj) { const int col = lc0 + bj * HALF, g = col >> 4, half = (col >> 3) & 1;
                        *(u32x4*)(UG + ((size_t)((b * 64 + g) * 4096 + t) * 16 + 8 * half)) = pack8(acc[ai][bj][m][0] * r, acc[ai][bj][m][1] * r); } }
        } else if (seg == 3) {
#pragma unroll
            for (int ai = 0; ai < 2; ++ai)
#pragma unroll
                for (int m = 0; m < 4; ++m) { const float r = rstd_of(ssr[ai * HALF + m * 16], 1.0f / 2048.0f); const int row = row0 + ai * HALF + m * 16;
#pragma unroll
                    for (int bj = 0; bj < 2; ++bj) *(u32x4*)(V + (size_t)row * 1024 + lc0 + bj * HALF) = pack8(acc[ai][bj][m][0] * r, acc[ai][bj][m][1] * r); }
        } else {
#pragma unroll
            for (int ai = 0; ai < 2; ++ai)
#pragma unroll
                for (int m = 0; m < 4; ++m) { const int rl = ai * HALF + wr * 64 + m * 16 + fr;
#pragma unroll
                    for (int bj = 0; bj < 2; ++bj) { float q = sumsq4(acc[ai][bj][m][0]) + sumsq4(acc[ai][bj][m][1]); q += __shfl_xor(q, 16); q += __shfl_xor(q, 32);
                        if (fq == 0) xch[rl * 8 + bj * 4 + wc] = q; } }
            asm volatile("s_waitcnt lgkmcnt(0)" ::: "memory"); __builtin_amdgcn_s_barrier(); asm volatile("" ::: "memory");
            const float* gain = (seg == 1) ? gq : gk; bf16_t* dst = (seg == 1) ? Q : K;
            const float osc = (seg == 1) ? (0.08838834764831845f * 1.4426950408889634f) : 1.0f;
            const int d0 = wc * 32 + 8 * fq;
            const f32x4 g0 = *(const f32x4*)(gain + d0) * osc, g1 = *(const f32x4*)(gain + d0 + 4) * osc;
#pragma unroll
            for (int ai = 0; ai < 2; ++ai)
#pragma unroll
                for (int m = 0; m < 4; ++m) { const int rl = ai * HALF + wr * 64 + m * 16 + fr, row = u.pm * BM + rl;
                    const float epr = 1e-6f * (ssr[ai * HALF + m * 16] * (1.0f / 2048.0f) + 1e-6f);
#pragma unroll
                    for (int bj = 0; bj < 2; ++bj) { const f32x4 p = *(const PG8_LAS f32x4*)(xch + rl * 8 + bj * 4);
                        const float rq = __builtin_amdgcn_rsqf(((p[0] + p[1]) + (p[2] + p[3])) * (1.0f / 128.0f) + epr);
                        *(u32x4*)(dst + (size_t)row * 1024 + lc0 + bj * HALF) = pack8(acc[ai][bj][m][0] * g0 * rq, acc[ai][bj][m][1] * g1 * rq); } }
        }
    }
};

struct EpiGlu {
    static constexpr bool PERM = true, AFTER_DRAIN = false, MID = false, PREF = false;
    const bf16_t* Z; const float* bias; bf16_t* Y; float* ssout;
    __device__ __forceinline__ void mid(f32x4 (&)[2][2][4][2], const Unit&, int, int) const {}
    __device__ __forceinline__ void operator()(f32x4 (&acc)[2][2][4][2], const Unit& u, int wr, int wc, int fr, int fq) const {
        const int row0 = u.pm * BM + wr * 64 + fr, col0 = u.pn * BM + wc * 32 + 8 * fq;
        f32x4 bv[2][2];
#pragma unroll
        for (int bj = 0; bj < 2; ++bj)
#pragma unroll
            for (int n = 0; n < 2; ++n) bv[bj][n] = *(const f32x4*)(bias + col0 + bj * HALF + 4 * n);
        u32x4 zw[2][4][2];
#pragma unroll
        for (int ai = 0; ai < 2; ++ai)
#pragma unroll
            for (int m = 0; m < 4; ++m)
#pragma unroll
                for (int bj = 0; bj < 2; ++bj) zw[ai][m][bj] = *(const u32x4*)(Z + (size_t)(row0 + ai * HALF + m * 16) * 1024 + col0 + bj * HALF);
#pragma unroll
        for (int ai = 0; ai < 2; ++ai)
#pragma unroll
            for (int m = 0; m < 4; ++m) { const int row = row0 + ai * HALF + m * 16; float q = 0.f;
#pragma unroll
                for (int bj = 0; bj < 2; ++bj) { const u32x4 zb = zw[ai][m][bj];
                    const f32x4 z0 = {bf_lo(zb.x), bf_hi(zb.x), bf_lo(zb.y), bf_hi(zb.y)}, z1 = {bf_lo(zb.z), bf_hi(zb.z), bf_lo(zb.w), bf_hi(zb.w)};
                    const f32x4 a0 = acc[ai][bj][m][0] + bv[bj][0], a1 = acc[ai][bj][m][1] + bv[bj][1]; f32x4 y0, y1;
#pragma unroll
                    for (int e = 0; e < 4; ++e) { y0[e] = z0[e] * sigmoid_f(a0[e]); y1[e] = z1[e] * sigmoid_f(a1[e]); }
                    *(u32x4*)(Y + (size_t)row * 2048 + col0 + bj * HALF) = pack8(y0, y1); q += sumsq4(y0) + sumsq4(y1); }
                q += __shfl_xor(q, 16); q += __shfl_xor(q, 32);
                if (fq == 0) atomicAdd(ssout + row, q); }
    }
};

struct EpiPle {
    static constexpr bool PERM = true, AFTER_DRAIN = false, MID = false, PREF = false;
    const bf16_t* PP; const float* ss; bf16_t* E; float* ssout;
    __device__ __forceinline__ void mid(f32x4 (&)[2][2][4][2], const Unit&, int, int) const {}
    __device__ __forceinline__ void operator()(f32x4 (&acc)[2][2][4][2], const Unit& u, int wr, int wc, int fr, int fq) const {
        const int row0 = u.pm * BM + wr * 64 + fr, col0 = u.pn * BM + wc * 32 + 8 * fq;
        u32x4 pw[2][4][2];
#pragma unroll
        for (int ai = 0; ai < 2; ++ai)
#pragma unroll
            for (int m = 0; m < 4; ++m)
#pragma unroll
                for (int bj = 0; bj < 2; ++bj) pw[ai][m][bj] = *(const u32x4*)(PP + (size_t)(row0 + ai * HALF + m * 16) * 2048 + col0 + bj * HALF);
#pragma unroll
        for (int ai = 0; ai < 2; ++ai)
#pragma unroll
            for (int m = 0; m < 4; ++m) { const int row = row0 + ai * HALF + m * 16; const float r = rstd_of(ss[row], 1.0f / 2048.0f); float q = 0.f;
#pragma unroll
                for (int bj = 0; bj < 2; ++bj) { const u32x4 pb = pw[ai][m][bj];
                    const f32x4 p0 = {bf_lo(pb.x), bf_hi(pb.x), bf_lo(pb.y), bf_hi(pb.y)}, p1 = {bf_lo(pb.z), bf_hi(pb.z), bf_lo(pb.w), bf_hi(pb.w)};
                    const f32x4 a0 = acc[ai][bj][m][0] * r, a1 = acc[ai][bj][m][1] * r; f32x4 y0, y1;
#pragma unroll
                    for (int e = 0; e < 4; ++e) { y0[e] = p0[e] * sigmoid_f(a0[e]); y1[e] = p1[e] * sigmoid_f(a1[e]); }
                    *(u32x4*)(E + (size_t)row * 2048 + col0 + bj * HALF) = pack8(y0, y1); q += sumsq4(y0) + sumsq4(y1); }
                q += __shfl_xor(q, 16); q += __shfl_xor(q, 32);
                if (fq == 0) atomicAdd(ssout + row, q); }
    }
};

struct EpiPlain {
    static constexpr bool PERM = true, AFTER_DRAIN = false, MID = false, PREF = false;
    bf16_t* O; int ldo;
    __device__ __forceinline__ void mid(f32x4 (&)[2][2][4][2], const Unit&, int, int) const {}
    __device__ __forceinline__ void operator()(f32x4 (&acc)[2][2][4][2], const Unit& u, int wr, int wc, int fr, int fq) const {
        const int row0 = u.pm * BM + wr * 64 + fr, col0 = u.pn * BM + wc * 32 + 8 * fq;
#pragma unroll
        for (int ai = 0; ai < 2; ++ai)
#pragma unroll
            for (int m = 0; m < 4; ++m) { const int row = row0 + ai * HALF + m * 16;
#pragma unroll
                for (int bj = 0; bj < 2; ++bj) *(u32x4*)(O + (size_t)row * ldo + col0 + bj * HALF) = pack8(acc[ai][bj][m][0], acc[ai][bj][m][1]); }
    }
};
template <class Epi, class Sched, bool ALIGN_EPI = false, bool SP2 = false, bool ABLK = false>
__device__ __forceinline__ void gemm_phase(PG8_LAS unsigned char* lds, const Gemm g, const Sched& S, const Epi& E, const int wave_s) {
    unsigned ones_ = ~0u; asm volatile("" : "+s"(ones_));
    const int lane = (int)__builtin_amdgcn_mbcnt_hi(ones_, __builtin_amdgcn_mbcnt_lo(ones_, 0u)), wid = wave_s, tid = wid * 64 + lane, wr = wid >> 2, wc = wid & 3, fr = lane & 15, fq = lane >> 4;
    const int K = g.K, nt = g.KU / BK;
    unsigned voffA[2], voffB[2];
#pragma unroll
    for (int i = 0; i < 2; ++i) { int R, C; stage_rc(tid * 16 + i * 8192, R, C); const int Rb = Epi::PERM ? ((R & ~31) + perm32(R & 31)) : R;
        voffA[i] = ABLK ? (unsigned)(R * BK + C) * 2u : (unsigned)(R * K + C) * 2u; voffB[i] = (unsigned)(Rb * K + C) * 2u; }
    const size_t kstep = (size_t)(BK * 2);
    const size_t hstep = (size_t)HALF * K * 2;
    const size_t tstep = 2 * hstep;
    const size_t kstepA = ABLK ? (size_t)(BM * BK * 2) : kstep, hstepA = ABLK ? (size_t)(HALF * BK * 2) : hstep;
    const unsigned ldsw = (unsigned)wid * 1024u;
    const int aoff = lds_byte(wr * 64 + fr, fq * 8), boff = lds_byte(wc * 32 + fr, fq * 8);
#define PG8_SA(b, h) (((b) * 2 + (h)) * HTB)
#define PG8_SB(b, h) ((4 + (b) * 2 + (h)) * HTB)
#define PG8_STAGE(bufoff, gbase, voff) do { _Pragma("unroll") for (int _i = 0; _i < 2; ++_i) \
        __builtin_amdgcn_global_load_lds((const unsigned*)((const char*)(gbase) + (voff)[_i]), (PG8_LAS unsigned*)(lds + (bufoff) + ldsw + _i * 8192), 16, 0, 0); } while (0)
#define PG8_LDA(dst, b, h) do { _Pragma("unroll") for (int m = 0; m < 4; ++m) _Pragma("unroll") for (int k = 0; k < 2; ++k) dst[m][k] = *(const PG8_LAS bf16x8*)(lds + PG8_SA(b, h) + aoff + m * 2048 + k * 1024); } while (0)
#define PG8_LDB(dst, b, h) do { _Pragma("unroll") for (int n = 0; n < 2; ++n) _Pragma("unroll") for (int k = 0; k < 2; ++k) dst[n][k] = *(const PG8_LAS bf16x8*)(lds + PG8_SB(b, h) + boff + n * 2048 + k * 1024); } while (0)
#define PG8_MMA(ai, bj, At, Bt) do { __builtin_amdgcn_s_setprio(1); _Pragma("unroll") for (int m = 0; m < 4; ++m) _Pragma("unroll") for (int n = 0; n < 2; ++n) _Pragma("unroll") for (int k = 0; k < 2; ++k) \
        acc[ai][bj][m][n] = __builtin_amdgcn_mfma_f32_16x16x32_bf16(Bt[n][k], At[m][k], acc[ai][bj][m][n], 0, 0, 0); __builtin_amdgcn_s_setprio(0); } while (0)
#define PG8_WAIT_V(n) asm volatile("s_waitcnt vmcnt(" #n ")" ::: "memory")
#define PG8_WAIT_L(n) asm volatile("s_waitcnt lgkmcnt(" #n ")" ::: "memory")
#define PG8_BAR __builtin_amdgcn_s_barrier()
#define PG8_SCHED __builtin_amdgcn_sched_barrier(0)
    Unit cur, nxt; int ui = 0;
    if (!S.next(0, cur)) return;
    cur.par = 0;
    if constexpr (Epi::PREF) E.prefetch(cur, wid, lane);
    f32x4 acc[2][2][4][2];
#pragma unroll
    for (int a = 0; a < 2; ++a)
#pragma unroll
        for (int b = 0; b < 2; ++b)
#pragma unroll
            for (int m = 0; m < 4; ++m)
#pragma unroll
                for (int n = 0; n < 2; ++n) acc[a][b][m][n] = (f32x4){0.f, 0.f, 0.f, 0.f};
    bf16x8 At[4][2], B0[2][2], B1[2][2];
    const size_t khb = (size_t)g.KU * 2, khbA = ABLK ? (size_t)(g.KU / BK) * kstepA : khb; const char* cA = (const char*)g.A + (size_t)cur.pm * tstep + cur.kh * khbA; const char* cB = (const char*)g.Bt + (size_t)cur.pn * tstep + cur.kh * khb;
    S.a_ready(cur);
    if constexpr (SP2) {
        PG8_STAGE(PG8_SB(0, 0), cB, voffB); PG8_STAGE(PG8_SB(0, 1), cB + hstep, voffB); PG8_STAGE(PG8_SA(0, 0), cA, voffA); PG8_STAGE(PG8_SA(0, 1), cA + hstepA, voffA);
        if (wr == 1) PG8_BAR;
        PG8_WAIT_V(2); PG8_BAR;
        PG8_STAGE(PG8_SB(1, 0), cB + kstep, voffB); PG8_STAGE(PG8_SA(1, 0), cA + kstepA, voffA); PG8_STAGE(PG8_SB(1, 1), cB + hstep + kstep, voffB);
        PG8_WAIT_V(6); PG8_BAR;
    } else {
        PG8_STAGE(PG8_SB(0, 0), cB, voffB); PG8_STAGE(PG8_SA(0, 0), cA, voffA); PG8_STAGE(PG8_SB(0, 1), cB + hstep, voffB); PG8_STAGE(PG8_SA(0, 1), cA + hstepA, voffA);
        if (wr == 1) PG8_BAR;
        PG8_WAIT_V(4); PG8_BAR;
        PG8_STAGE(PG8_SB(1, 0), cB + kstep, voffB); PG8_STAGE(PG8_SA(1, 0), cA + kstepA, voffA); PG8_STAGE(PG8_SB(1, 1), cB + hstep + kstep, voffB);
        PG8_WAIT_V(6); PG8_BAR;
    }
    for (;;) {
        const bool has_next = S.next(ui + 1, nxt); nxt.par = (ui + 1) & 1;
        const char* nA = has_next ? (const char*)g.A + (size_t)nxt.pm * tstep + nxt.kh * khbA : cA; const char* nB = has_next ? (const char*)g.Bt + (size_t)nxt.pn * tstep + nxt.kh * khb : cB;
        for (int t = 0; t < nt; t += 2) {
            const bool last = (t == nt - 2);
            const char* a1 = cA + (size_t)(t + 1) * kstepA;
            const char* a2 = last ? nA : cA + (size_t)(t + 2) * kstepA; const char* b2 = last ? nB : cB + (size_t)(t + 2) * kstep;
            const char* a3 = a2 + kstepA; const char* b3 = b2 + kstep;
            if (last && has_next) { S.a_ready(nxt); if constexpr (Epi::PREF) E.prefetch(nxt, wid, lane); }
            if constexpr (SP2) {
            PG8_LDB(B0, 0, 0); PG8_LDB(B1, 0, 1); PG8_SCHED; PG8_LDA(At, 0, 0); PG8_STAGE(PG8_SA(1, 1), a1 + hstepA, voffA);
            PG8_WAIT_V(8); PG8_WAIT_L(0); PG8_BAR; PG8_MMA(0, 0, At, B0); PG8_MMA(0, 1, At, B1); PG8_BAR; PG8_SCHED;
            PG8_LDA(At, 0, 1); PG8_STAGE(PG8_SB(0, 0), b2, voffB); PG8_STAGE(PG8_SB(0, 1), b2 + hstep, voffB); PG8_STAGE(PG8_SA(0, 0), a2, voffA);
            PG8_WAIT_V(8); PG8_WAIT_L(0); PG8_BAR; PG8_MMA(1, 0, At, B0); PG8_MMA(1, 1, At, B1); PG8_BAR; PG8_SCHED;
            PG8_LDB(B0, 1, 0); PG8_LDB(B1, 1, 1); PG8_SCHED; PG8_LDA(At, 1, 0); PG8_STAGE(PG8_SA(0, 1), a2 + hstepA, voffA);
            PG8_WAIT_V(8); PG8_WAIT_L(0); PG8_BAR; PG8_MMA(0, 0, At, B0); PG8_MMA(0, 1, At, B1); PG8_BAR; PG8_SCHED;
            PG8_LDA(At, 1, 1); PG8_STAGE(PG8_SB(1, 0), b3, voffB); PG8_STAGE(PG8_SB(1, 1), b3 + hstep, voffB); PG8_STAGE(PG8_SA(1, 0), a3, voffA);
            PG8_WAIT_V(8); PG8_WAIT_L(0); PG8_BAR; PG8_MMA(1, 0, At, B0); PG8_MMA(1, 1, At, B1); PG8_BAR; PG8_SCHED;
            } else {
            PG8_LDB(B0, 0, 0); PG8_SCHED; PG8_LDA(At, 0, 0); PG8_STAGE(PG8_SA(1, 1), a1 + hstepA, voffA);
            PG8_WAIT_L(8); PG8_BAR; PG8_WAIT_L(0); PG8_MMA(0, 0, At, B0); PG8_BAR; PG8_SCHED;
            PG8_LDB(B1, 0, 1); PG8_STAGE(PG8_SB(0, 0), b2, voffB);
            PG8_BAR; PG8_WAIT_L(0); PG8_MMA(0, 1, At, B1); PG8_BAR;
            PG8_LDA(At, 0, 1); PG8_STAGE(PG8_SA(0, 0), a2, voffA);
            PG8_BAR; PG8_WAIT_L(0); PG8_MMA(1, 0, At, B0); PG8_BAR; PG8_SCHED;
            PG8_STAGE(PG8_SB(0, 1), b2 + hstep, voffB);
            PG8_WAIT_V(6); PG8_BAR; PG8_MMA(1, 1, At, B1); PG8_BAR;
            PG8_LDB(B0, 1, 0); PG8_SCHED; PG8_LDA(At, 1, 0); PG8_STAGE(PG8_SA(0, 1), a2 + hstepA, voffA);
            PG8_WAIT_L(8); PG8_BAR; PG8_WAIT_L(0); PG8_MMA(0, 0, At, B0); PG8_BAR; PG8_SCHED;
            PG8_LDB(B1, 1, 1); PG8_STAGE(PG8_SB(1, 0), b3, voffB);
            PG8_BAR; PG8_WAIT_L(0); PG8_MMA(0, 1, At, B1); PG8_BAR;
            PG8_LDA(At, 1, 1); PG8_STAGE(PG8_SA(1, 0), a3, voffA);
            PG8_BAR; PG8_WAIT_L(0); PG8_MMA(1, 0, At, B0); PG8_BAR; PG8_SCHED;
            PG8_STAGE(PG8_SB(1, 1), b3 + hstep, voffB);
            PG8_WAIT_V(6); PG8_BAR; PG8_MMA(1, 1, At, B1); PG8_BAR;
            }
        }
        if constexpr (ALIGN_EPI) { if (wr == 0) PG8_BAR; }
        if constexpr (!Epi::AFTER_DRAIN) { E(acc, cur, wr, wc, fr, fq); S.done(cur); }
        if (!has_next) break;
        if (!(Epi::MID && cur.kh == 0))
#pragma unroll
        for (int a = 0; a < 2; ++a)
#pragma unroll
            for (int b = 0; b < 2; ++b)
#pragma unroll
                for (int m = 0; m < 4; ++m)
#pragma unroll
                    for (int n = 0; n < 2; ++n) acc[a][b][m][n] = (f32x4){0.f, 0.f, 0.f, 0.f};
        cur = nxt; cA = nA; cB = nB; ++ui;
        if constexpr (ALIGN_EPI) { if (wr == 1) PG8_BAR; }
    }
    PG8_WAIT_V(0);
    if constexpr (!ALIGN_EPI) { if (wr == 0) PG8_BAR; }
    PG8_BAR;
    if constexpr (Epi::AFTER_DRAIN) { E.fused(acc, cur, wr, wc, fr, fq, lds, wid, lane); S.done(cur); }
#undef PG8_SA
#undef PG8_SB
#undef PG8_STAGE
#undef PG8_LDA
#undef PG8_LDB
#undef PG8_MMA
#undef PG8_WAIT_V
#undef PG8_WAIT_L
#undef PG8_BAR
#undef PG8_SCHED
}
}
constexpr int NWAVES = 8, NTHREADS = 512;
constexpr int DM = 2048, NB = 8, SEQ = 4096, MROWS = NB * SEQ, FF = 5632, PLE = 256;
constexpr int SSMW = 1024, NG = 64, GH = 16, NP = 64, SBW = 1024, NHEAD = 8, HD = 128, NIN = 4096;
constexpr size_t MiB = 1u << 20;
constexpr size_t WS_STAT = 0;
constexpr size_t WS_BAR = 960 * 1024;
constexpr int BAR_WORDS = 3456;
constexpr size_t WS_LAM8 = 1 * MiB;
constexpr size_t WS_SSMMAT = 2 * MiB;
constexpr size_t WS_WGU1 = 8 * MiB, WS_WD1 = 52 * MiB, WS_WIN = 74 * MiB, WS_WGLU = 90 * MiB, WS_WOUT = 92 * MiB, WS_WGU2 = 100 * MiB, WS_WD2 = 144 * MiB, WS_WPG = 166 * MiB, WS_WPP = 174 * MiB;
constexpr size_t WS_PB = 176 * MiB;
constexpr size_t WS_XB = 192 * MiB;
constexpr size_t WS_YMIX = 320 * MiB;
constexpr size_t WS_ACT = 448 * MiB;
constexpr size_t WS_UG = WS_ACT, WS_Q = WS_ACT + 64 * MiB, WS_K = WS_ACT + 128 * MiB, WS_V = WS_ACT + 192 * MiB, WS_Z = WS_ACT + 256 * MiB, WS_E = WS_ACT;
constexpr size_t WS_END = 800 * MiB;
enum { ST_SS1 = 0, ST_SS2, ST_SSM, ST_SB, ST_SS3, ST_SS4, ST_SSE, ST_N };
constexpr int RING_BYTES = 131072, XCH_OFF = RING_BYTES, LDS_BYTES = 147456;

#define GAS __attribute__((address_space(1)))
#define LAS __attribute__((address_space(3)))
typedef unsigned short bf16;
typedef unsigned v4u __attribute__((ext_vector_type(4)));
typedef unsigned v2u __attribute__((ext_vector_type(2)));
typedef float f32x4 __attribute__((ext_vector_type(4)));
typedef short bf16x8 __attribute__((ext_vector_type(8)));
#define LDS_WAIT() asm volatile("s_waitcnt lgkmcnt(0)" ::: "memory")
using pg8::cvt_pk_bf16;
__device__ __forceinline__ float wave_sum(float v) {
#pragma unroll
    for (int o = 1; o < 64; o <<= 1) v += __shfl_xor(v, o);
    return v;
}
__device__ __forceinline__ f32x4 mfma16(bf16x8 a, bf16x8 b, f32x4 c) { return __builtin_amdgcn_mfma_f32_16x16x32_bf16(a, b, c, 0, 0, 0); }

#ifndef MK_DUP
#define MK_DUP 0u
#endif
constexpr int P0_REP = 1 + (int)(MK_DUP & 1u), P4_REP = 1 + (int)((MK_DUP >> 4) & 1u);
__device__ __forceinline__ void tr_item(const float* W, int K, int N, const float* gain, bf16* WT, int k0, int n0, int dstrow, LAS float* scr, int lane) {
    const int c4 = lane & 15, r0 = lane >> 4;
#pragma unroll 4
    for (int i = 0; i < 16; ++i) { const int kk = 4 * i + r0; f32x4 v = *(const GAS f32x4*)(W + (size_t)(k0 + kk) * N + n0 + 4 * c4); if (gain) v = v * gain[k0 + kk];
        *(LAS f32x4*)(scr + kk * 64 + 4 * (c4 ^ (2 * ((kk >> 3) & 7)))) = v; }
    LDS_WAIT(); asm volatile("" ::: "memory");
    const int c = lane & 7;
#pragma unroll
    for (int ps = 0; ps < 2; ++ps) { const int ng = (lane >> 3) + 8 * ps; f32x4 v[8];
#pragma unroll
        for (int j = 0; j < 8; ++j) v[j] = *(const LAS f32x4*)(scr + (8 * c + j) * 64 + 4 * (ng ^ (2 * c)));
#pragma unroll
        for (int i = 0; i < 4; ++i) { v4u o; o.x = cvt_pk_bf16(v[0][i], v[1][i]); o.y = cvt_pk_bf16(v[2][i], v[3][i]); o.z = cvt_pk_bf16(v[4][i], v[5][i]); o.w = cvt_pk_bf16(v[6][i], v[7][i]);
            *(GAS v4u*)(WT + (size_t)(dstrow + 4 * ng + i) * K + k0 + 8 * c) = o; } }
    LDS_WAIT(); asm volatile("" ::: "memory");
}

struct In {
    const float *x, *p, *ffn1_norm, *ffn1_wg, *ffn1_wu, *ffn1_wd, *mix_norm, *w_in, *lam_re, *lam_im, *b_re, *b_im, *c_re, *c_im, *log_dt, *ssm_d, *w_glu, *b_glu, *q_norm, *k_norm,
        *on_ssm, *on_sb, *w_out, *ffn2_norm, *ffn2_wg, *ffn2_wu, *ffn2_wd, *ple_norm, *w_pg, *w_pp, *ple_post;
};

__device__ __forceinline__ void ssm_build(const In& in, unsigned char* ws, LAS unsigned char* lds, int g, int tid) {
    LAS float* PW = (LAS float*)lds;
    LAS float* CO = PW + 9 * 64 * 2;
    LAS float* CB = CO + 64 * 2;
    LAS float* KT = CB + 64 * 16 * 2;
    LAS float* CR = KT + 2048; LAS float* CI = CR + 1024;
    for (int i = tid; i < 1024; i += NTHREADS) { CR[i] = in.c_re[g * 1024 + i]; CI[i] = in.c_im[g * 1024 + i]; }
    if (tid < 64) {
        const int p = tid; const float dt = expf(in.log_dt[g]); const float lr = fminf(in.lam_re[g * 64 + p], -1e-4f), li = in.lam_im[g * 64 + p];
        const float a = lr * dt, th = li * dt; float s1, c1; sincosf(th, &s1, &c1); const float ea = expf(a);
        const float l1r = ea * c1, l1i = ea * s1;
        float pr = 1.f, pi = 0.f;
#pragma unroll
        for (int t = 0; t <= 8; ++t) { PW[(t * 64 + p) * 2] = pr; PW[(t * 64 + p) * 2 + 1] = pi; const float nr = pr * l1r - pi * l1i, ni = pr * l1i + pi * l1r; pr = nr; pi = ni; }
        float* l8 = (float*)(ws + WS_LAM8) + (g * 64 + p) * 2; l8[0] = PW[(8 * 64 + p) * 2]; l8[1] = PW[(8 * 64 + p) * 2 + 1];
        const float sh = sinf(0.5f * th); const float nr = expm1f(a) * c1 - 2.f * sh * sh, ni = l1i;
        const float den = 1.f / (lr * lr + li * li);
        CO[p * 2] = (nr * lr + ni * li) * den; CO[p * 2 + 1] = (ni * lr - nr * li) * den;
    }
    __syncthreads();
    for (int i = tid; i < 1024; i += NTHREADS) { const int p = i >> 4; const float br = in.b_re[g * 1024 + i], bi = in.b_im[g * 1024 + i], cr = CO[p * 2], ci = CO[p * 2 + 1];
        CB[i * 2] = cr * br - ci * bi; CB[i * 2 + 1] = cr * bi + ci * br; }
    __syncthreads();
    for (int i = tid; i < 2048; i += NTHREADS) { const int tau = i >> 8, h = (i >> 4) & 15, h2 = i & 15; float s = 0.f;
        for (int p = 0; p < 64; ++p) { const float cr = CR[h * 64 + p], ci = CI[h * 64 + p], pr = PW[(tau * 64 + p) * 2], pi = PW[(tau * 64 + p) * 2 + 1];
            const float wr = cr * pr - ci * pi, wi = cr * pi + ci * pr; s += wr * CB[(p * 16 + h2) * 2] - wi * CB[(p * 16 + h2) * 2 + 1]; }
        KT[i] = s; }
    __syncthreads();
    bf16* Ms = (bf16*)(ws + WS_SSMMAT) + (size_t)g * 3 * 16384; bf16* Mi = Ms + 16384; bf16* Mo = Mi + 16384;
    for (int i = tid; i < 16384; i += NTHREADS) { const int r = i >> 7, c = i & 127;
        { const int p = r & 63, s = c >> 4, h2 = c & 15; const float pr = PW[((7 - s) * 64 + p) * 2], pi = PW[((7 - s) * 64 + p) * 2 + 1], br = CB[(p * 16 + h2) * 2], bi = CB[(p * 16 + h2) * 2 + 1];
          const float v = (r < 64) ? (pr * br - pi * bi) : (pr * bi + pi * br); Ms[i] = (bf16)(cvt_pk_bf16(v, 0.f) & 0xffffu); }
        { const int t = r >> 4, h = r & 15, s = c >> 4, h2 = c & 15; float v = 0.f; if (s <= t) { v = KT[((t - s) * 16 + h) * 16 + h2]; if (r == c) v += in.ssm_d[g * 16 + h]; } Mi[i] = (bf16)(cvt_pk_bf16(v, 0.f) & 0xffffu); }
        { const int t = r >> 4, h = r & 15, p = c & 63; const float cr = CR[h * 64 + p], ci = CI[h * 64 + p], pr = PW[((t + 1) * 64 + p) * 2], pi = PW[((t + 1) * 64 + p) * 2 + 1];
          const float v = (c < 64) ? (cr * pr - ci * pi) : -(cr * pi + ci * pr); Mo[i] = (bf16)(cvt_pk_bf16(v, 0.f) & 0xffffu); }
    }
    __syncthreads();
}

__device__ __forceinline__ void p0_prologue(const In& in, float* out, unsigned char* ws, LAS unsigned char* lds, int tid, int lane, int wave) {
    const int G = gridDim.x, bx = blockIdx.x;
    if (bx == 0) { unsigned* bw = (unsigned*)(ws + WS_BAR); for (int i = tid; i < BAR_WORDS; i += NTHREADS) bw[i] = 0u; }
    for (int g = bx; g < NG; g += G) ssm_build(in, ws, lds, g, tid);
    { float* st = (float*)(ws + WS_STAT) + MROWS; for (int i = bx * NTHREADS + tid; i < (ST_N - 1) * MROWS; i += G * NTHREADS) st[i] = 0.f; }
    LAS float* scr = (LAS float*)(lds + wave * 16384);
    const int gw = bx * NWAVES + wave, NGW = G * NWAVES;
    constexpr int I_GU = (DM / 64) * (FF / 64), I_D = (FF / 64) * (DM / 64), I_IN = (DM / 64) * (NIN / 64), I_GLU = (SSMW / 64) * (SSMW / 64), I_SQ = (DM / 64) * (DM / 64), I_PP = (PLE / 64) * (DM / 64);
    constexpr int NITEMS = 4 * I_GU + 2 * I_D + I_IN + I_GLU + 2 * I_SQ + I_PP;
#define TR_ITEM(NI, Wp, Kd, Nd, gainp, dstoff, MODE) \
        if (r < (NI)) { const int nbk = (Nd) / 64, kb = r / nbk, nb = r % nbk, k0 = 64 * kb, n0 = 64 * nb; \
            const int dr = (MODE) == 0 ? n0 : (n0 / 128) * 256 + (n0 % 128) + ((MODE) == 2 ? 128 : 0); \
            tr_item((Wp), (Kd), (Nd), (gainp), (bf16*)(ws + (dstoff)), k0, n0, dr, scr, lane); continue; } r -= (NI);
    for (int it = gw; it < NITEMS * P0_REP; it += NGW) {
        int r = it % NITEMS;
        TR_ITEM(I_GU, in.ffn1_wg, DM, FF, in.ffn1_norm, WS_WGU1, 1)
        TR_ITEM(I_GU, in.ffn1_wu, DM, FF, in.ffn1_norm, WS_WGU1, 2)
        TR_ITEM(I_D, in.ffn1_wd, FF, DM, (const float*)nullptr, WS_WD1, 0)
        TR_ITEM(I_IN, in.w_in, DM, NIN, in.mix_norm, WS_WIN, 0)
        TR_ITEM(I_GLU, in.w_glu, SSMW, SSMW, (const float*)nullptr, WS_WGLU, 0)
        TR_ITEM(I_SQ, in.w_out, DM, DM, (k0 < 1024 ? in.on_ssm : in.on_sb - 1024), WS_WOUT, 0)
        TR_ITEM(I_GU, in.ffn2_wg, DM, FF, in.ffn2_norm, WS_WGU2, 1)
        TR_ITEM(I_GU, in.ffn2_wu, DM, FF, in.ffn2_norm, WS_WGU2, 2)
        TR_ITEM(I_D, in.ffn2_wd, FF, DM, (const float*)nullptr, WS_WD2, 0)
        TR_ITEM(I_SQ, in.w_pg, DM, DM, in.ple_norm, WS_WPG, 0)
        TR_ITEM(I_PP, in.w_pp, PLE, DM, (const float*)nullptr, WS_WPP, 0)
    }
#undef TR_ITEM
    { bf16* XB = (bf16*)(ws + WS_XB); float* ss1 = (float*)(ws + WS_STAT) + ST_SS1 * MROWS;
      for (int mm = gw; mm < MROWS * P0_REP; mm += NGW) { const int m = mm % MROWS; const GAS f32x4* xr = (const GAS f32x4*)(in.x + (size_t)m * DM) + lane; GAS v2u* o = (GAS v2u*)(XB + (size_t)m * DM) + lane; float s = 0.f;
#pragma unroll
          for (int j = 0; j < 8; ++j) { const f32x4 v = xr[64 * j]; s += (v.x * v.x + v.y * v.y) + (v.z * v.z + v.w * v.w); v2u w; w.x = cvt_pk_bf16(v.x, v.y); w.y = cvt_pk_bf16(v.z, v.w); o[64 * j] = w; }
          s = wave_sum(s); if (lane == 0) ss1[m] = s; } }
    { const GAS f32x4* ps = (const GAS f32x4*)in.p; GAS v2u* o = (GAS v2u*)(ws + WS_PB);
      for (int i = bx * NTHREADS + tid; i < MROWS * PLE / 4; i += G * NTHREADS) { const f32x4 v = ps[i]; v2u w; w.x = cvt_pk_bf16(v.x, v.y); w.y = cvt_pk_bf16(v.z, v.w); o[i] = w; } }
}

constexpr int SSM_DROW = 132, SSM_SROW = 136;
__device__ __forceinline__ void ssm_unit(unsigned char* ws, LAS unsigned char* lds, int b, int g, int lane, int wave) {
    const int r16 = lane & 15, q4 = lane >> 4;
    LAS float* DL = (LAS float*)lds; LAS bf16* S0 = (LAS bf16*)(lds + 64 * SSM_DROW * 4);
    const bf16* Ms = (const bf16*)(ws + WS_SSMMAT) + (size_t)g * 3 * 16384; const bf16* Mi = Ms + 16384; const bf16* Mo = Mi + 16384;
    bf16x8 aS[4], aI[4], aO[4];
#pragma unroll
    for (int ks = 0; ks < 4; ++ks) { const int o = (16 * wave + r16) * 128 + 32 * ks + 8 * q4; aS[ks] = *(const bf16x8*)(Ms + o); aI[ks] = *(const bf16x8*)(Mi + o); aO[ks] = *(const bf16x8*)(Mo + o); }
    const bf16* ug = (const bf16*)(ws + WS_UG) + (size_t)(b * 64 + g) * 4096 * 16;
    bf16* zb = (bf16*)(ws + WS_Z) + (size_t)b * 4096 * 1024 + g * 16;
    const float* l8 = (const float*)(ws + WS_LAM8) + (g * 64 + lane) * 2; const float l8r = l8[0], l8i = l8[1];
    float sre = 0.f, sim = 0.f;
    bf16x8 bu[4][4];
#define SSM_LOADU(SEG) do { _Pragma("unroll") for (int nt = 0; nt < 4; ++nt) { const int n = 64 * (SEG) + 16 * nt + r16; _Pragma("unroll") for (int ks = 0; ks < 4; ++ks) \
        bu[nt][ks] = *(const bf16x8*)(ug + (size_t)(n * 8 + 2 * ks + (q4 >> 1)) * 16 + 8 * (q4 & 1)); } } while (0)
    SSM_LOADU(0);
    for (int seg = 0; seg < 8; ++seg) {
        f32x4 ay[4];
#pragma unroll
        for (int nt = 0; nt < 4; ++nt) { f32x4 acc = {0.f, 0.f, 0.f, 0.f}, accy = {0.f, 0.f, 0.f, 0.f};
#pragma unroll
            for (int ks = 0; ks < 4; ++ks) { acc = mfma16(aS[ks], bu[nt][ks], acc); accy = mfma16(aI[ks], bu[nt][ks], accy); }
            *(LAS f32x4*)(DL + (16 * nt + r16) * SSM_DROW + 16 * wave + 4 * q4) = acc; ay[nt] = accy; }
        if (seg < 7) SSM_LOADU(seg + 1);
        __syncthreads();
        if (wave == 0) {
            for (int nb = 0; nb < 64; nb += 8) {
                float dr[8], di[8];
#pragma unroll
                for (int j = 0; j < 8; ++j) { dr[j] = DL[(nb + j) * SSM_DROW + lane]; di[j] = DL[(nb + j) * SSM_DROW + 64 + lane]; }
#pragma unroll
                for (int j = 0; j < 8; ++j) { S0[(nb + j) * SSM_SROW + lane] = (bf16)(cvt_pk_bf16(sre, 0.f) & 0xffffu); S0[(nb + j) * SSM_SROW + 64 + lane] = (bf16)(cvt_pk_bf16(sim, 0.f) & 0xffffu);
                    const float nr = l8r * sre - l8i * sim + dr[j], ni = l8r * sim + l8i * sre + di[j]; sre = nr; sim = ni; } }
        }
        __syncthreads();
#pragma unroll
        for (int nt = 0; nt < 4; ++nt) { const int n = 64 * seg + 16 * nt + r16; f32x4 acc = ay[nt];
            bf16x8 bs[4];
#pragma unroll
            for (int ks = 0; ks < 4; ++ks) bs[ks] = *(const LAS bf16x8*)(S0 + (16 * nt + r16) * SSM_SROW + 32 * ks + 8 * q4);
#pragma unroll
            for (int ks = 0; ks < 4; ++ks) acc = mfma16(aO[ks], bs[ks], acc);
            f32x4 z;
#pragma unroll
            for (int e = 0; e < 4; ++e) { const float y = acc[e]; const float t = 1.5957691216057308f * (y + 0.044715f * y * y * y); z[e] = y * __builtin_amdgcn_rcpf(1.0f + __builtin_amdgcn_exp2f(-1.4426950408889634f * t)); }
            v2u w; w.x = cvt_pk_bf16(z[0], z[1]); w.y = cvt_pk_bf16(z[2], z[3]);
            *(v2u*)(zb + (size_t)(n * 8 + wave) * 1024 + 4 * q4) = w; }
    }
#undef SSM_LOADU
    __syncthreads();
}

constexpr int AT_KROW = 136, AT_VROW = 152, AT_SROW = 68, AT_PROW = 72;
constexpr int AT_KB = 64 * AT_KROW * 2, AT_VB = 64 * AT_VROW * 2, AT_BUF = AT_KB + AT_VB;
constexpr int AT_S_OFF = 2 * AT_BUF, AT_P_OFF = AT_S_OFF + 8 * 16 * AT_SROW * 4, AT_FLAG_OFF = AT_P_OFF + 8 * 16 * AT_PROW * 2;
static_assert(AT_FLAG_OFF + 64 <= RING_BYTES, "attention LDS");
constexpr float AT_THR = -152.0f;
typedef short s16x4 __attribute__((ext_vector_type(4)));
__device__ __forceinline__ s16x4 lds_tr(const LAS bf16* p) { return __builtin_bit_cast(s16x4, __builtin_amdgcn_ds_read_tr16_b64_v4i16((LAS s16x4*)p)); }
__device__ __forceinline__ void attn_unit(unsigned char* ws, LAS unsigned char* lds, int b, int h, int qb, int tid, int lane, int wave, bool do_ss) {
    const int r16 = lane & 15, q4 = lane >> 4;
    LAS float* Sw = (LAS float*)(lds + AT_S_OFF) + wave * 16 * AT_SROW; LAS bf16* Pw = (LAS bf16*)(lds + AT_P_OFF) + wave * 16 * AT_PROW;
    volatile LAS unsigned* flag = (volatile LAS unsigned*)(lds + AT_FLAG_OFF);
    const bf16* Qg = (const bf16*)(ws + WS_Q) + (size_t)b * SEQ * 1024 + h * 128;
    const bf16* Kg = (const bf16*)(ws + WS_K) + (size_t)b * SEQ * 1024 + h * 128;
    const bf16* Vg = (const bf16*)(ws + WS_V) + (size_t)b * SEQ * 1024 + h * 128;
    const int qw0 = 128 * qb + 16 * wave, qrow = qw0 + r16;
    bf16x8 qf[4];
#pragma unroll
    for (int ks = 0; ks < 4; ++ks) qf[ks] = *(const bf16x8*)(Qg + (size_t)qrow * 1024 + 32 * ks + 8 * q4);
    f32x4 o[8];
#pragma unroll
    for (int i = 0; i < 8; ++i) o[i] = (f32x4){0.f, 0.f, 0.f, 0.f};
    float carry = 0.f; bool done = false;
    const int pr0 = tid >> 4, pc = tid & 15;
    v4u kr[2], vr[2];
    int kt = 2 * qb + 1, buf = 0, it = 0;
#define AT_LOAD(KT) do { _Pragma("unroll") for (int i = 0; i < 2; ++i) { const size_t go = (size_t)(64 * (KT) + pr0 + 32 * i) * 1024 + 8 * pc; kr[i] = *(const v4u*)(Kg + go); vr[i] = *(const v4u*)(Vg + go); } } while (0)
#define AT_STAGE(B) do { _Pragma("unroll") for (int i = 0; i < 2; ++i) { const int row = pr0 + 32 * i; *(LAS v4u*)((LAS bf16*)(lds + (B) * AT_BUF) + row * AT_KROW + 8 * pc) = kr[i]; \
        *(LAS v4u*)((LAS bf16*)(lds + (B) * AT_BUF + AT_KB) + row * AT_VROW + 8 * pc) = vr[i]; } } while (0)
    AT_LOAD(kt); AT_STAGE(0);
    if (kt > 0) AT_LOAD(kt - 1);
    __syncthreads();
    for (;;) {
        const LAS bf16* Ks = (const LAS bf16*)(lds + buf * AT_BUF); const LAS bf16* Vs = (const LAS bf16*)(lds + buf * AT_BUF + AT_KB);
        const int j0 = 64 * kt;
        if (!done && j0 < qw0 + 15) {
            {
                bf16x8 ak[2][4];
#pragma unroll
                for (int ks = 0; ks < 4; ++ks) ak[0][ks] = *(const LAS bf16x8*)(Ks + r16 * AT_KROW + 32 * ks + 8 * q4);
#pragma unroll
                for (int t4 = 0; t4 < 4; ++t4) {
                    if (t4 < 3) {
#pragma unroll
                        for (int ks = 0; ks < 4; ++ks) ak[(t4 + 1) & 1][ks] = *(const LAS bf16x8*)(Ks + (16 * (t4 + 1) + r16) * AT_KROW + 32 * ks + 8 * q4); }
                    __builtin_amdgcn_sched_barrier(0);
                    f32x4 acc = {0.f, 0.f, 0.f, 0.f};
#pragma unroll
                    for (int ks = 0; ks < 4; ++ks) acc = mfma16(ak[t4 & 1][ks], qf[ks], acc);
                    *(LAS f32x4*)(Sw + r16 * AT_SROW + 16 * t4 + 4 * q4) = acc;
                    __builtin_amdgcn_sched_barrier(0); } }
            LDS_WAIT(); __builtin_amdgcn_wave_barrier();
            float lk[16], ls[16];
#pragma unroll
            for (int c = 0; c < 4; ++c) { const f32x4 sv = *(const LAS f32x4*)(Sw + r16 * AT_SROW + 16 * q4 + 4 * c);
#pragma unroll
                for (int e = 0; e < 4; ++e) { const float z2 = sv[e]; const float az = __builtin_fabsf(z2); const float ex = __builtin_amdgcn_exp2f(-az); const float sp = fmaxf(z2, 0.f) + __builtin_amdgcn_logf(1.0f + ex);
                    const bool valid = (j0 + 16 * q4 + 4 * c + e) < qrow; lk[4 * c + e] = valid ? -sp : 0.f; ls[4 * c + e] = valid ? (z2 - sp) : -1.0e30f; } }
            float run = 0.f, ps[16];
#pragma unroll
            for (int i = 15; i >= 0; --i) { ps[i] = run; run += lk[i]; }
            const float t0 = __shfl(run, r16), t1 = __shfl(run, r16 + 16), t2 = __shfl(run, r16 + 32), t3 = __shfl(run, r16 + 48);
            const float offs = (q4 < 1 ? t1 : 0.f) + (q4 < 2 ? t2 : 0.f) + (q4 < 3 ? t3 : 0.f);
            const float base = carry + offs;
            float wv[16];
#pragma unroll
            for (int i = 0; i < 16; ++i) wv[i] = __builtin_amdgcn_exp2f(ls[i] + ps[i] + base);
            carry += (t0 + t1) + (t2 + t3);
            v4u p0, p1;
            p0.x = cvt_pk_bf16(wv[0], wv[1]); p0.y = cvt_pk_bf16(wv[2], wv[3]); p0.z = cvt_pk_bf16(wv[4], wv[5]); p0.w = cvt_pk_bf16(wv[6], wv[7]);
            p1.x = cvt_pk_bf16(wv[8], wv[9]); p1.y = cvt_pk_bf16(wv[10], wv[11]); p1.z = cvt_pk_bf16(wv[12], wv[13]); p1.w = cvt_pk_bf16(wv[14], wv[15]);
            *(LAS v4u*)(Pw + r16 * AT_PROW + 16 * q4) = p0; *(LAS v4u*)(Pw + r16 * AT_PROW + 16 * q4 + 8) = p1;
            LDS_WAIT(); __builtin_amdgcn_wave_barrier();
            bf16x8 bp[2];
#pragma unroll
            for (int ks = 0; ks < 2; ++ks) bp[ks] = *(const LAS bf16x8*)(Pw + r16 * AT_PROW + 32 * ks + 8 * q4);
            const LAS bf16* vb = Vs + (8 * q4 + (r16 >> 2)) * AT_VROW + 4 * (r16 & 3);
            {
                s16x4 vlo[2][2], vhi[2][2];
#pragma unroll
                for (int ks = 0; ks < 2; ++ks) { vlo[0][ks] = lds_tr(vb + 32 * ks * AT_VROW); vhi[0][ks] = lds_tr(vb + (32 * ks + 4) * AT_VROW); }
#pragma unroll
                for (int dt = 0; dt < 8; ++dt) {
                    if (dt < 7) {
#pragma unroll
                        for (int ks = 0; ks < 2; ++ks) { vlo[(dt + 1) & 1][ks] = lds_tr(vb + 32 * ks * AT_VROW + 16 * (dt + 1)); vhi[(dt + 1) & 1][ks] = lds_tr(vb + (32 * ks + 4) * AT_VROW + 16 * (dt + 1)); } }
                    __builtin_amdgcn_sched_barrier(0);
#pragma unroll
                    for (int ks = 0; ks < 2; ++ks) { const bf16x8 av = __builtin_shufflevector(vlo[dt & 1][ks], vhi[dt & 1][ks], 0, 1, 2, 3, 4, 5, 6, 7); o[dt] = mfma16(av, bp[ks], o[dt]); }
                    __builtin_amdgcn_sched_barrier(0); } }
            done = __all(carry < AT_THR);
        }
        if (kt > 0) { AT_STAGE(buf ^ 1); if (kt > 1) AT_LOAD(kt - 2); }
        if (lane == 0) flag[(it & 1) * 8 + wave] = (!done && kt > 0) ? 1u : 0u;
        __syncthreads();
        unsigned any = 0;
#pragma unroll
        for (int i = 0; i < 8; ++i) any |= flag[(it & 1) * 8 + i];
        if (!any) break;
        --kt; buf ^= 1; ++it;
    }
#undef AT_LOAD
#undef AT_STAGE
    bf16* Y = (bf16*)(ws + WS_YMIX) + (size_t)(b * SEQ + qrow) * 2048 + 1024 + h * 128 + 4 * q4;
    float q = 0.f;
#pragma unroll
    for (int dt = 0; dt < 8; ++dt) { v2u w; w.x = cvt_pk_bf16(o[dt][0], o[dt][1]); w.y = cvt_pk_bf16(o[dt][2], o[dt][3]); *(v2u*)(Y + 16 * dt) = w; q += (o[dt][0] * o[dt][0] + o[dt][1] * o[dt][1]) + (o[dt][2] * o[dt][2] + o[dt][3] * o[dt][3]); }
    q += __shfl_xor(q, 16); q += __shfl_xor(q, 32);
    if (q4 == 0 && do_ss) atomicAdd((float*)(ws + WS_STAT) + ST_SB * MROWS + b * SEQ + qrow, q);
    __syncthreads();
}

#define XB_TMO      128
#define XB_XCNT(j)  (256  + 64 * (j))
#define XB_XSUB(j)  (1280 + 64 * (j))
#define XB_XGEN(j)  (2304 + 64 * (j))
#define XB_TOP      3328
#define XB_TOPGEN   3392
#define XCD_BAR_WORDS 3456
#define XB_SPIN_CAP (1u << 18)

__device__ __forceinline__ unsigned xb_ld(unsigned* p)              { return __hip_atomic_load(p, __ATOMIC_RELAXED, __HIP_MEMORY_SCOPE_AGENT); }
__device__ __forceinline__ unsigned xb_add(unsigned* p, unsigned v) { return __hip_atomic_fetch_add(p, v, __ATOMIC_RELAXED, __HIP_MEMORY_SCOPE_AGENT); }
__device__ __forceinline__ unsigned xb_xcc_id() { return (unsigned)__builtin_amdgcn_s_getreg((3 << 11) | 20) & 0xFu; }
#define XB_SPIN(cond, bar) do { unsigned _sp = 0; while (cond) { __builtin_amdgcn_s_sleep(1); \
    if ((++_sp & 255u) == 0u) { if (xb_ld(&(bar)[XB_TMO])) break; if (_sp > XB_SPIN_CAP) { atomicAdd(&(bar)[XB_TMO], 1u); break; } } } } while (0)

struct XcdBarrier {
    unsigned* bar; unsigned x;
    volatile LAS unsigned* st;
};

__device__ __forceinline__ XcdBarrier xcd_barrier_post(unsigned* bar, volatile LAS unsigned* st) {
    XcdBarrier b; b.bar = bar; b.x = xb_xcc_id(); b.st = st;
    if (threadIdx.x == 0) (void)xb_add(&bar[XB_XCNT(b.x)], 1u);
    return b;
}
__device__ __forceinline__ void xcd_barrier_complete(unsigned* bar, unsigned x, unsigned& nloc, unsigned& nx) {
    const unsigned G = gridDim.x * gridDim.y * gridDim.z;
    unsigned sum, cnt, mine, sp = 0u;
    for (;;) {
        sum = 0u; cnt = 0u; mine = 0u;
#pragma unroll
        for (unsigned j = 0; j < 16; ++j) { const unsigned c = xb_ld(&bar[XB_XCNT(j)]); sum += c; cnt += (c > 0u) ? 1u : 0u; mine = (j == x) ? c : mine; }
        if (sum == G) break;
        __builtin_amdgcn_s_sleep(1);
        if ((++sp & 255u) == 0u) { if (xb_ld(&bar[XB_TMO])) break; if (sp > XB_SPIN_CAP) { atomicAdd(&bar[XB_TMO], 1u); break; } }
    }
    nloc = mine > 0u ? mine : 1u; nx = cnt > 0u ? cnt : 1u;
}

__device__ __forceinline__ void xcd_barrier(const XcdBarrier& b) {
    asm volatile("s_waitcnt vmcnt(0)" ::: "memory");
    __syncthreads();
    if (threadIdx.x == 0) {
        unsigned* bar = b.bar;
        __builtin_amdgcn_s_waitcnt(0);
        unsigned nloc = b.st[0], nx = b.st[1];
        if (nloc == 0u) { xcd_barrier_complete(bar, b.x, nloc, nx); b.st[0] = nloc; b.st[1] = nx; }
        const unsigned old = xb_add(&bar[XB_XSUB(b.x)], 1u);
        const unsigned gen = old / nloc;
        if (old + 1u == (gen + 1u) * nloc) {
            __builtin_amdgcn_fence(__ATOMIC_RELEASE, "agent");
            asm volatile("s_waitcnt vmcnt(0)" ::: "memory");
            const unsigned og = xb_add(&bar[XB_TOP], 1u);
            const unsigned tg = og / nx;
            if (og + 1u == (tg + 1u) * nx) xb_add(&bar[XB_TOPGEN], 1u);
            else XB_SPIN(xb_ld(&bar[XB_TOPGEN]) == tg, bar);
            __builtin_amdgcn_fence(__ATOMIC_ACQUIRE, "agent");
            xb_add(&bar[XB_XGEN(b.x)], 1u);
            asm volatile("s_waitcnt vmcnt(0)" ::: "memory");
        } else {
            XB_SPIN(xb_ld(&bar[XB_XGEN(b.x)]) == gen, bar);
            __builtin_amdgcn_fence(__ATOMIC_ACQUIRE, "agent");
            asm volatile("s_waitcnt vmcnt(0)" ::: "memory");
        }
    }
    __syncthreads();
}

static_assert(BAR_WORDS == XCD_BAR_WORDS, "barrier words");
struct Args { const float* in[31]; float* out; unsigned char* ws; };
#ifndef MK_PHASE_MASK
#define MK_PHASE_MASK 0xFFFFFFFFu
#endif
__global__ void __launch_bounds__(NTHREADS, 2) mk_fwd(Args args) {
    extern __shared__ __attribute__((aligned(16))) unsigned char lds_raw[];
    LAS unsigned char* lds = (LAS unsigned char*)lds_raw;
    cg::grid_group grid = cg::this_grid();
    volatile LAS unsigned* bar_st = (volatile LAS unsigned*)(lds + XCH_OFF + 12288);
    if (threadIdx.x < 2) bar_st[threadIdx.x] = 0u;
    __syncthreads();
    const int wave_s = __builtin_amdgcn_readfirstlane(threadIdx.x >> 6);
#define FRESH_IDS unsigned ones_ = ~0u; asm volatile("" : "+s"(ones_)); const int lane = (int)__builtin_amdgcn_mbcnt_hi(ones_, __builtin_amdgcn_mbcnt_lo(ones_, 0u)), wave = wave_s, tid = wave * 64 + lane; (void)tid; (void)lane; (void)wave;
    const int G = gridDim.x, bx = blockIdx.x;
    unsigned char* ws = args.ws; float* out = args.out;
    In in;
    in.x = args.in[0]; in.p = args.in[1]; in.ffn1_norm = args.in[2]; in.ffn1_wg = args.in[3]; in.ffn1_wu = args.in[4]; in.ffn1_wd = args.in[5]; in.mix_norm = args.in[6]; in.w_in = args.in[7];
    in.lam_re = args.in[8]; in.lam_im = args.in[9]; in.b_re = args.in[10]; in.b_im = args.in[11]; in.c_re = args.in[12]; in.c_im = args.in[13]; in.log_dt = args.in[14]; in.ssm_d = args.in[15];
    in.w_glu = args.in[16]; in.b_glu = args.in[17]; in.q_norm = args.in[18]; in.k_norm = args.in[19]; in.on_ssm = args.in[20]; in.on_sb = args.in[21]; in.w_out = args.in[22];
    in.ffn2_norm = args.in[23]; in.ffn2_wg = args.in[24]; in.ffn2_wu = args.in[25]; in.ffn2_wd = args.in[26]; in.ple_norm = args.in[27]; in.w_pg = args.in[28]; in.w_pp = args.in[29]; in.ple_post = args.in[30];
    float* stat = (float*)(ws + WS_STAT);
    bf16* XB = (bf16*)(ws + WS_XB); bf16* ACT = (bf16*)(ws + WS_ACT); bf16* YMIX = (bf16*)(ws + WS_YMIX);
#define PH(k) ((MK_PHASE_MASK >> (k)) & 1u)
#ifndef MK_DUP
#define MK_DUP 0u
#endif
#define NREP(k) (1 + (int)((MK_DUP >> (k)) & 1u))

    { FRESH_IDS p0_prologue(in, out, ws, lds, tid, lane, wave); }
    grid.sync();
    const XcdBarrier xbar = xcd_barrier_post((unsigned*)(ws + WS_BAR), bar_st);
    for (int rep_ = 0; rep_ < NREP(1); ++rep_) { pg8::Gemm g{XB, (const bf16*)(ws + WS_WGU1), MROWS, 2 * FF, DM, DM}; pg8::StaticOrder S; S.init(MROWS, 2 * FF, G, bx);
        pg8::EpiSwiGLU E{ACT, stat + ST_SS1 * MROWS, FF, (LAS float*)(lds + XCH_OFF)}; pg8::gemm_phase<pg8::EpiSwiGLU, pg8::StaticOrder, true, true>(lds, g, S, E, wave_s); }
    xcd_barrier(xbar);
    for (int rep_ = 0; rep_ < NREP(2); ++rep_) { pg8::Gemm g{ACT, (const bf16*)(ws + WS_WD1), MROWS, DM, FF, FF}; pg8::StaticOrder S; S.init(MROWS, DM, G, bx);
        pg8::EpiResid<0, false> E{nullptr, XB, (rep_ + 1 < NREP(2)) ? nullptr : stat + ST_SS2 * MROWS, nullptr, nullptr}; pg8::gemm_phase<pg8::EpiResid<0, false>, pg8::StaticOrder, true, true, true>(lds, g, S, E, wave_s); }
    xcd_barrier(xbar);
    for (int rep_ = 0; rep_ < NREP(3); ++rep_) { pg8::Gemm g{XB, (const bf16*)(ws + WS_WIN), MROWS, NIN, DM, DM}; pg8::StaticOrder S; S.init(MROWS, NIN, G, bx);
        pg8::EpiWin E{stat + ST_SS2 * MROWS, (bf16*)(ws + WS_UG), (bf16*)(ws + WS_Q), (bf16*)(ws + WS_K), (bf16*)(ws + WS_V), in.q_norm, in.k_norm, (LAS float*)(lds + XCH_OFF)};
        pg8::gemm_phase<pg8::EpiWin, pg8::StaticOrder, true, true>(lds, g, S, E, wave_s); }
    xcd_barrier(xbar);
    { FRESH_IDS
        for (int itt = bx; itt < (512 + 2048) * P4_REP; itt += G) { const int it = itt % (512 + 2048);
            if (it < 512) ssm_unit(ws, lds, it >> 6, it & 63, lane, wave);
            else { const int a = it - 512; attn_unit(ws, lds, a >> 8, (a >> 5) & 7, a & 31, tid, lane, wave, itt >= (512 + 2048) * (P4_REP - 1)); }
        }
    }
    xcd_barrier(xbar);
    if (PH(5)) { pg8::Gemm g{(const bf16*)(ws + WS_Z), (const bf16*)(ws + WS_WGLU), MROWS, SSMW, SSMW, SSMW}; pg8::StaticOrder S; S.init(MROWS, SSMW, G, bx);
        pg8::EpiGlu E{(const bf16*)(ws + WS_Z), in.b_glu, YMIX, stat + ST_SSM * MROWS}; pg8::gemm_phase<pg8::EpiGlu, pg8::StaticOrder, true, true>(lds, g, S, E, wave_s); }
    xcd_barrier(xbar);
    if (PH(6)) { pg8::Gemm g{YMIX, (const bf16*)(ws + WS_WOUT), MROWS, DM, DM, DM / 2}; pg8::SplitOrder S; S.base.init(MROWS, DM, G, bx);
        pg8::EpiResid<1, false> E{nullptr, XB, stat + ST_SS3 * MROWS, stat + ST_SSM * MROWS, stat + ST_SB * MROWS}; pg8::gemm_phase<pg8::EpiResid<1, false>, pg8::SplitOrder, true, true>(lds, g, S, E, wave_s); }
    xcd_barrier(xbar);
    if (PH(7)) { pg8::Gemm g{XB, (const bf16*)(ws + WS_WGU2), MROWS, 2 * FF, DM, DM}; pg8::StaticOrder S; S.init(MROWS, 2 * FF, G, bx);
        pg8::EpiSwiGLU E{ACT, stat + ST_SS3 * MROWS, FF, (LAS float*)(lds + XCH_OFF)}; pg8::gemm_phase<pg8::EpiSwiGLU, pg8::StaticOrder, true, true>(lds, g, S, E, wave_s); }
    xcd_barrier(xbar);
    if (PH(8)) { pg8::Gemm g{ACT, (const bf16*)(ws + WS_WD2), MROWS, DM, FF, FF}; pg8::StaticOrder S; S.init(MROWS, DM, G, bx);
        pg8::EpiResid<0, false> E{nullptr, XB, stat + ST_SS4 * MROWS, nullptr, nullptr}; pg8::gemm_phase<pg8::EpiResid<0, false>, pg8::StaticOrder, true, true, true>(lds, g, S, E, wave_s); }
    xcd_barrier(xbar);
    if (PH(9)) { pg8::Gemm g{(const bf16*)(ws + WS_PB), (const bf16*)(ws + WS_WPP), MROWS, DM, PLE, PLE}; pg8::StaticOrder S; S.init(MROWS, DM, G, bx);
        pg8::EpiPlain E{YMIX, DM}; pg8::gemm_phase<pg8::EpiPlain, pg8::StaticOrder, true, true>(lds, g, S, E, wave_s); }
    asm volatile("s_waitcnt vmcnt(0)" ::: "memory"); __syncthreads();
    if (PH(10)) { pg8::Gemm g{XB, (const bf16*)(ws + WS_WPG), MROWS, DM, DM, DM}; pg8::StaticOrder S; S.init(MROWS, DM, G, bx);
        pg8::EpiPle E{YMIX, stat + ST_SS4 * MROWS, (bf16*)(ws + WS_E), stat + ST_SSE * MROWS}; pg8::gemm_phase<pg8::EpiPle, pg8::StaticOrder, true, true>(lds, g, S, E, wave_s); }
    xcd_barrier(xbar);
    if (PH(11)) { FRESH_IDS const bf16* E = (const bf16*)(ws + WS_E); const float* sse = stat + ST_SSE * MROWS; const int gw = bx * NWAVES + wave, NGW = G * NWAVES;
        for (int m = gw; m < MROWS; m += NGW) { const float r = pg8::rstd_of(sse[m], 1.0f / 2048.0f); GAS f32x4* xr = (GAS f32x4*)(out + (size_t)m * DM) + lane; const GAS v2u* xbr = (const GAS v2u*)(XB + (size_t)m * DM) + lane; const GAS v2u* er = (const GAS v2u*)(E + (size_t)m * DM) + lane;
            const GAS f32x4* gp = (const GAS f32x4*)in.ple_post + lane;
#pragma unroll
            for (int j = 0; j < 8; ++j) { const v2u xw = xbr[64 * j]; const v2u w = er[64 * j]; const f32x4 gg = gp[64 * j]; f32x4 v;
                v.x = pg8::bf_lo(xw.x) + pg8::bf_lo(w.x) * r * gg.x; v.y = pg8::bf_hi(xw.x) + pg8::bf_hi(w.x) * r * gg.y; v.z = pg8::bf_lo(xw.y) + pg8::bf_lo(w.y) * r * gg.z; v.w = pg8::bf_hi(xw.y) + pg8::bf_hi(w.y) * r * gg.w; xr[64 * j] = v; } } }
#undef PH
}

extern "C" void kernel_launch(void* const* d_in, const int* in_sizes, int n_in, void* d_out, int out_size, void* d_ws, size_t ws_size, hipStream_t stream) {
    static int grid = 0;
    if (grid == 0) {
        if (n_in != 31 || out_size != MROWS * DM || ws_size < WS_END) { fprintf(stderr, "kernel_launch: unexpected shapes (n_in %d, out %d, ws %zu)\n", n_in, out_size, ws_size); grid = -1; return; }
        int dev = 0, cus = 0, per_cu = 0;
        hipGetDevice(&dev); hipDeviceGetAttribute(&cus, hipDeviceAttributeMultiprocessorCount, dev);
        if (hipFuncSetAttribute((const void*)mk_fwd, hipFuncAttributeMaxDynamicSharedMemorySize, LDS_BYTES) != hipSuccess) { fprintf(stderr, "kernel_launch: hipFuncSetAttribute failed\n"); grid = -1; return; }
        if (hipOccupancyMaxActiveBlocksPerMultiprocessor(&per_cu, (const void*)mk_fwd, NTHREADS, LDS_BYTES) != hipSuccess || per_cu < 1) { fprintf(stderr, "kernel_launch: occupancy query gives %d\n", per_cu); per_cu = 1; }
        (void)hipGetLastError();
        grid = cus * 1;
    }
    if (grid < 0) return;
    Args a{};
    for (int i = 0; i < 31; ++i) a.in[i] = (const float*)d_in[i];
    a.out = (float*)d_out; a.ws = (unsigned char*)d_ws;
    void* kargs[] = {&a};
    hipError_t e = hipLaunchCooperativeKernel((const void*)mk_fwd, dim3(grid), dim3(NTHREADS), kargs, LDS_BYTES, stream);
    if (e != hipSuccess) fprintf(stderr, "kernel_launch: cooperative launch failed: %s (grid %d)\n", hipGetErrorString(e), grid);
}
```

```cpp
#include <hip/hip_runtime.h>
#include <hip/hip_cooperative_groups.h>
#include <cstdio>
#include <cstdint>
namespace cg = cooperative_groups;
namespace pg8 {
#define PG8_LAS __attribute__((address_space(3)))
typedef unsigned short bf16_t;
typedef short bf16x8 __attribute__((ext_vector_type(8)));
typedef float f32x4 __attribute__((ext_vector_type(4)));
typedef unsigned u32x4 __attribute__((ext_vector_type(4)));
constexpr int BM = 256, BK = 64, HALF = 128, HTB = HALF * BK * 2  , STAGE_BYTES = 8 * HTB, NXCD = 8, WGM = 8;

__host__ __device__ __forceinline__ int lds_byte(int r, int c) { const int st = (r >> 4) * 2 + (c >> 5), rr = r & 15, cc = c & 31, ob = rr * 64 + cc * 2; return st * 1024 + (ob ^ (((ob >> 9) & 1) << 5)); }
__host__ __device__ __forceinline__ void stage_rc(int b, int& R, int& C) { const int st = b / 1024, sb = b % 1024, swz = sb ^ (((sb >> 9) & 1) << 5); R = (st >> 1) * 16 + swz / 64; C = (st & 1) * 32 + (swz % 64) / 2; }
__host__ __device__ __forceinline__ int perm32(int rho) { const int n = rho >> 4, i = rho & 15; return 8 * (i >> 2) + 4 * n + (i & 3); }

struct Unit { int pm, pn, kh, par; };
struct Gemm { const bf16_t* A; const bf16_t* Bt; int M, N, K, KU; };

struct StaticOrder {
    int nM, nN, nwg, G, c;
    __host__ __device__ void init(int M, int N, int G_, int c_) { nM = M / BM; nN = N / BM; nwg = nM * nN; G = G_; c = c_; }
    __host__ __device__ bool next(int i, Unit& u) const {
        const long L = (long)i * G + c; if (L >= nwg) return false;
        int wgid = (int)L; { const int q = nwg / NXCD, r = nwg % NXCD, xcd = wgid % NXCD, off = wgid / NXCD; wgid = (xcd < r ? xcd * (q + 1) : r * (q + 1) + (xcd - r) * q) + off; }
        const int nig = WGM * nN, gid = wgid / nig, fm = gid * WGM, gsz = (nM - fm) < WGM ? (nM - fm) : WGM;
        u.pm = fm + ((wgid % nig) % gsz); u.pn = (wgid % nig) / gsz; u.kh = 0; return true;
    }
    __device__ __forceinline__ void a_ready(const Unit&) const {}
    __device__ __forceinline__ void done(const Unit&) const {}
};

__device__ __forceinline__ unsigned cvt_pk_bf16(float lo, float hi) { unsigned r; asm volatile("v_cvt_pk_bf16_f32 %0, %1, %2" : "=v"(r) : "v"(lo), "v"(hi)); return r; }
typedef int i32x4 __attribute__((ext_vector_type(4)));
typedef int i32x8 __attribute__((ext_vector_type(8)));
__device__ __forceinline__ i32x8 cat8(bf16x8 a, bf16x8 b) { return __builtin_shufflevector(__builtin_bit_cast(i32x4, a), __builtin_bit_cast(i32x4, b), 0, 1, 2, 3, 4, 5, 6, 7); }
__device__ __forceinline__ unsigned pack4_fp8(float a, float b, float c, float d) {
    a = __builtin_fminf(__builtin_fmaxf(a, -448.f), 448.f); b = __builtin_fminf(__builtin_fmaxf(b, -448.f), 448.f); c = __builtin_fminf(__builtin_fmaxf(c, -448.f), 448.f); d = __builtin_fminf(__builtin_fmaxf(d, -448.f), 448.f);
    int w = __builtin_amdgcn_cvt_pk_fp8_f32(a, b, 0, false); w = __builtin_amdgcn_cvt_pk_fp8_f32(c, d, w, true); return (unsigned)w; }
constexpr float F8_ACT_SCALE = 8.0f, F8_W_SCALE = 64.0f;
struct SplitOrder {
    StaticOrder base;
    __device__ bool next(int i, Unit& u) const { const bool r = base.next(i >> 1, u); u.kh = i & 1; return r; }
    __device__ __forceinline__ void a_ready(const Unit&) const {}
    __device__ __forceinline__ void done(const Unit&) const {}
};
typedef float f32x2 __attribute__((ext_vector_type(2)));
__device__ __forceinline__ float rstd_of(float ss, float inv_n) { return __builtin_amdgcn_rsqf(ss * inv_n + 1e-6f); }
__device__ __forceinline__ float sigmoid_f(float v) { return __builtin_amdgcn_rcpf(1.0f + __builtin_amdgcn_exp2f(-1.4426950408889634f * v)); }
__device__ __forceinline__ float bf_lo(unsigned w) { return __uint_as_float(w << 16); }
__device__ __forceinline__ float bf_hi(unsigned w) { return __uint_as_float(w & 0xffff0000u); }
__device__ __forceinline__ u32x4 pack8(const f32x4 a, const f32x4 b) { u32x4 w; w.x = cvt_pk_bf16(a[0], a[1]); w.y = cvt_pk_bf16(a[2], a[3]); w.z = cvt_pk_bf16(b[0], b[1]); w.w = cvt_pk_bf16(b[2], b[3]); return w; }
__device__ __forceinline__ float sumsq4(const f32x4 a) { return (a[0] * a[0] + a[1] * a[1]) + (a[2] * a[2] + a[3] * a[3]); }

template <bool F8OUT> struct EpiSwiGLU {
    static constexpr bool PERM = true, AFTER_DRAIN = false, MID = false, PREF = true;
    bf16_t* O; const float* ss; int ldo; PG8_LAS float* sl;
    __device__ __forceinline__ void prefetch(const Unit& u, int wid, int lane) const {
        if (wid < 4) __builtin_amdgcn_global_load_lds((const unsigned*)(ss + u.pm * BM + 64 * wid + lane), (PG8_LAS unsigned*)(sl + u.par * 256 + 64 * wid), 4, 0, 0);
    }
    __device__ __forceinline__ void operator()(f32x4 (&acc)[2][2][4][2], const Unit& u, int wr, int wc, int fr, int fq) const {
        const int row0 = u.pm * BM + wr * 64 + fr, col0 = u.pn * HALF + wc * 32 + 8 * fq;
#pragma unroll
        for (int ai = 0; ai < 2; ++ai)
#pragma unroll
            for (int m = 0; m < 4; ++m) {
                const int row = row0 + ai * HALF + m * 16; const float r = rstd_of(sl[u.par * 256 + ai * HALF + wr * 64 + m * 16 + fr], 1.0f / 2048.0f);
                f32x4 o[2];
#pragma unroll
                for (int n = 0; n < 2; ++n) { const f32x4 g = acc[ai][0][m][n] * r, uu = acc[ai][1][m][n] * r;
#pragma unroll
                    for (int e = 0; e < 4; ++e) o[n][e] = g[e] * uu[e] * sigmoid_f(g[e]); }
                if constexpr (F8OUT) {
                    typedef unsigned u32x2 __attribute__((ext_vector_type(2))); u32x2 w8; w8.x = pack4_fp8(o[0][0] * F8_ACT_SCALE, o[0][1] * F8_ACT_SCALE, o[0][2] * F8_ACT_SCALE, o[0][3] * F8_ACT_SCALE);
                    w8.y = pack4_fp8(o[1][0] * F8_ACT_SCALE, o[1][1] * F8_ACT_SCALE, o[1][2] * F8_ACT_SCALE, o[1][3] * F8_ACT_SCALE);
                    *(u32x2*)((unsigned char*)O + (((size_t)u.pm * (ldo / 128) + (col0 >> 7)) * BM + (ai * HALF + wr * 64 + m * 16 + fr)) * 128 + (col0 & 127)) = w8;
                } else
                *(u32x4*)(O + (((size_t)u.pm * (ldo / 64) + (col0 >> 6)) * BM + (ai * HALF + wr * 64 + m * 16 + fr)) * 64 + (col0 & 63)) = pack8(o[0], o[1]);
            }
    }
    __device__ __forceinline__ void mid(f32x4 (&)[2][2][4][2], const Unit&, int, int) const {}
};

template <int MODE, bool XF32, bool BATCH = true> struct EpiResid {
    static constexpr bool PERM = true, AFTER_DRAIN = false, MID = (MODE == 1), PREF = false;
    const float* xin; bf16_t* xb; float* ssout; const float* ssa; const float* ssb; float alpha;
    __device__ __forceinline__ void mid(f32x4 (&acc)[2][2][4][2], const Unit& u, int wr, int fr) const {
        {
            const int row0 = u.pm * BM + wr * 64 + fr;
#pragma unroll
            for (int ai = 0; ai < 2; ++ai)
#pragma unroll
                for (int m = 0; m < 4; ++m) { const int row = row0 + ai * HALF + m * 16;
                    const float ra = rstd_of(ssa[row], 1.0f / 1024.0f), rb = rstd_of(ssb[row], 1.0f / 1024.0f), ratio = ra * __builtin_amdgcn_rcpf(rb);
#pragma unroll
                    for (int bj = 0; bj < 2; ++bj)
#pragma unroll
                        for (int n = 0; n < 2; ++n) acc[ai][bj][m][n] = acc[ai][bj][m][n] * ratio;
                    asm volatile("" ::: "memory"); }
        }
    }
    __device__ __forceinline__ void operator()(f32x4 (&acc)[2][2][4][2], const Unit& u, int wr, int wc, int fr, int fq) const {
        if (MODE == 1 && u.kh == 0) { mid(acc, u, wr, fr); return; }
        const int row0 = u.pm * BM + wr * 64 + fr, col0 = u.pn * BM + wc * 32 + 8 * fq;
        u32x4 xw[2][4][2]; f32x4 xf[XF32 ? 16 : 1][2];
#pragma unroll
        for (int ai = 0; ai < 2; ++ai)
#pragma unroll
            for (int m = 0; m < 4; ++m)
#pragma unroll
                for (int bj = 0; bj < 2; ++bj) { const size_t off = (size_t)(row0 + ai * HALF + m * 16) * 2048 + col0 + bj * HALF;
                    if constexpr (XF32) { xf[(ai * 4 + m) * 2 + bj][0] = *(const f32x4*)(xin + off); xf[(ai * 4 + m) * 2 + bj][1] = *(const f32x4*)(xin + off + 4); }
                    else if constexpr (BATCH) xw[ai][m][bj] = *(const u32x4*)(xb + off); }
#pragma unroll
        for (int ai = 0; ai < 2; ++ai)
#pragma unroll
            for (int m = 0; m < 4; ++m) {
                const int row = row0 + ai * HALF + m * 16; const size_t off = (size_t)row * 2048 + col0;
                float sc = alpha; if constexpr (MODE == 1) sc = rstd_of(ssb[row], 1.0f / 1024.0f);
                float q = 0.f;
#pragma unroll
                for (int bj = 0; bj < 2; ++bj) {
                    f32x4 x0, x1;
                    if constexpr (XF32) { x0 = xf[(ai * 4 + m) * 2 + bj][0]; x1 = xf[(ai * 4 + m) * 2 + bj][1]; }
                    else { const u32x4 w = BATCH ? xw[ai][m][bj] : *(const u32x4*)(xb + off + bj * HALF); x0 = (f32x4){bf_lo(w.x), bf_hi(w.x), bf_lo(w.y), bf_hi(w.y)}; x1 = (f32x4){bf_lo(w.z), bf_hi(w.z), bf_lo(w.w), bf_hi(w.w)}; }
                    const f32x4 v0 = x0 + acc[ai][bj][m][0] * sc, v1 = x1 + acc[ai][bj][m][1] * sc;
                    *(u32x4*)(xb + off + bj * HALF) = pack8(v0, v1);
                    q += sumsq4(v0) + sumsq4(v1);
                }
                q += __shfl_xor(q, 16); q += __shfl_xor(q, 32);
                if (fq == 0 && ssout) atomicAdd(ssout + row, q);
                if constexpr (!BATCH) { if (m & 1) asm volatile("" ::: "memory"); }
            }
    }
};

struct EpiWin {
    static constexpr bool PERM = true, AFTER_DRAIN = false, MID = false, PREF = false;
    const float* ss; bf16_t *UG, *Q, *K, *V; const float *gq, *gk; PG8_LAS float* xch;
    __device__ __forceinline__ void mid(f32x4 (&)[2][2][4][2], const Unit&, int, int) const {}
    __device__ __forceinline__ void operator()(f32x4 (&acc)[2][2][4][2], const Unit& u, int wr, int wc, int fr, int fq) const {
        const int row0 = u.pm * BM + wr * 64 + fr, seg = u.pn >> 2, lc0 = (u.pn & 3) * BM + wc * 32 + 8 * fq; const float* ssr = ss + row0;
        if (seg == 0) {
#pragma unroll
            for (int ai = 0; ai < 2; ++ai)
#pragma unroll
                for (int m = 0; m < 4; ++m) { const float r = rstd_of(ssr[ai * HALF + m * 16], 1.0f / 2048.0f); const int row = row0 + ai * HALF + m * 16, b = row >> 12, t = row & 4095;
#pragma unroll
                    for (int bj = 0; bj < 2; ++bj) { const int col = lc0 + bj * HALF, g = col >> 4, half = (col >> 3) & 1;
                        *(u32x4*)(UG + ((size_t)((b * 64 + g) * 4096 + t) * 16 + 8 * half)) = pack8(acc[ai][bj][m][0] * r, acc[ai][bj][m][1] * r); } }
        } else if (seg == 3) {
#pragma unroll
            for (int ai = 0; ai < 2; ++ai)
#pragma unroll
                for (int m = 0; m < 4; ++m) { const float r = rstd_of(ssr[ai * HALF + m * 16], 1.0f / 2048.0f); const int row = row0 + ai * HALF + m * 16;
#pragma unroll
                    for (int bj = 0; bj < 2; ++bj) *(u32x4*)(V + (size_t)row * 1024 + lc0 + bj * HALF) = pack8(acc[ai][bj][m][0] * r, acc[ai][bj][m][1] * r); }
        } else {
#pragma unroll
            for (int ai = 0; ai < 2; ++ai)
#pragma unroll
                for (int m = 0; m < 4; ++m) { const int rl = ai * HALF + wr * 64 + m * 16 + fr;
#pragma unroll
                    for (int bj = 0; bj < 2; ++bj) { float q = sumsq4(acc[ai][bj][m][0]) + sumsq4(acc[ai][bj][m][1]); q += __shfl_xor(q, 16); q += __shfl_xor(q, 32);
                        if (fq == 0) xch[rl * 8 + bj * 4 + wc] = q; } }
            asm volatile("s_waitcnt lgkmcnt(0)" ::: "memory"); __builtin_amdgcn_s_barrier(); asm volatile("" ::: "memory");
            const float* gain = (seg == 1) ? gq : gk; bf16_t* dst = (seg == 1) ? Q : K;
            const float osc = (seg == 1) ? (0.08838834764831845f * 1.4426950408889634f) : 1.0f;
            const int d0 = wc * 32 + 8 * fq;
            const f32x4 g0 = *(const f32x4*)(gain + d0) * osc, g1 = *(const f32x4*)(gain + d0 + 4) * osc;
#pragma unroll
            for (int ai = 0; ai < 2; ++ai)
#pragma unroll
                for (int m = 0; m < 4; ++m) { const int rl = ai * HALF + wr * 64 + m * 16 + fr, row = u.pm * BM + rl;
                    const float epr = 1e-6f * (ssr[ai * HALF + m * 16] * (1.0f / 2048.0f) + 1e-6f);
#pragma unroll
                    for (int bj = 0; bj < 2; ++bj) { const f32x4 p = *(const PG8_LAS f32x4*)(xch + rl * 8 + bj * 4);
                        const float rq = __builtin_amdgcn_rsqf(((p[0] + p[1]) + (p[2] + p[3])) * (1.0f / 128.0f) + epr);
                        *(u32x4*)(dst + (size_t)row * 1024 + lc0 + bj * HALF) = pack8(acc[ai][bj][m][0] * g0 * rq, acc[ai][bj][m][1] * g1 * rq); } }
        }
    }
};

struct EpiGlu {
    static constexpr bool PERM = true, AFTER_DRAIN = false, MID = false, PREF = false;
    const bf16_t* Z; const float* bias; bf16_t* Y; float* ssout;
    __device__ __forceinline__ void mid(f32x4 (&)[2][2][4][2], const Unit&, int, int) const {}
    __device__ __forceinline__ void operator()(f32x4 (&acc)[2][2][4][2], const Unit& u, int wr, int wc, int fr, int fq) const {
        const int row0 = u.pm * BM + wr * 64 + fr, col0 = u.pn * BM + wc * 32 + 8 * fq;
        f32x4 bv[2][2];
#pragma unroll
        for (int bj = 0; bj < 2; ++bj)
#pragma unroll
            for (int n = 0; n < 2; ++n) bv[bj][n] = *(const f32x4*)(bias + col0 + bj * HALF + 4 * n);
        u32x4 zw[2][4][2];
#pragma unroll
        for (int ai = 0; ai < 2; ++ai)
#pragma unroll
            for (int m = 0; m < 4; ++m)
#pragma unroll
                for (int bj = 0; bj < 2; ++bj) zw[ai][m][bj] = *(const u32x4*)(Z + (size_t)(row0 + ai * HALF + m * 16) * 1024 + col0 + bj * HALF);
#pragma unroll
        for (int ai = 0; ai < 2; ++ai)
#pragma unroll
            for (int m = 0; m < 4; ++m) { const int row = row0 + ai * HALF + m * 16; float q = 0.f;
#pragma unroll
                for (int bj = 0; bj < 2; ++bj) { const u32x4 zb = zw[ai][m][bj];
                    const f32x4 z0 = {bf_lo(zb.x), bf_hi(zb.x), bf_lo(zb.y), bf_hi(zb.y)}, z1 = {bf_lo(zb.z), bf_hi(zb.z), bf_lo(zb.w), bf_hi(zb.w)};
                    const f32x4 a0 = acc[ai][bj][m][0] + bv[bj][0], a1 = acc[ai][bj][m][1] + bv[bj][1]; f32x4 y0, y1;
#pragma unroll
                    for (int e = 0; e < 4; ++e) { y0[e] = z0[e] * sigmoid_f(a0[e]); y1[e] = z1[e] * sigmoid_f(a1[e]); }
                    *(u32x4*)(Y + (size_t)row * 2048 + col0 + bj * HALF) = pack8(y0, y1); q += sumsq4(y0) + sumsq4(y1); }
                q += __shfl_xor(q, 16); q += __shfl_xor(q, 32);
                if (fq == 0) atomicAdd(ssout + row, q); }
    }
};

struct EpiPle {
    static constexpr bool PERM = true, AFTER_DRAIN = false, MID = false, PREF = false;
    const bf16_t* PP; const float* ss; bf16_t* E; float* ssout;
    __device__ __forceinline__ void mid(f32x4 (&)[2][2][4][2], const Unit&, int, int) const {}
    __device__ __forceinline__ void operator()(f32x4 (&acc)[2][2][4][2], const Unit& u, int wr, int wc, int fr, int fq) const {
        const int row0 = u.pm * BM + wr * 64 + fr, col0 = u.pn * BM + wc * 32 + 8 * fq;
        u32x4 pw[2][4][2];
#pragma unroll
        for (int ai = 0; ai < 2; ++ai)
#pragma unroll
            for (int m = 0; m < 4; ++m)
#pragma unroll
                for (int bj = 0; bj < 2; ++bj) pw[ai][m][bj] = *(const u32x4*)(PP + (size_t)(row0 + ai * HALF + m * 16) * 2048 + col0 + bj * HALF);
#pragma unroll
        for (int ai = 0; ai < 2; ++ai)
#pragma unroll
            for (int m = 0; m < 4; ++m) { const int row = row0 + ai * HALF + m * 16; const float r = rstd_of(ss[row], 1.0f / 2048.0f); float q = 0.f;
#pragma unroll
                for (int bj = 0; bj < 2; ++bj) { const u32x4 pb = pw[ai][m][bj];
                    const f32x4 p0 = {bf_lo(pb.x), bf_hi(pb.x), bf_lo(pb.y), bf_hi(pb.y)}, p1 = {bf_lo(pb.z), bf_hi(pb.z), bf_lo(pb.w), bf_hi(pb.w)};
                    const f32x4 a0 = acc[ai][bj][m][0] * r, a1 = acc[ai][bj][m][1] * r; f32x4 y0, y1;
#pragma unroll
                    for (int e = 0; e < 4; ++e) { y0[e] = p0[e] * sigmoid_f(a0[e]); y1[e] = p1[e] * sigmoid_f(a1[e]); }
                    *(u32x4*)(E + (size_t)row * 2048 + col0 + bj * HALF) = pack8(y0, y1); q += sumsq4(y0) + sumsq4(y1); }
                q += __shfl_xor(q, 16); q += __shfl_xor(q, 32);
                if (fq == 0) atomicAdd(ssout + row, q); }
    }
};

struct EpiPlain {
    static constexpr bool PERM = true, AFTER_DRAIN = false, MID = false, PREF = false;
    bf16_t* O; int ldo;
    __device__ __forceinline__ void mid(f32x4 (&)[2][2][4][2], const Unit&, int, int) const {}
    __device__ __forceinline__ void operator()(f32x4 (&acc)[2][2][4][2], const Unit& u, int wr, int wc, int fr, int fq) const {
        const int row0 = u.pm * BM + wr * 64 + fr, col0 = u.pn * BM + wc * 32 + 8 * fq;
#pragma unroll
        for (int ai = 0; ai < 2; ++ai)
#pragma unroll
            for (int m = 0; m < 4; ++m) { const int row = row0 + ai * HALF + m * 16;
#pragma unroll
                for (int bj = 0; bj < 2; ++bj) *(u32x4*)(O + (size_t)row * ldo + col0 + bj * HALF) = pack8(acc[ai][bj][m][0], acc[ai][bj][m][1]); }
    }
};
template <class Epi, class Sched, bool ALIGN_EPI = false, bool SP2 = false, bool ABLK = false, bool F8 = false>
__device__ __forceinline__ void gemm_phase(PG8_LAS unsigned char* lds, const Gemm g, const Sched& S, const Epi& E, const int wave_s) {
    unsigned ones_ = ~0u; asm volatile("" : "+s"(ones_));
    const int lane = (int)__builtin_amdgcn_mbcnt_hi(ones_, __builtin_amdgcn_mbcnt_lo(ones_, 0u)), wid = wave_s, tid = wid * 64 + lane, wr = wid >> 2, wc = wid & 3, fr = lane & 15, fq = lane >> 4;
    const int K = g.K, nt = g.KU / BK;
    unsigned voffA[2], voffB[2];
#pragma unroll
    for (int i = 0; i < 2; ++i) { int R, C; stage_rc(tid * 16 + i * 8192, R, C); const int Rb = Epi::PERM ? ((R & ~31) + perm32(R & 31)) : R;
        voffA[i] = ABLK ? (unsigned)(R * BK + C) * 2u : (unsigned)(R * K + C) * 2u; voffB[i] = (unsigned)(Rb * K + C) * 2u; }
    const size_t kstep = (size_t)(BK * 2);
    const size_t hstep = (size_t)HALF * K * 2;
    const size_t tstep = 2 * hstep;
    const size_t kstepA = ABLK ? (size_t)(BM * BK * 2) : kstep, hstepA = ABLK ? (size_t)(HALF * BK * 2) : hstep;
    const unsigned ldsw = (unsigned)wid * 1024u;
    const int aoff = lds_byte(wr * 64 + fr, fq * 8), boff = lds_byte(wc * 32 + fr, fq * 8);
#define PG8_SA(b, h) (((b) * 2 + (h)) * HTB)
#define PG8_SB(b, h) ((4 + (b) * 2 + (h)) * HTB)
#define PG8_STAGE(bufoff, gbase, voff) do { _Pragma("unroll") for (int _i = 0; _i < 2; ++_i) \
        { unsigned _vo = (voff)[_i]; asm volatile("" : "+v"(_vo));     \
        __builtin_amdgcn_global_load_lds((const unsigned*)((const char*)(gbase) + _vo), (PG8_LAS unsigned*)(lds + (bufoff) + ldsw + _i * 8192), 16, 0, 0); } } while (0)
#define PG8_LDA(dst, b, h) do { _Pragma("unroll") for (int m = 0; m < 4; ++m) _Pragma("unroll") for (int k = 0; k < 2; ++k) dst[m][k] = *(const PG8_LAS bf16x8*)(lds + PG8_SA(b, h) + aoff + m * 2048 + k * 1024); } while (0)
#define PG8_LDB(dst, b, h) do { _Pragma("unroll") for (int n = 0; n < 2; ++n) _Pragma("unroll") for (int k = 0; k < 2; ++k) dst[n][k] = *(const PG8_LAS bf16x8*)(lds + PG8_SB(b, h) + boff + n * 2048 + k * 1024); } while (0)
#define PG8_MMA(ai, bj, At, Bt) do { __builtin_amdgcn_s_setprio(1); if constexpr (F8) { _Pragma("unroll") for (int m = 0; m < 4; ++m) _Pragma("unroll") for (int n = 0; n < 2; ++n) \
        acc[ai][bj][m][n] = __builtin_amdgcn_mfma_scale_f32_16x16x128_f8f6f4(cat8(Bt[n][0], Bt[n][1]), cat8(At[m][0], At[m][1]), acc[ai][bj][m][n], 0, 0, 0, 0x7F7F7F7F, 0, 0x7F7F7F7F); } \
    else { _Pragma("unroll") for (int m = 0; m < 4; ++m) _Pragma("unroll") for (int n = 0; n < 2; ++n) _Pragma("unroll") for (int k = 0; k < 2; ++k) \
        acc[ai][bj][m][n] = __builtin_amdgcn_mfma_f32_16x16x32_bf16(Bt[n][k], At[m][k], acc[ai][bj][m][n], 0, 0, 0); } __builtin_amdgcn_s_setprio(0); } while (0)
#define PG8_WAIT_V(n) asm volatile("s_waitcnt vmcnt(" #n ")" ::: "memory")
#define PG8_WAIT_L(n) asm volatile("s_waitcnt lgkmcnt(" #n ")" ::: "memory")
#define PG8_BAR __builtin_amdgcn_s_barrier()
#define PG8_SCHED __builtin_amdgcn_sched_barrier(0)
    Unit cur, nxt; int ui = 0;
    if (!S.next(0, cur)) return;
    cur.par = 0;
    if constexpr (Epi::PREF) E.prefetch(cur, wid, lane);
    f32x4 acc[2][2][4][2];
#pragma unroll
    for (int a = 0; a < 2; ++a)
#pragma unroll
        for (int b = 0; b < 2; ++b)
#pragma unroll
            for (int m = 0; m < 4; ++m)
#pragma unroll
                for (int n = 0; n < 2; ++n) acc[a][b][m][n] = (f32x4){0.f, 0.f, 0.f, 0.f};
    bf16x8 At[4][2], B0[2][2], B1[2][2];
    const size_t khb = (size_t)g.KU * 2, khbA = ABLK ? (size_t)(g.KU / BK) * kstepA : khb; const char* cA = (const char*)g.A + (size_t)cur.pm * tstep + cur.kh * khbA; const char* cB = (const char*)g.Bt + (size_t)cur.pn * tstep + cur.kh * khb;
    S.a_ready(cur);
    if constexpr (SP2) {
        PG8_STAGE(PG8_SB(0, 0), cB, voffB); PG8_STAGE(PG8_SB(0, 1), cB + hstep, voffB); PG8_STAGE(PG8_SA(0, 0), cA, voffA); PG8_STAGE(PG8_SA(0, 1), cA + hstepA, voffA);
        if (wr == 1) PG8_BAR;
        PG8_WAIT_V(2); PG8_BAR;
        PG8_STAGE(PG8_SB(1, 0), cB + kstep, voffB); PG8_STAGE(PG8_SA(1, 0), cA + kstepA, voffA); PG8_STAGE(PG8_SB(1, 1), cB + hstep + kstep, voffB);
        PG8_WAIT_V(6); PG8_BAR;
    } else {
        PG8_STAGE(PG8_SB(0, 0), cB, voffB); PG8_STAGE(PG8_SA(0, 0), cA, voffA); PG8_STAGE(PG8_SB(0, 1), cB + hstep, voffB); PG8_STAGE(PG8_SA(0, 1), cA + hstepA, voffA);
        if (wr == 1) PG8_BAR;
        PG8_WAIT_V(4); PG8_BAR;
        PG8_STAGE(PG8_SB(1, 0), cB + kstep, voffB); PG8_STAGE(PG8_SA(1, 0), cA + kstepA, voffA); PG8_STAGE(PG8_SB(1, 1), cB + hstep + kstep, voffB);
        PG8_WAIT_V(6); PG8_BAR;
    }
    for (;;) {
        const bool has_next = S.next(ui + 1, nxt); nxt.par = (ui + 1) & 1;
        const char* nA = has_next ? (const char*)g.A + (size_t)nxt.pm * tstep + nxt.kh * khbA : cA; const char* nB = has_next ? (const char*)g.Bt + (size_t)nxt.pn * tstep + nxt.kh * khb : cB;
        for (int t = 0; t < nt; t += 2) {
            const bool last = (t == nt - 2);
            const char* a1 = cA + (size_t)(t + 1) * kstepA;
            const char* a2 = last ? nA : cA + (size_t)(t + 2) * kstepA; const char* b2 = last ? nB : cB + (size_t)(t + 2) * kstep;
            const char* a3 = a2 + kstepA; const char* b3 = b2 + kstep;
            if (last && has_next) { S.a_ready(nxt); if constexpr (Epi::PREF) E.prefetch(nxt, wid, lane); }
            if constexpr (SP2) {
            PG8_LDB(B0, 0, 0); PG8_LDB(B1, 0, 1); PG8_SCHED; PG8_LDA(At, 0, 0); PG8_STAGE(PG8_SA(1, 1), a1 + hstepA, voffA);
            PG8_WAIT_V(8); PG8_WAIT_L(0); PG8_BAR; PG8_MMA(0, 0, At, B0); PG8_MMA(0, 1, At, B1); PG8_BAR; PG8_SCHED;
            PG8_LDA(At, 0, 1); PG8_STAGE(PG8_SB(0, 0), b2, voffB); PG8_STAGE(PG8_SB(0, 1), b2 + hstep, voffB); PG8_STAGE(PG8_SA(0, 0), a2, voffA);
            PG8_WAIT_V(8); PG8_WAIT_L(0); PG8_BAR; PG8_MMA(1, 0, At, B0); PG8_MMA(1, 1, At, B1); PG8_BAR; PG8_SCHED;
            PG8_LDB(B0, 1, 0); PG8_LDB(B1, 1, 1); PG8_SCHED; PG8_LDA(At, 1, 0); PG8_STAGE(PG8_SA(0, 1), a2 + hstepA, voffA);
            PG8_WAIT_V(8); PG8_WAIT_L(0); PG8_BAR; PG8_MMA(0, 0, At, B0); PG8_MMA(0, 1, At, B1); PG8_BAR; PG8_SCHED;
            PG8_LDA(At, 1, 1); PG8_STAGE(PG8_SB(1, 0), b3, voffB); PG8_STAGE(PG8_SB(1, 1), b3 + hstep, voffB); PG8_STAGE(PG8_SA(1, 0), a3, voffA);
            PG8_WAIT_V(8); PG8_WAIT_L(0); PG8_BAR; PG8_MMA(1, 0, At, B0); PG8_MMA(1, 1, At, B1); PG8_BAR; PG8_SCHED;
            } else {
            PG8_LDB(B0, 0, 0); PG8_SCHED; PG8_LDA(At, 0, 0); PG8_STAGE(PG8_SA(1, 1), a1 + hstepA, voffA);
            PG8_WAIT_L(8); PG8_BAR; PG8_WAIT_L(0); PG8_MMA(0, 0, At, B0); PG8_BAR; PG8_SCHED;
            PG8_LDB(B1, 0, 1); PG8_STAGE(PG8_SB(0, 0), b2, voffB);
            PG8_BAR; PG8_WAIT_L(0); PG8_MMA(0, 1, At, B1); PG8_BAR;
            PG8_LDA(At, 0, 1); PG8_STAGE(PG8_SA(0, 0), a2, voffA);
            PG8_BAR; PG8_WAIT_L(0); PG8_MMA(1, 0, At, B0); PG8_BAR; PG8_SCHED;
            PG8_STAGE(PG8_SB(0, 1), b2 + hstep, voffB);
            PG8_WAIT_V(6); PG8_BAR; PG8_MMA(1, 1, At, B1); PG8_BAR;
            PG8_LDB(B0, 1, 0); PG8_SCHED; PG8_LDA(At, 1, 0); PG8_STAGE(PG8_SA(0, 1), a2 + hstepA, voffA);
            PG8_WAIT_L(8); PG8_BAR; PG8_WAIT_L(0); PG8_MMA(0, 0, At, B0); PG8_BAR; PG8_SCHED;
            PG8_LDB(B1, 1, 1); PG8_STAGE(PG8_SB(1, 0), b3, voffB);
            PG8_BAR; PG8_WAIT_L(0); PG8_MMA(0, 1, At, B1); PG8_BAR;
            PG8_LDA(At, 1, 1); PG8_STAGE(PG8_SA(1, 0), a3, voffA);
            PG8_BAR; PG8_WAIT_L(0); PG8_MMA(1, 0, At, B0); PG8_BAR; PG8_SCHED;
            PG8_STAGE(PG8_SB(1, 1), b3 + hstep, voffB);
            PG8_WAIT_V(6); PG8_BAR; PG8_MMA(1, 1, At, B1); PG8_BAR;
            }
        }
        if constexpr (ALIGN_EPI) { if (wr == 0) PG8_BAR; }
        if constexpr (!Epi::AFTER_DRAIN) { E(acc, cur, wr, wc, fr, fq); S.done(cur); }
        if (!has_next) break;
        if (!(Epi::MID && cur.kh == 0))
#pragma unroll
        for (int a = 0; a < 2; ++a)
#pragma unroll
            for (int b = 0; b < 2; ++b)
#pragma unroll
                for (int m = 0; m < 4; ++m)
#pragma unroll
                    for (int n = 0; n < 2; ++n) acc[a][b][m][n] = (f32x4){0.f, 0.f, 0.f, 0.f};
        cur = nxt; cA = nA; cB = nB; ++ui;
        if constexpr (ALIGN_EPI) { if (wr == 1) PG8_BAR; }
    }
    PG8_WAIT_V(0);
    if constexpr (!ALIGN_EPI) { if (wr == 0) PG8_BAR; }
    PG8_BAR;
    if constexpr (Epi::AFTER_DRAIN) { E.fused(acc, cur, wr, wc, fr, fq, lds, wid, lane); S.done(cur); }
#undef PG8_SA
#undef PG8_SB
#undef PG8_STAGE
#undef PG8_LDA
#undef PG8_LDB
#undef PG8_MMA
#undef PG8_WAIT_V
#undef PG8_WAIT_L
#undef PG8_BAR
#undef PG8_SCHED
}
}
constexpr int NWAVES = 8, NTHREADS = 512;
constexpr int DM = 2048, NB = 8, SEQ = 4096, MROWS = NB * SEQ, FF = 5632, PLE = 256;
constexpr int SSMW = 1024, NG = 64, GH = 16, NP = 64, SBW = 1024, NHEAD = 8, HD = 128, NIN = 4096;
constexpr size_t MiB = 1u << 20;
constexpr size_t WS_STAT = 0;
constexpr size_t WS_BAR = 960 * 1024;
constexpr int BAR_WORDS = 3456;
constexpr size_t WS_LAM8 = 1 * MiB;
constexpr size_t WS_SSMMAT = 2 * MiB;
constexpr size_t WS_WGU1 = 8 * MiB, WS_WD1 = 52 * MiB, WS_WIN = 74 * MiB, WS_WGLU = 90 * MiB, WS_WOUT = 92 * MiB, WS_WGU2 = 100 * MiB, WS_WD2 = 144 * MiB, WS_WPG = 166 * MiB, WS_WPP = 174 * MiB;
constexpr size_t WS_PB = 176 * MiB;
constexpr size_t WS_XB = 192 * MiB;
constexpr size_t WS_YMIX = 320 * MiB;
constexpr size_t WS_ACT = 448 * MiB;
constexpr size_t WS_UG = WS_ACT, WS_Q = WS_ACT + 64 * MiB, WS_K = WS_ACT + 128 * MiB, WS_V = WS_ACT + 192 * MiB, WS_Z = WS_ACT + 256 * MiB, WS_E = WS_ACT;
constexpr size_t WS_END = 800 * MiB;
enum { ST_SS1 = 0, ST_SS2, ST_SSM, ST_SB, ST_SS3, ST_SS4, ST_SSE, ST_N };
constexpr int RING_BYTES = 131072, XCH_OFF = RING_BYTES, LDS_BYTES = 147456;

#define GAS __attribute__((address_space(1)))
#define LAS __attribute__((address_space(3)))
typedef unsigned short bf16;
typedef unsigned v4u __attribute__((ext_vector_type(4)));
typedef unsigned v2u __attribute__((ext_vector_type(2)));
typedef float f32x4 __attribute__((ext_vector_type(4)));
typedef short bf16x8 __attribute__((ext_vector_type(8)));
#define LDS_WAIT() asm volatile("s_waitcnt lgkmcnt(0)" ::: "memory")
using pg8::cvt_pk_bf16;
__device__ __forceinline__ float wave_sum(float v) {
#pragma unroll
    for (int o = 1; o < 64; o <<= 1) v += __shfl_xor(v, o);
    return v;
}
__device__ __forceinline__ f32x4 mfma16(bf16x8 a, bf16x8 b, f32x4 c) { return __builtin_amdgcn_mfma_f32_16x16x32_bf16(a, b, c, 0, 0, 0); }

#ifndef MK_DUP
#define MK_DUP 0u
#endif
constexpr int P0_REP = 1 + (int)(MK_DUP & 1u), P4_REP = 1 + (int)((MK_DUP >> 4) & 1u);
__device__ __forceinline__ void tr_item(const float* W, int K, int N, const float* gain, bf16* WT, int k0, int n0, int dstrow, LAS float* scr, int lane, float f8s) {
    const int c4 = lane & 15, r0 = lane >> 4;
#pragma unroll 4
    for (int i = 0; i < 16; ++i) { const int kk = 4 * i + r0; f32x4 v = *(const GAS f32x4*)(W + (size_t)(k0 + kk) * N + n0 + 4 * c4); if (gain) v = v * gain[k0 + kk];
        *(LAS f32x4*)(scr + kk * 64 + 4 * (c4 ^ (2 * ((kk >> 3) & 7)))) = v; }
    LDS_WAIT(); asm volatile("" ::: "memory");
    const int c = lane & 7;
#pragma unroll
    for (int ps = 0; ps < 2; ++ps) { const int ng = (lane >> 3) + 8 * ps; f32x4 v[8];
#pragma unroll
        for (int j = 0; j < 8; ++j) v[j] = *(const LAS f32x4*)(scr + (8 * c + j) * 64 + 4 * (ng ^ (2 * c)));
#pragma unroll
        for (int i = 0; i < 4; ++i) {
            if (f8s != 0.f) { v2u o8; o8.x = pg8::pack4_fp8(v[0][i] * f8s, v[1][i] * f8s, v[2][i] * f8s, v[3][i] * f8s); o8.y = pg8::pack4_fp8(v[4][i] * f8s, v[5][i] * f8s, v[6][i] * f8s, v[7][i] * f8s);
                *(GAS v2u*)((GAS unsigned char*)WT + (size_t)(dstrow + 4 * ng + i) * K + k0 + 8 * c) = o8; continue; }
            v4u o; o.x = cvt_pk_bf16(v[0][i], v[1][i]); o.y = cvt_pk_bf16(v[2][i], v[3][i]); o.z = cvt_pk_bf16(v[4][i], v[5][i]); o.w = cvt_pk_bf16(v[6][i], v[7][i]);
            *(GAS v4u*)(WT + (size_t)(dstrow + 4 * ng + i) * K + k0 + 8 * c) = o; } }
    LDS_WAIT(); asm volatile("" ::: "memory");
}

struct In {
    const float *x, *p, *ffn1_norm, *ffn1_wg, *ffn1_wu, *ffn1_wd, *mix_norm, *w_in, *lam_re, *lam_im, *b_re, *b_im, *c_re, *c_im, *log_dt, *ssm_d, *w_glu, *b_glu, *q_norm, *k_norm,
        *on_ssm, *on_sb, *w_out, *ffn2_norm, *ffn2_wg, *ffn2_wu, *ffn2_wd, *ple_norm, *w_pg, *w_pp, *ple_post;
};

__device__ __forceinline__ void ssm_build(const In& in, unsigned char* ws, LAS unsigned char* lds, int g, int tid) {
    LAS float* PW = (LAS float*)lds;
    LAS float* CO = PW + 9 * 64 * 2;
    LAS float* CB = CO + 64 * 2;
    LAS float* KT = CB + 64 * 16 * 2;
    LAS float* CR = KT + 2048; LAS float* CI = CR + 1024;
    for (int i = tid; i < 1024; i += NTHREADS) { CR[i] = in.c_re[g * 1024 + i]; CI[i] = in.c_im[g * 1024 + i]; }
    if (tid < 64) {
        const int p = tid; const float dt = expf(in.log_dt[g]); const float lr = fminf(in.lam_re[g * 64 + p], -1e-4f), li = in.lam_im[g * 64 + p];
        const float a = lr * dt, th = li * dt; float s1, c1; sincosf(th, &s1, &c1); const float ea = expf(a);
        const float l1r = ea * c1, l1i = ea * s1;
        float pr = 1.f, pi = 0.f;
#pragma unroll
        for (int t = 0; t <= 8; ++t) { PW[(t * 64 + p) * 2] = pr; PW[(t * 64 + p) * 2 + 1] = pi; const float nr = pr * l1r - pi * l1i, ni = pr * l1i + pi * l1r; pr = nr; pi = ni; }
        float* l8 = (float*)(ws + WS_LAM8) + (g * 64 + p) * 2; l8[0] = PW[(8 * 64 + p) * 2]; l8[1] = PW[(8 * 64 + p) * 2 + 1];
        const float sh = sinf(0.5f * th); const float nr = expm1f(a) * c1 - 2.f * sh * sh, ni = l1i;
        const float den = 1.f / (lr * lr + li * li);
        CO[p * 2] = (nr * lr + ni * li) * den; CO[p * 2 + 1] = (ni * lr - nr * li) * den;
    }
    __syncthreads();
    for (int i = tid; i < 1024; i += NTHREADS) { const int p = i >> 4; const float br = in.b_re[g * 1024 + i], bi = in.b_im[g * 1024 + i], cr = CO[p * 2], ci = CO[p * 2 + 1];
        CB[i * 2] = cr * br - ci * bi; CB[i * 2 + 1] = cr * bi + ci * br; }
    __syncthreads();
    for (int i = tid; i < 2048; i += NTHREADS) { const int tau = i >> 8, h = (i >> 4) & 15, h2 = i & 15; float s = 0.f;
        for (int p = 0; p < 64; ++p) { const float cr = CR[h * 64 + p], ci = CI[h * 64 + p], pr = PW[(tau * 64 + p) * 2], pi = PW[(tau * 64 + p) * 2 + 1];
            const float wr = cr * pr - ci * pi, wi = cr * pi + ci * pr; s += wr * CB[(p * 16 + h2) * 2] - wi * CB[(p * 16 + h2) * 2 + 1]; }
        KT[i] = s; }
    __syncthreads();
    bf16* Ms = (bf16*)(ws + WS_SSMMAT) + (size_t)g * 3 * 16384; bf16* Mi = Ms + 16384; bf16* Mo = Mi + 16384;
    for (int i = tid; i < 16384; i += NTHREADS) { const int r = i >> 7, c = i & 127;
        { const int p = r & 63, s = c >> 4, h2 = c & 15; const float pr = PW[((7 - s) * 64 + p) * 2], pi = PW[((7 - s) * 64 + p) * 2 + 1], br = CB[(p * 16 + h2) * 2], bi = CB[(p * 16 + h2) * 2 + 1];
          const float v = (r < 64) ? (pr * br - pi * bi) : (pr * bi + pi * br); Ms[i] = (bf16)(cvt_pk_bf16(v, 0.f) & 0xffffu); }
        { const int t = r >> 4, h = r & 15, s = c >> 4, h2 = c & 15; float v = 0.f; if (s <= t) { v = KT[((t - s) * 16 + h) * 16 + h2]; if (r == c) v += in.ssm_d[g * 16 + h]; } Mi[i] = (bf16)(cvt_pk_bf16(v, 0.f) & 0xffffu); }
        { const int t = r >> 4, h = r & 15, p = c & 63; const float cr = CR[h * 64 + p], ci = CI[h * 64 + p], pr = PW[((t + 1) * 64 + p) * 2], pi = PW[((t + 1) * 64 + p) * 2 + 1];
          const float v = (c < 64) ? (cr * pr - ci * pi) : -(cr * pi + ci * pr); Mo[i] = (bf16)(cvt_pk_bf16(v, 0.f) & 0xffffu); }
    }
    __syncthreads();
}

__device__ __forceinline__ void p0_prologue(const In& in, float* out, unsigned char* ws, LAS unsigned char* lds, int tid, int lane, int wave) {
    const int G = gridDim.x, bx = blockIdx.x;
    if (bx == 0) { unsigned* bw = (unsigned*)(ws + WS_BAR); for (int i = tid; i < BAR_WORDS; i += NTHREADS) bw[i] = 0u; }
    for (int g = bx; g < NG; g += G) ssm_build(in, ws, lds, g, tid);
    { float* st = (float*)(ws + WS_STAT) + MROWS; for (int i = bx * NTHREADS + tid; i < (ST_N - 1) * MROWS; i += G * NTHREADS) st[i] = 0.f; }
    LAS float* scr = (LAS float*)(lds + wave * 16384);
    const int gw = bx * NWAVES + wave, NGW = G * NWAVES;
    constexpr int I_GU = (DM / 64) * (FF / 64), I_D = (FF / 64) * (DM / 64), I_IN = (DM / 64) * (NIN / 64), I_GLU = (SSMW / 64) * (SSMW / 64), I_SQ = (DM / 64) * (DM / 64), I_PP = (PLE / 64) * (DM / 64);
    constexpr int NITEMS = 4 * I_GU + 2 * I_D + I_IN + I_GLU + 2 * I_SQ + I_PP;
#define TR_ITEM(NI, Wp, Kd, Nd, gainp, dstoff, MODE, F8S) \
        if (r < (NI)) { const int nbk = (Nd) / 64, kb = r / nbk, nb = r % nbk, k0 = 64 * kb, n0 = 64 * nb; \
            const int dr = (MODE) == 0 ? n0 : (n0 / 128) * 256 + (n0 % 128) + ((MODE) == 2 ? 128 : 0); \
            tr_item((Wp), (Kd), (Nd), (gainp), (bf16*)(ws + (dstoff)), k0, n0, dr, scr, lane, (F8S)); continue; } r -= (NI);
    for (int it = gw; it < NITEMS * P0_REP; it += NGW) {
        int r = it % NITEMS;
        TR_ITEM(I_GU, in.ffn1_wg, DM, FF, in.ffn1_norm, WS_WGU1, 1, 0.f)
        TR_ITEM(I_GU, in.ffn1_wu, DM, FF, in.ffn1_norm, WS_WGU1, 2, 0.f)
        TR_ITEM(I_D, in.ffn1_wd, FF, DM, (const float*)nullptr, WS_WD1, 0, 0.f)
        TR_ITEM(I_IN, in.w_in, DM, NIN, in.mix_norm, WS_WIN, 0, 0.f)
        TR_ITEM(I_GLU, in.w_glu, SSMW, SSMW, (const float*)nullptr, WS_WGLU, 0, 0.f)
        TR_ITEM(I_SQ, in.w_out, DM, DM, (k0 < 1024 ? in.on_ssm : in.on_sb - 1024), WS_WOUT, 0, 0.f)
        TR_ITEM(I_GU, in.ffn2_wg, DM, FF, in.ffn2_norm, WS_WGU2, 1, 0.f)
        TR_ITEM(I_GU, in.ffn2_wu, DM, FF, in.ffn2_norm, WS_WGU2, 2, 0.f)
        TR_ITEM(I_D, in.ffn2_wd, FF, DM, (const float*)nullptr, WS_WD2, 0, pg8::F8_W_SCALE)
        TR_ITEM(I_SQ, in.w_pg, DM, DM, in.ple_norm, WS_WPG, 0, 0.f)
        TR_ITEM(I_PP, in.w_pp, PLE, DM, (const float*)nullptr, WS_WPP, 0, 0.f)
    }
#undef TR_ITEM
    { bf16* XB = (bf16*)(ws + WS_XB); float* ss1 = (float*)(ws + WS_STAT) + ST_SS1 * MROWS;
      for (int mm = gw; mm < MROWS * P0_REP; mm += NGW) { const int m = mm % MROWS; const GAS f32x4* xr = (const GAS f32x4*)(in.x + (size_t)m * DM) + lane; GAS v2u* o = (GAS v2u*)(XB + (size_t)m * DM) + lane; float s = 0.f;
#pragma unroll
          for (int j = 0; j < 8; ++j) { const f32x4 v = xr[64 * j]; s += (v.x * v.x + v.y * v.y) + (v.z * v.z + v.w * v.w); v2u w; w.x = cvt_pk_bf16(v.x, v.y); w.y = cvt_pk_bf16(v.z, v.w); o[64 * j] = w; }
          s = wave_sum(s); if (lane == 0) ss1[m] = s; } }
    { const GAS f32x4* ps = (const GAS f32x4*)in.p; GAS v2u* o = (GAS v2u*)(ws + WS_PB);
      for (int i = bx * NTHREADS + tid; i < MROWS * PLE / 4; i += G * NTHREADS) { const f32x4 v = ps[i]; v2u w; w.x = cvt_pk_bf16(v.x, v.y); w.y = cvt_pk_bf16(v.z, v.w); o[i] = w; } }
}

constexpr int SSM_DROW = 132, SSM_SROW = 136;
__device__ __forceinline__ void ssm_unit(unsigned char* ws, LAS unsigned char* lds, int b, int g, int lane, int wave) {
    const int r16 = lane & 15, q4 = lane >> 4;
    LAS float* DL = (LAS float*)lds; LAS bf16* S0 = (LAS bf16*)(lds + 64 * SSM_DROW * 4);
    const bf16* Ms = (const bf16*)(ws + WS_SSMMAT) + (size_t)g * 3 * 16384; const bf16* Mi = Ms + 16384; const bf16* Mo = Mi + 16384;
    bf16x8 aS[4], aI[4], aO[4];
#pragma unroll
    for (int ks = 0; ks < 4; ++ks) { const int o = (16 * wave + r16) * 128 + 32 * ks + 8 * q4; aS[ks] = *(const bf16x8*)(Ms + o); aI[ks] = *(const bf16x8*)(Mi + o); aO[ks] = *(const bf16x8*)(Mo + o); }
    const bf16* ug = (const bf16*)(ws + WS_UG) + (size_t)(b * 64 + g) * 4096 * 16;
    bf16* zb = (bf16*)(ws + WS_Z) + (size_t)b * 4096 * 1024 + g * 16;
    const float* l8 = (const float*)(ws + WS_LAM8) + (g * 64 + lane) * 2; const float l8r = l8[0], l8i = l8[1];
    float sre = 0.f, sim = 0.f;
    bf16x8 bu[4][4];
#define SSM_LOADU(SEG) do { _Pragma("unroll") for (int nt = 0; nt < 4; ++nt) { const int n = 64 * (SEG) + 16 * nt + r16; _Pragma("unroll") for (int ks = 0; ks < 4; ++ks) \
        bu[nt][ks] = *(const bf16x8*)(ug + (size_t)(n * 8 + 2 * ks + (q4 >> 1)) * 16 + 8 * (q4 & 1)); } } while (0)
    SSM_LOADU(0);
    for (int seg = 0; seg < 8; ++seg) {
        f32x4 ay[4];
#pragma unroll
        for (int nt = 0; nt < 4; ++nt) { f32x4 acc = {0.f, 0.f, 0.f, 0.f}, accy = {0.f, 0.f, 0.f, 0.f};
#pragma unroll
            for (int ks = 0; ks < 4; ++ks) { acc = mfma16(aS[ks], bu[nt][ks], acc); accy = mfma16(aI[ks], bu[nt][ks], accy); }
            *(LAS f32x4*)(DL + (16 * nt + r16) * SSM_DROW + 16 * wave + 4 * q4) = acc; ay[nt] = accy; }
        if (seg < 7) SSM_LOADU(seg + 1);
        __syncthreads();
        if (wave == 0) {
            for (int nb = 0; nb < 64; nb += 8) {
                float dr[8], di[8];
#pragma unroll
                for (int j = 0; j < 8; ++j) { dr[j] = DL[(nb + j) * SSM_DROW + lane]; di[j] = DL[(nb + j) * SSM_DROW + 64 + lane]; }
#pragma unroll
                for (int j = 0; j < 8; ++j) { S0[(nb + j) * SSM_SROW + lane] = (bf16)(cvt_pk_bf16(sre, 0.f) & 0xffffu); S0[(nb + j) * SSM_SROW + 64 + lane] = (bf16)(cvt_pk_bf16(sim, 0.f) & 0xffffu);
                    const float nr = l8r * sre - l8i * sim + dr[j], ni = l8r * sim + l8i * sre + di[j]; sre = nr; sim = ni; } }
        }
        __syncthreads();
#pragma unroll
        for (int nt = 0; nt < 4; ++nt) { const int n = 64 * seg + 16 * nt + r16; f32x4 acc = ay[nt];
            bf16x8 bs[4];
#pragma unroll
            for (int ks = 0; ks < 4; ++ks) bs[ks] = *(const LAS bf16x8*)(S0 + (16 * nt + r16) * SSM_SROW + 32 * ks + 8 * q4);
#pragma unroll
            for (int ks = 0; ks < 4; ++ks) acc = mfma16(aO[ks], bs[ks], acc);
            f32x4 z;
#pragma unroll
            for (int e = 0; e < 4; ++e) { const float y = acc[e]; const float t = 1.5957691216057308f * (y + 0.044715f * y * y * y); z[e] = y * __builtin_amdgcn_rcpf(1.0f + __builtin_amdgcn_exp2f(-1.4426950408889634f * t)); }
            v2u w; w.x = cvt_pk_bf16(z[0], z[1]); w.y = cvt_pk_bf16(z[2], z[3]);
            *(v2u*)(zb + (size_t)(n * 8 + wave) * 1024 + 4 * q4) = w; }
    }
#undef SSM_LOADU
    __syncthreads();
}

constexpr int AT_KROW = 136, AT_VROW = 152, AT_SROW = 68, AT_PROW = 72;
constexpr int AT_KB = 64 * AT_KROW * 2, AT_VB = 64 * AT_VROW * 2, AT_BUF = AT_KB + AT_VB;
constexpr int AT_S_OFF = 2 * AT_BUF, AT_P_OFF = AT_S_OFF + 8 * 16 * AT_SROW * 4, AT_FLAG_OFF = AT_P_OFF + 8 * 16 * AT_PROW * 2;
static_assert(AT_FLAG_OFF + 64 <= RING_BYTES, "attention LDS");
constexpr float AT_THR = -152.0f;
typedef short s16x4 __attribute__((ext_vector_type(4)));
__device__ __forceinline__ s16x4 lds_tr(const LAS bf16* p) { return __builtin_bit_cast(s16x4, __builtin_amdgcn_ds_read_tr16_b64_v4i16((LAS s16x4*)p)); }
__device__ __forceinline__ void attn_unit(unsigned char* ws, LAS unsigned char* lds, int b, int h, int qb, int tid, int lane, int wave, bool do_ss) {
    const int r16 = lane & 15, q4 = lane >> 4;
    LAS float* Sw = (LAS float*)(lds + AT_S_OFF) + wave * 16 * AT_SROW; LAS bf16* Pw = (LAS bf16*)(lds + AT_P_OFF) + wave * 16 * AT_PROW;
    volatile LAS unsigned* flag = (volatile LAS unsigned*)(lds + AT_FLAG_OFF);
    const bf16* Qg = (const bf16*)(ws + WS_Q) + (size_t)b * SEQ * 1024 + h * 128;
    const bf16* Kg = (const bf16*)(ws + WS_K) + (size_t)b * SEQ * 1024 + h * 128;
    const bf16* Vg = (const bf16*)(ws + WS_V) + (size_t)b * SEQ * 1024 + h * 128;
    const int qw0 = 128 * qb + 16 * wave, qrow = qw0 + r16;
    bf16x8 qf[4];
#pragma unroll
    for (int ks = 0; ks < 4; ++ks) qf[ks] = *(const bf16x8*)(Qg + (size_t)qrow * 1024 + 32 * ks + 8 * q4);
    f32x4 o[8];
#pragma unroll
    for (int i = 0; i < 8; ++i) o[i] = (f32x4){0.f, 0.f, 0.f, 0.f};
    float carry = 0.f; bool done = false;
    const int pr0 = tid >> 4, pc = tid & 15;
    v4u kr[2], vr[2];
    int kt = 2 * qb + 1, buf = 0, it = 0;
#define AT_LOAD(KT) do { _Pragma("unroll") for (int i = 0; i < 2; ++i) { const size_t go = (size_t)(64 * (KT) + pr0 + 32 * i) * 1024 + 8 * pc; kr[i] = *(const v4u*)(Kg + go); vr[i] = *(const v4u*)(Vg + go); } } while (0)
#define AT_STAGE(B) do { _Pragma("unroll") for (int i = 0; i < 2; ++i) { const int row = pr0 + 32 * i; *(LAS v4u*)((LAS bf16*)(lds + (B) * AT_BUF) + row * AT_KROW + 8 * pc) = kr[i]; \
        *(LAS v4u*)((LAS bf16*)(lds + (B) * AT_BUF + AT_KB) + row * AT_VROW + 8 * pc) = vr[i]; } } while (0)
    AT_LOAD(kt); AT_STAGE(0);
    if (kt > 0) AT_LOAD(kt - 1);
    __syncthreads();
    for (;;) {
        const LAS bf16* Ks = (const LAS bf16*)(lds + buf * AT_BUF); const LAS bf16* Vs = (const LAS bf16*)(lds + buf * AT_BUF + AT_KB);
        const int j0 = 64 * kt;
        if (!done && j0 < qw0 + 15) {
            {
                bf16x8 ak[2][4];
#pragma unroll
                for (int ks = 0; ks < 4; ++ks) ak[0][ks] = *(const LAS bf16x8*)(Ks + r16 * AT_KROW + 32 * ks + 8 * q4);
#pragma unroll
                for (int t4 = 0; t4 < 4; ++t4) {
                    if (t4 < 3) {
#pragma unroll
                        for (int ks = 0; ks < 4; ++ks) ak[(t4 + 1) & 1][ks] = *(const LAS bf16x8*)(Ks + (16 * (t4 + 1) + r16) * AT_KROW + 32 * ks + 8 * q4); }
                    __builtin_amdgcn_sched_barrier(0);
                    f32x4 acc = {0.f, 0.f, 0.f, 0.f};
#pragma unroll
                    for (int ks = 0; ks < 4; ++ks) acc = mfma16(ak[t4 & 1][ks], qf[ks], acc);
                    *(LAS f32x4*)(Sw + r16 * AT_SROW + 16 * t4 + 4 * q4) = acc;
                    __builtin_amdgcn_sched_barrier(0); } }
            LDS_WAIT(); __builtin_amdgcn_wave_barrier();
            float lk[16], ls[16];
#pragma unroll
            for (int c = 0; c < 4; ++c) { const f32x4 sv = *(const LAS f32x4*)(Sw + r16 * AT_SROW + 16 * q4 + 4 * c);
#pragma unroll
                for (int e = 0; e < 4; ++e) { const float z2 = sv[e]; const float az = __builtin_fabsf(z2); const float ex = __builtin_amdgcn_exp2f(-az); const float sp = fmaxf(z2, 0.f) + __builtin_amdgcn_logf(1.0f + ex);
                    const bool valid = (j0 + 16 * q4 + 4 * c + e) < qrow; lk[4 * c + e] = valid ? -sp : 0.f; ls[4 * c + e] = valid ? (z2 - sp) : -1.0e30f; } }
            float run = 0.f, ps[16];
#pragma unroll
            for (int i = 15; i >= 0; --i) { ps[i] = run; run += lk[i]; }
            const float t0 = __shfl(run, r16), t1 = __shfl(run, r16 + 16), t2 = __shfl(run, r16 + 32), t3 = __shfl(run, r16 + 48);
            const float offs = (q4 < 1 ? t1 : 0.f) + (q4 < 2 ? t2 : 0.f) + (q4 < 3 ? t3 : 0.f);
            const float base = carry + offs;
            float wv[16];
#pragma unroll
            for (int i = 0; i < 16; ++i) wv[i] = __builtin_amdgcn_exp2f(ls[i] + ps[i] + base);
            carry += (t0 + t1) + (t2 + t3);
            v4u p0, p1;
            p0.x = cvt_pk_bf16(wv[0], wv[1]); p0.y = cvt_pk_bf16(wv[2], wv[3]); p0.z = cvt_pk_bf16(wv[4], wv[5]); p0.w = cvt_pk_bf16(wv[6], wv[7]);
            p1.x = cvt_pk_bf16(wv[8], wv[9]); p1.y = cvt_pk_bf16(wv[10], wv[11]); p1.z = cvt_pk_bf16(wv[12], wv[13]); p1.w = cvt_pk_bf16(wv[14], wv[15]);
            *(LAS v4u*)(Pw + r16 * AT_PROW + 16 * q4) = p0; *(LAS v4u*)(Pw + r16 * AT_PROW + 16 * q4 + 8) = p1;
            LDS_WAIT(); __builtin_amdgcn_wave_barrier();
            bf16x8 bp[2];
#pragma unroll
            for (int ks = 0; ks < 2; ++ks) bp[ks] = *(const LAS bf16x8*)(Pw + r16 * AT_PROW + 32 * ks + 8 * q4);
            const LAS bf16* vb = Vs + (8 * q4 + (r16 >> 2)) * AT_VROW + 4 * (r16 & 3);
            {
                s16x4 vlo[2][2], vhi[2][2];
#pragma unroll
                for (int ks = 0; ks < 2; ++ks) { vlo[0][ks] = lds_tr(vb + 32 * ks * AT_VROW); vhi[0][ks] = lds_tr(vb + (32 * ks + 4) * AT_VROW); }
#pragma unroll
                for (int dt = 0; dt < 8; ++dt) {
                    if (dt < 7) {
#pragma unroll
                        for (int ks = 0; ks < 2; ++ks) { vlo[(dt + 1) & 1][ks] = lds_tr(vb + 32 * ks * AT_VROW + 16 * (dt + 1)); vhi[(dt + 1) & 1][ks] = lds_tr(vb + (32 * ks + 4) * AT_VROW + 16 * (dt + 1)); } }
                    __builtin_amdgcn_sched_barrier(0);
#pragma unroll
                    for (int ks = 0; ks < 2; ++ks) { const bf16x8 av = __builtin_shufflevector(vlo[dt & 1][ks], vhi[dt & 1][ks], 0, 1, 2, 3, 4, 5, 6, 7); o[dt] = mfma16(av, bp[ks], o[dt]); }
                    __builtin_amdgcn_sched_barrier(0); } }
            done = __all(carry < AT_THR);
        }
        if (kt > 0) { AT_STAGE(buf ^ 1); if (kt > 1) AT_LOAD(kt - 2); }
        if (lane == 0) flag[(it & 1) * 8 + wave] = (!done && kt > 0) ? 1u : 0u;
        __syncthreads();
        unsigned any = 0;
#pragma unroll
        for (int i = 0; i < 8; ++i) any |= flag[(it & 1) * 8 + i];
        if (!any) break;
        --kt; buf ^= 1; ++it;
    }
#undef AT_LOAD
#undef AT_STAGE
    bf16* Y = (bf16*)(ws + WS_YMIX) + (size_t)(b * SEQ + qrow) * 2048 + 1024 + h * 128 + 4 * q4;
    float q = 0.f;
#pragma unroll
    for (int dt = 0; dt < 8; ++dt) { v2u w; w.x = cvt_pk_bf16(o[dt][0], o[dt][1]); w.y = cvt_pk_bf16(o[dt][2], o[dt][3]); *(v2u*)(Y + 16 * dt) = w; q += (o[dt][0] * o[dt][0] + o[dt][1] * o[dt][1]) + (o[dt][2] * o[dt][2] + o[dt][3] * o[dt][3]); }
    q += __shfl_xor(q, 16); q += __shfl_xor(q, 32);
    if (q4 == 0 && do_ss) atomicAdd((float*)(ws + WS_STAT) + ST_SB * MROWS + b * SEQ + qrow, q);
    __syncthreads();
}

#define XB_TMO      128
#define XB_XCNT(j)  (256  + 64 * (j))
#define XB_XSUB(j)  (1280 + 64 * (j))
#define XB_XGEN(j)  (2304 + 64 * (j))
#define XB_TOP      3328
#define XB_TOPGEN   3392
#define XCD_BAR_WORDS 3456
#define XB_SPIN_CAP (1u << 18)

__device__ __forceinline__ unsigned xb_ld(unsigned* p)              { return __hip_atomic_load(p, __ATOMIC_RELAXED, __HIP_MEMORY_SCOPE_AGENT); }
__device__ __forceinline__ unsigned xb_add(unsigned* p, unsigned v) { return __hip_atomic_fetch_add(p, v, __ATOMIC_RELAXED, __HIP_MEMORY_SCOPE_AGENT); }
__device__ __forceinline__ unsigned xb_xcc_id() { return (unsigned)__builtin_amdgcn_s_getreg((3 << 11) | 20) & 0xFu; }
#define XB_SPIN(cond, bar) do { unsigned _sp = 0; while (cond) { __builtin_amdgcn_s_sleep(1); \
    if ((++_sp & 255u) == 0u) { if (xb_ld(&(bar)[XB_TMO])) break; if (_sp > XB_SPIN_CAP) { atomicAdd(&(bar)[XB_TMO], 1u); break; } } } } while (0)

struct XcdBarrier {
    unsigned* bar; unsigned x;
    volatile LAS unsigned* st;
};

__device__ __forceinline__ XcdBarrier xcd_barrier_post(unsigned* bar, volatile LAS unsigned* st) {
    XcdBarrier b; b.bar = bar; b.x = xb_xcc_id(); b.st = st;
    if (threadIdx.x == 0) (void)xb_add(&bar[XB_XCNT(b.x)], 1u);
    return b;
}
__device__ __forceinline__ void xcd_barrier_complete(unsigned* bar, unsigned x, unsigned& nloc, unsigned& nx) {
    const unsigned G = gridDim.x * gridDim.y * gridDim.z;
    unsigned sum, cnt, mine, sp = 0u;
    for (;;) {
        sum = 0u; cnt = 0u; mine = 0u;
#pragma unroll
        for (unsigned j = 0; j < 16; ++j) { const unsigned c = xb_ld(&bar[XB_XCNT(j)]); sum += c; cnt += (c > 0u) ? 1u : 0u; mine = (j == x) ? c : mine; }
        if (sum == G) break;
        __builtin_amdgcn_s_sleep(1);
        if ((++sp & 255u) == 0u) { if (xb_ld(&bar[XB_TMO])) break; if (sp > XB_SPIN_CAP) { atomicAdd(&bar[XB_TMO], 1u); break; } }
    }
    nloc = mine > 0u ? mine : 1u; nx = cnt > 0u ? cnt : 1u;
}

__device__ __forceinline__ void xcd_barrier(const XcdBarrier& b) {
    asm volatile("s_waitcnt vmcnt(0)" ::: "memory");
    __syncthreads();
    if (threadIdx.x == 0) {
        unsigned* bar = b.bar;
        __builtin_amdgcn_s_waitcnt(0);
        unsigned nloc = b.st[0], nx = b.st[1];
        if (nloc == 0u) { xcd_barrier_complete(bar, b.x, nloc, nx); b.st[0] = nloc; b.st[1] = nx; }
        const unsigned old = xb_add(&bar[XB_XSUB(b.x)], 1u);
        const unsigned gen = old / nloc;
        if (old + 1u == (gen + 1u) * nloc) {
            __builtin_amdgcn_fence(__ATOMIC_RELEASE, "agent");
            asm volatile("s_waitcnt vmcnt(0)" ::: "memory");
            const unsigned og = xb_add(&bar[XB_TOP], 1u);
            const unsigned tg = og / nx;
            if (og + 1u == (tg + 1u) * nx) xb_add(&bar[XB_TOPGEN], 1u);
            else XB_SPIN(xb_ld(&bar[XB_TOPGEN]) == tg, bar);
            __builtin_amdgcn_fence(__ATOMIC_ACQUIRE, "agent");
            xb_add(&bar[XB_XGEN(b.x)], 1u);
            asm volatile("s_waitcnt vmcnt(0)" ::: "memory");
        } else {
            XB_SPIN(xb_ld(&bar[XB_XGEN(b.x)]) == gen, bar);
            __builtin_amdgcn_fence(__ATOMIC_ACQUIRE, "agent");
            asm volatile("s_waitcnt vmcnt(0)" ::: "memory");
        }
    }
    __syncthreads();
}

static_assert(BAR_WORDS == XCD_BAR_WORDS, "barrier words");
struct Args { const float* in[31]; float* out; unsigned char* ws; };
#ifndef MK_PHASE_MASK
#define MK_PHASE_MASK 0xFFFFFFFFu
#endif
__global__ void __launch_bounds__(NTHREADS, 2) mk_fwd(Args args) {
    extern __shared__ __attribute__((aligned(16))) unsigned char lds_raw[];
    LAS unsigned char* lds = (LAS unsigned char*)lds_raw;
    cg::grid_group grid = cg::this_grid();
    volatile LAS unsigned* bar_st = (volatile LAS unsigned*)(lds + XCH_OFF + 12288);
    if (threadIdx.x < 2) bar_st[threadIdx.x] = 0u;
    __syncthreads();
    const int wave_s = __builtin_amdgcn_readfirstlane(threadIdx.x >> 6);
#define FRESH_IDS unsigned ones_ = ~0u; asm volatile("" : "+s"(ones_)); const int lane = (int)__builtin_amdgcn_mbcnt_hi(ones_, __builtin_amdgcn_mbcnt_lo(ones_, 0u)), wave = wave_s, tid = wave * 64 + lane; (void)tid; (void)lane; (void)wave;
    const int G = gridDim.x, bx = blockIdx.x;
    unsigned char* ws = args.ws; float* out = args.out;
    In in;
    in.x = args.in[0]; in.p = args.in[1]; in.ffn1_norm = args.in[2]; in.ffn1_wg = args.in[3]; in.ffn1_wu = args.in[4]; in.ffn1_wd = args.in[5]; in.mix_norm = args.in[6]; in.w_in = args.in[7];
    in.lam_re = args.in[8]; in.lam_im = args.in[9]; in.b_re = args.in[10]; in.b_im = args.in[11]; in.c_re = args.in[12]; in.c_im = args.in[13]; in.log_dt = args.in[14]; in.ssm_d = args.in[15];
    in.w_glu = args.in[16]; in.b_glu = args.in[17]; in.q_norm = args.in[18]; in.k_norm = args.in[19]; in.on_ssm = args.in[20]; in.on_sb = args.in[21]; in.w_out = args.in[22];
    in.ffn2_norm = args.in[23]; in.ffn2_wg = args.in[24]; in.ffn2_wu = args.in[25]; in.ffn2_wd = args.in[26]; in.ple_norm = args.in[27]; in.w_pg = args.in[28]; in.w_pp = args.in[29]; in.ple_post = args.in[30];
    float* stat = (float*)(ws + WS_STAT);
    bf16* XB = (bf16*)(ws + WS_XB); bf16* ACT = (bf16*)(ws + WS_ACT); bf16* YMIX = (bf16*)(ws + WS_YMIX);
#define PH(k) ((MK_PHASE_MASK >> (k)) & 1u)
#ifndef MK_DUP
#define MK_DUP 0u
#endif
#define NREP(k) (1 + (int)((MK_DUP >> (k)) & 1u))

    { FRESH_IDS p0_prologue(in, out, ws, lds, tid, lane, wave); }
    grid.sync();
    const XcdBarrier xbar = xcd_barrier_post((unsigned*)(ws + WS_BAR), bar_st);
    for (int rep_ = 0; rep_ < NREP(1); ++rep_) { pg8::Gemm g{XB, (const bf16*)(ws + WS_WGU1), MROWS, 2 * FF, DM, DM}; pg8::StaticOrder S; S.init(MROWS, 2 * FF, G, bx);
        pg8::EpiSwiGLU<false> E{ACT, stat + ST_SS1 * MROWS, FF, (LAS float*)(lds + XCH_OFF)}; pg8::gemm_phase<pg8::EpiSwiGLU<false>, pg8::StaticOrder, true, true>(lds, g, S, E, wave_s); }
    xcd_barrier(xbar);
    for (int rep_ = 0; rep_ < NREP(2); ++rep_) { pg8::Gemm g{ACT, (const bf16*)(ws + WS_WD1), MROWS, DM, FF, FF}; pg8::StaticOrder S; S.init(MROWS, DM, G, bx);
        pg8::EpiResid<0, false> E{nullptr, XB, (rep_ + 1 < NREP(2)) ? nullptr : stat + ST_SS2 * MROWS, nullptr, nullptr, 0.5f}; pg8::gemm_phase<pg8::EpiResid<0, false>, pg8::StaticOrder, true, true, true>(lds, g, S, E, wave_s); }
    xcd_barrier(xbar);
    for (int rep_ = 0; rep_ < NREP(3); ++rep_) { pg8::Gemm g{XB, (const bf16*)(ws + WS_WIN), MROWS, NIN, DM, DM}; pg8::StaticOrder S; S.init(MROWS, NIN, G, bx);
        pg8::EpiWin E{stat + ST_SS2 * MROWS, (bf16*)(ws + WS_UG), (bf16*)(ws + WS_Q), (bf16*)(ws + WS_K), (bf16*)(ws + WS_V), in.q_norm, in.k_norm, (LAS float*)(lds + XCH_OFF)};
        pg8::gemm_phase<pg8::EpiWin, pg8::StaticOrder, true, true>(lds, g, S, E, wave_s); }
    xcd_barrier(xbar);
    { FRESH_IDS
        for (int itt = bx; itt < (512 + 2048) * P4_REP; itt += G) { const int it = itt % (512 + 2048);
            if (it < 512) ssm_unit(ws, lds, it >> 6, it & 63, lane, wave);
            else { const int a = it - 512; attn_unit(ws, lds, a >> 8, (a >> 5) & 7, a & 31, tid, lane, wave, itt >= (512 + 2048) * (P4_REP - 1)); }
        }
    }
    xcd_barrier(xbar);
    if (PH(5)) { pg8::Gemm g{(const bf16*)(ws + WS_Z), (const bf16*)(ws + WS_WGLU), MROWS, SSMW, SSMW, SSMW}; pg8::StaticOrder S; S.init(MROWS, SSMW, G, bx);
        pg8::EpiGlu E{(const bf16*)(ws + WS_Z), in.b_glu, YMIX, stat + ST_SSM * MROWS}; pg8::gemm_phase<pg8::EpiGlu, pg8::StaticOrder, true, true>(lds, g, S, E, wave_s); }
    xcd_barrier(xbar);
    if (PH(6)) { pg8::Gemm g{YMIX, (const bf16*)(ws + WS_WOUT), MROWS, DM, DM, DM / 2}; pg8::SplitOrder S; S.base.init(MROWS, DM, G, bx);
        pg8::EpiResid<1, false> E{nullptr, XB, stat + ST_SS3 * MROWS, stat + ST_SSM * MROWS, stat + ST_SB * MROWS, 0.f}; pg8::gemm_phase<pg8::EpiResid<1, false>, pg8::SplitOrder, true, true>(lds, g, S, E, wave_s); }
    xcd_barrier(xbar);
    if (PH(7)) { pg8::Gemm g{XB, (const bf16*)(ws + WS_WGU2), MROWS, 2 * FF, DM, DM}; pg8::StaticOrder S; S.init(MROWS, 2 * FF, G, bx);
        pg8::EpiSwiGLU<true> E{ACT, stat + ST_SS3 * MROWS, FF, (LAS float*)(lds + XCH_OFF)}; pg8::gemm_phase<pg8::EpiSwiGLU<true>, pg8::StaticOrder, true, true>(lds, g, S, E, wave_s); }
    xcd_barrier(xbar);
    if (PH(8)) { pg8::Gemm g{ACT, (const bf16*)(ws + WS_WD2), MROWS, DM, FF / 2, FF / 2}; pg8::StaticOrder S; S.init(MROWS, DM, G, bx);
        pg8::EpiResid<0, false, false> E{nullptr, XB, stat + ST_SS4 * MROWS, nullptr, nullptr, 0.5f / (pg8::F8_ACT_SCALE * pg8::F8_W_SCALE)}; pg8::gemm_phase<pg8::EpiResid<0, false, false>, pg8::StaticOrder, true, true, true, true>(lds, g, S, E, wave_s); }
    xcd_barrier(xbar);
    if (PH(9)) { pg8::Gemm g{(const bf16*)(ws + WS_PB), (const bf16*)(ws + WS_WPP), MROWS, DM, PLE, PLE}; pg8::StaticOrder S; S.init(MROWS, DM, G, bx);
        pg8::EpiPlain E{YMIX, DM}; pg8::gemm_phase<pg8::EpiPlain, pg8::StaticOrder, true, true>(lds, g, S, E, wave_s); }
    asm volatile("s_waitcnt vmcnt(0)" ::: "memory"); __syncthreads();
    if (PH(10)) { pg8::Gemm g{XB, (const bf16*)(ws + WS_WPG), MROWS, DM, DM, DM}; pg8::StaticOrder S; S.init(MROWS, DM, G, bx);
        pg8::EpiPle E{YMIX, stat + ST_SS4 * MROWS, (bf16*)(ws + WS_E), stat + ST_SSE * MROWS}; pg8::gemm_phase<pg8::EpiPle, pg8::StaticOrder, true, true>(lds, g, S, E, wave_s); }
    xcd_barrier(xbar);
    if (PH(11)) { FRESH_IDS const bf16* E = (const bf16*)(ws + WS_E); const float* sse = stat + ST_SSE * MROWS; const int gw = bx * NWAVES + wave, NGW = G * NWAVES;
        for (int m = gw; m < MROWS; m += NGW) { const float r = pg8::rstd_of(sse[m], 1.0f / 2048.0f); GAS f32x4* xr = (GAS f32x4*)(out + (size_t)m * DM) + lane; const GAS v2u* xbr = (const GAS v2u*)(XB + (size_t)m * DM) + lane; const GAS v2u* er = (const GAS v2u*)(E + (size_t)m * DM) + lane;
            const GAS f32x4* gp = (const GAS f32x4*)in.ple_post + lane;
#pragma unroll
            for (int j = 0; j < 8; ++j) { const v2u xw = xbr[64 * j]; const v2u w = er[64 * j]; const f32x4 gg = gp[64 * j]; f32x4 v;
                v.x = pg8::bf_lo(xw.x) + pg8::bf_lo(w.x) * r * gg.x; v.y = pg8::bf_hi(xw.x) + pg8::bf_hi(w.x) * r * gg.y; v.z = pg8::bf_lo(xw.y) + pg8::bf_lo(w.y) * r * gg.z; v.w = pg8::bf_hi(xw.y) + pg8::bf_hi(w.y) * r * gg.w; xr[64 * j] = v; } } }
#undef PH
}

extern "C" void kernel_launch(void* const* d_in, const int* in_sizes, int n_in, void* d_out, int out_size, void* d_ws, size_t ws_size, hipStream_t stream) {
    static int grid = 0;
    if (grid == 0) {
        if (n_in != 31 || out_size != MROWS * DM || ws_size < WS_END) { fprintf(stderr, "kernel_launch: unexpected shapes (n_in %d, out %d, ws %zu)\n", n_in, out_size, ws_size); grid = -1; return; }
        int dev = 0, cus = 0, per_cu = 0;
        hipGetDevice(&dev); hipDeviceGetAttribute(&cus, hipDeviceAttributeMultiprocessorCount, dev);
        if (hipFuncSetAttribute((const void*)mk_fwd, hipFuncAttributeMaxDynamicSharedMemorySize, LDS_BYTES) != hipSuccess) { fprintf(stderr, "kernel_launch: hipFuncSetAttribute failed\n"); grid = -1; return; }
        if (hipOccupancyMaxActiveBlocksPerMultiprocessor(&per_cu, (const void*)mk_fwd, NTHREADS, LDS_BYTES) != hipSuccess || per_cu < 1) { fprintf(stderr, "kernel_launch: occupancy query gives %d\n", per_cu); per_cu = 1; }
        (void)hipGetLastError();
        grid = cus * 1;
    }
    if (grid < 0) return;
    Args a{};
    for (int i = 0; i < 31; ++i) a.in[i] = (const float*)d_in[i];
    a.out = (float*)d_out; a.ws = (unsigned char*)d_ws;
    void* kargs[] = {&a};
    hipError_t e = hipLaunchCooperativeKernel((const void*)mk_fwd, dim3(grid), dim3(NTHREADS), kargs, LDS_BYTES, stream);
    if (e != hipSuccess) fprintf(stderr, "kernel_launch: cooperative launch failed: %s (grid %d)\n", hipGetErrorString(e), grid);
}
```

```cpp
#include <hip/hip_runtime.h>
#include <hip/hip_cooperative_groups.h>
#include <cstdio>
#include <cstdint>
namespace cg = cooperative_groups;
namespace pg8 {
#define PG8_LAS __attribute__((address_space(3)))
typedef unsigned short bf16_t;
typedef short bf16x8 __attribute__((ext_vector_type(8)));
typedef float f32x4 __attribute__((ext_vector_type(4)));
typedef unsigned u32x4 __attribute__((ext_vector_type(4)));
constexpr int BM = 256, BK = 64, HALF = 128, HTB = HALF * BK * 2  , STAGE_BYTES = 8 * HTB, NXCD = 8, WGM = 8;

__host__ __device__ __forceinline__ int lds_byte(int r, int c) { const int st = (r >> 4) * 2 + (c >> 5), rr = r & 15, cc = c & 31, ob = rr * 64 + cc * 2; return st * 1024 + (ob ^ (((ob >> 9) & 1) << 5)); }
__host__ __device__ __forceinline__ void stage_rc(int b, int& R, int& C) { const int st = b / 1024, sb = b % 1024, swz = sb ^ (((sb >> 9) & 1) << 5); R = (st >> 1) * 16 + swz / 64; C = (st & 1) * 32 + (swz % 64) / 2; }
__host__ __device__ __forceinline__ int perm32(int rho) { const int n = rho >> 4, i = rho & 15; return 8 * (i >> 2) + 4 * n + (i & 3); }

struct Unit { int pm, pn, kh, par; };
struct Gemm { const bf16_t* A; const bf16_t* Bt; int M, N, K, KU; };

struct StaticOrder {
    int nM, nN, nwg, G, c;
    __host__ __device__ void init(int M, int N, int G_, int c_) { nM = M / BM; nN = N / BM; nwg = nM * nN; G = G_; c = c_; }
    __host__ __device__ bool next(int i, Unit& u) const {
        const long L = (long)i * G + c; if (L >= nwg) return false;
        int wgid = (int)L; { const int q = nwg / NXCD, r = nwg % NXCD, xcd = wgid % NXCD, off = wgid / NXCD; wgid = (xcd < r ? xcd * (q + 1) : r * (q + 1) + (xcd - r) * q) + off; }
        const int nig = WGM * nN, gid = wgid / nig, fm = gid * WGM, gsz = (nM - fm) < WGM ? (nM - fm) : WGM;
        u.pm = fm + ((wgid % nig) % gsz); u.pn = (wgid % nig) / gsz; u.kh = 0; return true;
    }
    __device__ __forceinline__ void a_ready(const Unit&) const {}
    __device__ __forceinline__ void done(const Unit&) const {}
};

__device__ __forceinline__ unsigned cvt_pk_bf16(float lo, float hi) { unsigned r; asm volatile("v_cvt_pk_bf16_f32 %0, %1, %2" : "=v"(r) : "v"(lo), "v"(hi)); return r; }
typedef int i32x4 __attribute__((ext_vector_type(4)));
typedef int i32x8 __attribute__((ext_vector_type(8)));
__device__ __forceinline__ i32x8 cat8(bf16x8 a, bf16x8 b) { return __builtin_shufflevector(__builtin_bit_cast(i32x4, a), __builtin_bit_cast(i32x4, b), 0, 1, 2, 3, 4, 5, 6, 7); }
__device__ __forceinline__ unsigned pack4_fp8(float a, float b, float c, float d) {
    a = __builtin_fminf(__builtin_fmaxf(a, -448.f), 448.f); b = __builtin_fminf(__builtin_fmaxf(b, -448.f), 448.f); c = __builtin_fminf(__builtin_fmaxf(c, -448.f), 448.f); d = __builtin_fminf(__builtin_fmaxf(d, -448.f), 448.f);
    int w = __builtin_amdgcn_cvt_pk_fp8_f32(a, b, 0, false); w = __builtin_amdgcn_cvt_pk_fp8_f32(c, d, w, true); return (unsigned)w; }
constexpr float F8_ACT_SCALE = 8.0f, F8_W_SCALE = 64.0f, F8_X_SCALE = 16.0f;
struct SplitOrder {
    StaticOrder base;
    __device__ bool next(int i, Unit& u) const { const bool r = base.next(i >> 1, u); u.kh = i & 1; return r; }
    __device__ __forceinline__ void a_ready(const Unit&) const {}
    __device__ __forceinline__ void done(const Unit&) const {}
};
typedef float f32x2 __attribute__((ext_vector_type(2)));
__device__ __forceinline__ float rstd_of(float ss, float inv_n) { return __builtin_amdgcn_rsqf(ss * inv_n + 1e-6f); }
__device__ __forceinline__ float sigmoid_f(float v) { return __builtin_amdgcn_rcpf(1.0f + __builtin_amdgcn_exp2f(-1.4426950408889634f * v)); }
__device__ __forceinline__ float bf_lo(unsigned w) { return __uint_as_float(w << 16); }
__device__ __forceinline__ float bf_hi(unsigned w) { return __uint_as_float(w & 0xffff0000u); }
__device__ __forceinline__ u32x4 pack8(const f32x4 a, const f32x4 b) { u32x4 w; w.x = cvt_pk_bf16(a[0], a[1]); w.y = cvt_pk_bf16(a[2], a[3]); w.z = cvt_pk_bf16(b[0], b[1]); w.w = cvt_pk_bf16(b[2], b[3]); return w; }
__device__ __forceinline__ float sumsq4(const f32x4 a) { return (a[0] * a[0] + a[1] * a[1]) + (a[2] * a[2] + a[3] * a[3]); }

template <bool F8OUT, bool OPQ = false> struct EpiSwiGLU {
    static constexpr bool PERM = true, AFTER_DRAIN = false, MID = false, PREF = true;
    bf16_t* O; const float* ss; int ldo; PG8_LAS float* sl; float ascale;
    __device__ __forceinline__ void prefetch(const Unit& u, int wid, int lane) const {
        if (wid < 4) __builtin_amdgcn_global_load_lds((const unsigned*)(ss + u.pm * BM + 64 * wid + lane), (PG8_LAS unsigned*)(sl + u.par * 256 + 64 * wid), 4, 0, 0);
    }
    __device__ __forceinline__ void operator()(f32x4 (&acc)[2][2][4][2], const Unit& u_, int wr, int wc, int fr, int fq) const {
        Unit u = u_; if constexpr (OPQ) { unsigned o1_ = ~0u; asm volatile("" : "+s"(u.pm), "+s"(u.pn), "+s"(o1_)); const int l_ = (int)__builtin_amdgcn_mbcnt_hi(o1_, __builtin_amdgcn_mbcnt_lo(o1_, 0u)); fr = l_ & 15; fq = l_ >> 4; }
        const int row0 = u.pm * BM + wr * 64 + fr, col0 = u.pn * HALF + wc * 32 + 8 * fq;
#pragma unroll
        for (int ai = 0; ai < 2; ++ai)
#pragma unroll
            for (int m = 0; m < 4; ++m) {
                const int row = row0 + ai * HALF + m * 16; const float r = rstd_of(sl[u.par * 256 + ai * HALF + wr * 64 + m * 16 + fr], 1.0f / 2048.0f) * ascale;
                f32x4 o[2];
#pragma unroll
                for (int n = 0; n < 2; ++n) { const f32x4 g = acc[ai][0][m][n] * r, uu = acc[ai][1][m][n] * r;
#pragma unroll
                    for (int e = 0; e < 4; ++e) o[n][e] = g[e] * uu[e] * sigmoid_f(g[e]); }
                if constexpr (F8OUT) {
                    typedef unsigned u32x2 __attribute__((ext_vector_type(2))); u32x2 w8; w8.x = pack4_fp8(o[0][0] * F8_ACT_SCALE, o[0][1] * F8_ACT_SCALE, o[0][2] * F8_ACT_SCALE, o[0][3] * F8_ACT_SCALE);
                    w8.y = pack4_fp8(o[1][0] * F8_ACT_SCALE, o[1][1] * F8_ACT_SCALE, o[1][2] * F8_ACT_SCALE, o[1][3] * F8_ACT_SCALE);
                    *(u32x2*)((unsigned char*)O + (((size_t)u.pm * (ldo / 128) + (col0 >> 7)) * BM + (ai * HALF + wr * 64 + m * 16 + fr)) * 128 + (col0 & 127)) = w8;
                } else
                *(u32x4*)(O + (((size_t)u.pm * (ldo / 64) + (col0 >> 6)) * BM + (ai * HALF + wr * 64 + m * 16 + fr)) * 64 + (col0 & 63)) = pack8(o[0], o[1]);
            }
    }
    __device__ __forceinline__ void mid(f32x4 (&)[2][2][4][2], const Unit&, int, int) const {}
};

template <int MODE, bool XF32, bool BATCH = true, bool OPQ = false> struct EpiResid {
    static constexpr bool PERM = true, AFTER_DRAIN = false, MID = (MODE == 1), PREF = false;
    const float* xin; bf16_t* xb; float* ssout; const float* ssa; const float* ssb; unsigned char* x8; float alpha;
    __device__ __forceinline__ void mid(f32x4 (&acc)[2][2][4][2], const Unit& u, int wr, int fr) const {
        {
            const int row0 = u.pm * BM + wr * 64 + fr;
#pragma unroll
            for (int ai = 0; ai < 2; ++ai)
#pragma unroll
                for (int m = 0; m < 4; ++m) { const int row = row0 + ai * HALF + m * 16;
                    const float ra = rstd_of(ssa[row], 1.0f / 1024.0f), rb = rstd_of(ssb[row], 1.0f / 1024.0f), ratio = ra * __builtin_amdgcn_rcpf(rb);
#pragma unroll
                    for (int bj = 0; bj < 2; ++bj)
#pragma unroll
                        for (int n = 0; n < 2; ++n) acc[ai][bj][m][n] = acc[ai][bj][m][n] * ratio;
                    asm volatile("" ::: "memory"); }
        }
    }
    __device__ __forceinline__ void operator()(f32x4 (&acc)[2][2][4][2], const Unit& u_, int wr, int wc, int fr, int fq) const {
        Unit u = u_; if constexpr (OPQ) { unsigned o1_ = ~0u; asm volatile("" : "+s"(u.pm), "+s"(u.pn), "+s"(o1_)); const int l_ = (int)__builtin_amdgcn_mbcnt_hi(o1_, __builtin_amdgcn_mbcnt_lo(o1_, 0u)); fr = l_ & 15; fq = l_ >> 4; }
        if (MODE == 1 && u.kh == 0) { mid(acc, u, wr, fr); return; }
        const int row0 = u.pm * BM + wr * 64 + fr, col0 = u.pn * BM + wc * 32 + 8 * fq;
        u32x4 xw[2][4][2]; f32x4 xf[XF32 ? 16 : 1][2];
#pragma unroll
        for (int ai = 0; ai < 2; ++ai)
#pragma unroll
            for (int m = 0; m < 4; ++m)
#pragma unroll
                for (int bj = 0; bj < 2; ++bj) { const size_t off = (size_t)(row0 + ai * HALF + m * 16) * 2048 + col0 + bj * HALF;
                    if constexpr (XF32) { xf[(ai * 4 + m) * 2 + bj][0] = *(const f32x4*)(xin + off); xf[(ai * 4 + m) * 2 + bj][1] = *(const f32x4*)(xin + off + 4); }
                    else if constexpr (BATCH) xw[ai][m][bj] = *(const u32x4*)(xb + off); }
#pragma unroll
        for (int ai = 0; ai < 2; ++ai)
#pragma unroll
            for (int m = 0; m < 4; ++m) {
                const int row = row0 + ai * HALF + m * 16; const size_t off = (size_t)row * 2048 + col0;
                float sc = alpha; if constexpr (MODE == 1) sc = rstd_of(ssb[row], 1.0f / 1024.0f);
                float q = 0.f;
#pragma unroll
                for (int bj = 0; bj < 2; ++bj) {
                    f32x4 x0, x1;
                    if constexpr (XF32) { x0 = xf[(ai * 4 + m) * 2 + bj][0]; x1 = xf[(ai * 4 + m) * 2 + bj][1]; }
                    else { const u32x4 w = BATCH ? xw[ai][m][bj] : *(const u32x4*)(xb + off + bj * HALF); x0 = (f32x4){bf_lo(w.x), bf_hi(w.x), bf_lo(w.y), bf_hi(w.y)}; x1 = (f32x4){bf_lo(w.z), bf_hi(w.z), bf_lo(w.w), bf_hi(w.w)}; }
                    const f32x4 v0 = x0 + acc[ai][bj][m][0] * sc, v1 = x1 + acc[ai][bj][m][1] * sc;
                    *(u32x4*)(xb + off + bj * HALF) = pack8(v0, v1);
                    if (x8) { typedef unsigned u32x2 __attribute__((ext_vector_type(2))); u32x2 w8; w8.x = pack4_fp8(v0[0] * F8_X_SCALE, v0[1] * F8_X_SCALE, v0[2] * F8_X_SCALE, v0[3] * F8_X_SCALE);
                        w8.y = pack4_fp8(v1[0] * F8_X_SCALE, v1[1] * F8_X_SCALE, v1[2] * F8_X_SCALE, v1[3] * F8_X_SCALE); *(u32x2*)(x8 + off + bj * HALF) = w8; }
                    q += sumsq4(v0) + sumsq4(v1);
                }
                q += __shfl_xor(q, 16); q += __shfl_xor(q, 32);
                if (fq == 0 && ssout) atomicAdd(ssout + row, q);
                if constexpr (!BATCH) { if (m & 1) asm volatile("" ::: "memory"); }
            }
    }
};

struct EpiWin {
    static constexpr bool PERM = true, AFTER_DRAIN = false, MID = false, PREF = false;
    const float* ss; bf16_t *UG, *Q, *K, *V; const float *gq, *gk; PG8_LAS float* xch;
    __device__ __forceinline__ void mid(f32x4 (&)[2][2][4][2], const Unit&, int, int) const {}
    __device__ __forceinline__ void operator()(f32x4 (&acc)[2][2][4][2], const Unit& u, int wr, int wc, int fr, int fq) const {
        const int row0 = u.pm * BM + wr * 64 + fr, seg = u.pn >> 2, lc0 = (u.pn & 3) * BM + wc * 32 + 8 * fq; const float* ssr = ss + row0;
        if (seg == 0) {
#pragma unroll
            for (int ai = 0; ai < 2; ++ai)
#pragma unroll
                for (int m = 0; m < 4; ++m) { const float r = rstd_of(ssr[ai * HALF + m * 16], 1.0f / 2048.0f); const int row = row0 + ai * HALF + m * 16, b = row >> 12, t = row & 4095;
#pragma unroll
                    for (int bj = 0; bj < 2; ++bj) { const int col = lc0 + bj * HALF, g = col >> 4, half = (col >> 3) & 1;
                        *(u32x4*)(UG + ((size_t)((b * 64 + g) * 4096 + t) * 16 + 8 * half)) = pack8(acc[ai][bj][m][0] * r, acc[ai][bj][m][1] * r); } }
        } else if (seg == 3) {
#pragma unroll
            for (int ai = 0; ai < 2; ++ai)
#pragma unroll
                for (int m = 0; m < 4; ++m) { const float r = rstd_of(ssr[ai * HALF + m * 16], 1.0f / 2048.0f); const int row = row0 + ai * HALF + m * 16;
#pragma unroll
                    for (int bj = 0; bj < 2; ++bj) *(u32x4*)(V + (size_t)row * 1024 + lc0 + bj * HALF) = pack8(acc[ai][bj][m][0] * r, acc[ai][bj][m][1] * r); }
        } else {
#pragma unroll
            for (int ai = 0; ai < 2; ++ai)
#pragma unroll
                for (int m = 0; m < 4; ++m) { const int rl = ai * HALF + wr * 64 + m * 16 + fr;
#pragma unroll
                    for (int bj = 0; bj < 2; ++bj) { float q = sumsq4(acc[ai][bj][m][0]) + sumsq4(acc[ai][bj][m][1]); q += __shfl_xor(q, 16); q += __shfl_xor(q, 32);
                        if (fq == 0) xch[rl * 8 + bj * 4 + wc] = q; } }
            asm volatile("s_waitcnt lgkmcnt(0)" ::: "memory"); __builtin_amdgcn_s_barrier(); asm volatile("" ::: "memory");
            const float* gain = (seg == 1) ? gq : gk; bf16_t* dst = (seg == 1) ? Q : K;
            const float osc = (seg == 1) ? (0.08838834764831845f * 1.4426950408889634f) : 1.0f;
            const int d0 = wc * 32 + 8 * fq;
            const f32x4 g0 = *(const f32x4*)(gain + d0) * osc, g1 = *(const f32x4*)(gain + d0 + 4) * osc;
#pragma unroll
            for (int ai = 0; ai < 2; ++ai)
#pragma unroll
                for (int m = 0; m < 4; ++m) { const int rl = ai * HALF + wr * 64 + m * 16 + fr, row = u.pm * BM + rl;
                    const float epr = 1e-6f * (ssr[ai * HALF + m * 16] * (1.0f / 2048.0f) + 1e-6f);
#pragma unroll
                    for (int bj = 0; bj < 2; ++bj) { const f32x4 p = *(const PG8_LAS f32x4*)(xch + rl * 8 + bj * 4);
                        const float rq = __builtin_amdgcn_rsqf(((p[0] + p[1]) + (p[2] + p[3])) * (1.0f / 128.0f) + epr);
                        *(u32x4*)(dst + (size_t)row * 1024 + lc0 + bj * HALF) = pack8(acc[ai][bj][m][0] * g0 * rq, acc[ai][bj][m][1] * g1 * rq); } }
        }
    }
};

struct EpiGlu {
    static constexpr bool PERM = true, AFTER_DRAIN = false, MID = false, PREF = false;
    const bf16_t* Z; const float* bias; bf16_t* Y; float* ssout;
    __device__ __forceinline__ void mid(f32x4 (&)[2][2][4][2], const Unit&, int, int) const {}
    __device__ __forceinline__ void operator()(f32x4 (&acc)[2][2][4][2], const Unit& u, int wr, int wc, int fr, int fq) const {
        const int row0 = u.pm * BM + wr * 64 + fr, col0 = u.pn * BM + wc * 32 + 8 * fq;
        f32x4 bv[2][2];
#pragma unroll
        for (int bj = 0; bj < 2; ++bj)
#pragma unroll
            for (int n = 0; n < 2; ++n) bv[bj][n] = *(const f32x4*)(bias + col0 + bj * HALF + 4 * n);
        u32x4 zw[2][4][2];
#pragma unroll
        for (int ai = 0; ai < 2; ++ai)
#pragma unroll
            for (int m = 0; m < 4; ++m)
#pragma unroll
                for (int bj = 0; bj < 2; ++bj) zw[ai][m][bj] = *(const u32x4*)(Z + (size_t)(row0 + ai * HALF + m * 16) * 1024 + col0 + bj * HALF);
#pragma unroll
        for (int ai = 0; ai < 2; ++ai)
#pragma unroll
            for (int m = 0; m < 4; ++m) { const int row = row0 + ai * HALF + m * 16; float q = 0.f;
#pragma unroll
                for (int bj = 0; bj < 2; ++bj) { const u32x4 zb = zw[ai][m][bj];
                    const f32x4 z0 = {bf_lo(zb.x), bf_hi(zb.x), bf_lo(zb.y), bf_hi(zb.y)}, z1 = {bf_lo(zb.z), bf_hi(zb.z), bf_lo(zb.w), bf_hi(zb.w)};
                    const f32x4 a0 = acc[ai][bj][m][0] + bv[bj][0], a1 = acc[ai][bj][m][1] + bv[bj][1]; f32x4 y0, y1;
#pragma unroll
                    for (int e = 0; e < 4; ++e) { y0[e] = z0[e] * sigmoid_f(a0[e]); y1[e] = z1[e] * sigmoid_f(a1[e]); }
                    *(u32x4*)(Y + (size_t)row * 2048 + col0 + bj * HALF) = pack8(y0, y1); q += sumsq4(y0) + sumsq4(y1); }
                q += __shfl_xor(q, 16); q += __shfl_xor(q, 32);
                if (fq == 0) atomicAdd(ssout + row, q); }
    }
};

struct EpiPle {
    static constexpr bool PERM = true, AFTER_DRAIN = false, MID = false, PREF = false;
    const bf16_t* PP; const float* ss; bf16_t* E; float* ssout;
    __device__ __forceinline__ void mid(f32x4 (&)[2][2][4][2], const Unit&, int, int) const {}
    __device__ __forceinline__ void operator()(f32x4 (&acc)[2][2][4][2], const Unit& u, int wr, int wc, int fr, int fq) const {
        const int row0 = u.pm * BM + wr * 64 + fr, col0 = u.pn * BM + wc * 32 + 8 * fq;
        u32x4 pw[2][4][2];
#pragma unroll
        for (int ai = 0; ai < 2; ++ai)
#pragma unroll
            for (int m = 0; m < 4; ++m)
#pragma unroll
                for (int bj = 0; bj < 2; ++bj) pw[ai][m][bj] = *(const u32x4*)(PP + (size_t)(row0 + ai * HALF + m * 16) * 2048 + col0 + bj * HALF);
#pragma unroll
        for (int ai = 0; ai < 2; ++ai)
#pragma unroll
            for (int m = 0; m < 4; ++m) { const int row = row0 + ai * HALF + m * 16; const float r = rstd_of(ss[row], 1.0f / 2048.0f); float q = 0.f;
#pragma unroll
                for (int bj = 0; bj < 2; ++bj) { const u32x4 pb = pw[ai][m][bj];
                    const f32x4 p0 = {bf_lo(pb.x), bf_hi(pb.x), bf_lo(pb.y), bf_hi(pb.y)}, p1 = {bf_lo(pb.z), bf_hi(pb.z), bf_lo(pb.w), bf_hi(pb.w)};
                    const f32x4 a0 = acc[ai][bj][m][0] * r, a1 = acc[ai][bj][m][1] * r; f32x4 y0, y1;
#pragma unroll
                    for (int e = 0; e < 4; ++e) { y0[e] = p0[e] * sigmoid_f(a0[e]); y1[e] = p1[e] * sigmoid_f(a1[e]); }
                    *(u32x4*)(E + (size_t)row * 2048 + col0 + bj * HALF) = pack8(y0, y1); q += sumsq4(y0) + sumsq4(y1); }
                q += __shfl_xor(q, 16); q += __shfl_xor(q, 32);
                if (fq == 0) atomicAdd(ssout + row, q); }
    }
};

struct EpiPlain {
    static constexpr bool PERM = true, AFTER_DRAIN = false, MID = false, PREF = false;
    bf16_t* O; int ldo;
    __device__ __forceinline__ void mid(f32x4 (&)[2][2][4][2], const Unit&, int, int) const {}
    __device__ __forceinline__ void operator()(f32x4 (&acc)[2][2][4][2], const Unit& u, int wr, int wc, int fr, int fq) const {
        const int row0 = u.pm * BM + wr * 64 + fr, col0 = u.pn * BM + wc * 32 + 8 * fq;
#pragma unroll
        for (int ai = 0; ai < 2; ++ai)
#pragma unroll
            for (int m = 0; m < 4; ++m) { const int row = row0 + ai * HALF + m * 16;
#pragma unroll
                for (int bj = 0; bj < 2; ++bj) *(u32x4*)(O + (size_t)row * ldo + col0 + bj * HALF) = pack8(acc[ai][bj][m][0], acc[ai][bj][m][1]); }
    }
};
template <class Epi, class Sched, bool ALIGN_EPI = false, bool SP2 = false, bool ABLK = false, bool F8 = false>
__device__ __forceinline__ void gemm_phase(PG8_LAS unsigned char* lds, const Gemm g, const Sched& S, const Epi& E, const int wave_s) {
    unsigned ones_ = ~0u; asm volatile("" : "+s"(ones_));
    const int lane = (int)__builtin_amdgcn_mbcnt_hi(ones_, __builtin_amdgcn_mbcnt_lo(ones_, 0u)), wid = wave_s, tid = wid * 64 + lane, wr = wid >> 2, wc = wid & 3, fr = lane & 15, fq = lane >> 4;
    const int K = g.K, nt = g.KU / BK;
    unsigned voffA[2], voffB[2];
#pragma unroll
    for (int i = 0; i < 2; ++i) { int R, C; stage_rc(tid * 16 + i * 8192, R, C); const int Rb = Epi::PERM ? ((R & ~31) + perm32(R & 31)) : R;
        voffA[i] = ABLK ? (unsigned)(R * BK + C) * 2u : (unsigned)(R * K + C) * 2u; voffB[i] = (unsigned)(Rb * K + C) * 2u; }
    const size_t kstep = (size_t)(BK * 2);
    const size_t hstep = (size_t)HALF * K * 2;
    const size_t tstep = 2 * hstep;
    const size_t kstepA = ABLK ? (size_t)(BM * BK * 2) : kstep, hstepA = ABLK ? (size_t)(HALF * BK * 2) : hstep;
    const unsigned ldsw = (unsigned)wid * 1024u;
    const int aoff = lds_byte(wr * 64 + fr, fq * 8), boff = lds_byte(wc * 32 + fr, fq * 8);
#define PG8_SA(b, h) (((b) * 2 + (h)) * HTB)
#define PG8_SB(b, h) ((4 + (b) * 2 + (h)) * HTB)
#define PG8_STAGE(bufoff, gbase, voff) do { _Pragma("unroll") for (int _i = 0; _i < 2; ++_i) \
        { unsigned _vo = (voff)[_i]; asm volatile("" : "+v"(_vo));     \
        __builtin_amdgcn_global_load_lds((const unsigned*)((const char*)(gbase) + _vo), (PG8_LAS unsigned*)(lds + (bufoff) + ldsw + _i * 8192), 16, 0, 0); } } while (0)
#define PG8_LDA(dst, b, h) do { _Pragma("unroll") for (int m = 0; m < 4; ++m) _Pragma("unroll") for (int k = 0; k < 2; ++k) dst[m][k] = *(const PG8_LAS bf16x8*)(lds + PG8_SA(b, h) + aoff + m * 2048 + k * 1024); } while (0)
#define PG8_LDB(dst, b, h) do { _Pragma("unroll") for (int n = 0; n < 2; ++n) _Pragma("unroll") for (int k = 0; k < 2; ++k) dst[n][k] = *(const PG8_LAS bf16x8*)(lds + PG8_SB(b, h) + boff + n * 2048 + k * 1024); } while (0)
#define PG8_MMA(ai, bj, At, Bt) do { __builtin_amdgcn_s_setprio(1); if constexpr (F8) { _Pragma("unroll") for (int m = 0; m < 4; ++m) _Pragma("unroll") for (int n = 0; n < 2; ++n) \
        acc[ai][bj][m][n] = __builtin_amdgcn_mfma_scale_f32_16x16x128_f8f6f4(cat8(Bt[n][0], Bt[n][1]), cat8(At[m][0], At[m][1]), acc[ai][bj][m][n], 0, 0, 0, 0x7F7F7F7F, 0, 0x7F7F7F7F); } \
    else { _Pragma("unroll") for (int m = 0; m < 4; ++m) _Pragma("unroll") for (int n = 0; n < 2; ++n) _Pragma("unroll") for (int k = 0; k < 2; ++k) \
        acc[ai][bj][m][n] = __builtin_amdgcn_mfma_f32_16x16x32_bf16(Bt[n][k], At[m][k], acc[ai][bj][m][n], 0, 0, 0); } __builtin_amdgcn_s_setprio(0); } while (0)
#define PG8_WAIT_V(n) asm volatile("s_waitcnt vmcnt(" #n ")" ::: "memory")
#define PG8_WAIT_L(n) asm volatile("s_waitcnt lgkmcnt(" #n ")" ::: "memory")
#define PG8_BAR __builtin_amdgcn_s_barrier()
#define PG8_SCHED __builtin_amdgcn_sched_barrier(0)
    Unit cur, nxt; int ui = 0;
    if (!S.next(0, cur)) return;
    cur.par = 0;
    if constexpr (Epi::PREF) E.prefetch(cur, wid, lane);
    f32x4 acc[2][2][4][2];
#pragma unroll
    for (int a = 0; a < 2; ++a)
#pragma unroll
        for (int b = 0; b < 2; ++b)
#pragma unroll
            for (int m = 0; m < 4; ++m)
#pragma unroll
                for (int n = 0; n < 2; ++n) acc[a][b][m][n] = (f32x4){0.f, 0.f, 0.f, 0.f};
    bf16x8 At[4][2], B0[2][2], B1[2][2];
    const size_t khb = (size_t)g.KU * 2, khbA = ABLK ? (size_t)(g.KU / BK) * kstepA : khb; const char* cA = (const char*)g.A + (size_t)cur.pm * tstep + cur.kh * khbA; const char* cB = (const char*)g.Bt + (size_t)cur.pn * tstep + cur.kh * khb;
    S.a_ready(cur);
    if constexpr (SP2) {
        PG8_STAGE(PG8_SB(0, 0), cB, voffB); PG8_STAGE(PG8_SB(0, 1), cB + hstep, voffB); PG8_STAGE(PG8_SA(0, 0), cA, voffA); PG8_STAGE(PG8_SA(0, 1), cA + hstepA, voffA);
        if (wr == 1) PG8_BAR;
        PG8_WAIT_V(2); PG8_BAR;
        PG8_STAGE(PG8_SB(1, 0), cB + kstep, voffB); PG8_STAGE(PG8_SA(1, 0), cA + kstepA, voffA); PG8_STAGE(PG8_SB(1, 1), cB + hstep + kstep, voffB);
        PG8_WAIT_V(6); PG8_BAR;
    } else {
        PG8_STAGE(PG8_SB(0, 0), cB, voffB); PG8_STAGE(PG8_SA(0, 0), cA, voffA); PG8_STAGE(PG8_SB(0, 1), cB + hstep, voffB); PG8_STAGE(PG8_SA(0, 1), cA + hstepA, voffA);
        if (wr == 1) PG8_BAR;
        PG8_WAIT_V(4); PG8_BAR;
        PG8_STAGE(PG8_SB(1, 0), cB + kstep, voffB); PG8_STAGE(PG8_SA(1, 0), cA + kstepA, voffA); PG8_STAGE(PG8_SB(1, 1), cB + hstep + kstep, voffB);
        PG8_WAIT_V(6); PG8_BAR;
    }
    for (;;) {
        const bool has_next = S.next(ui + 1, nxt); nxt.par = (ui + 1) & 1;
        const char* nA = has_next ? (const char*)g.A + (size_t)nxt.pm * tstep + nxt.kh * khbA : cA; const char* nB = has_next ? (const char*)g.Bt + (size_t)nxt.pn * tstep + nxt.kh * khb : cB;
        for (int t = 0; t < nt; t += 2) {
            const bool last = (t == nt - 2);
            const char* a1 = cA + (size_t)(t + 1) * kstepA;
            const char* a2 = last ? nA : cA + (size_t)(t + 2) * kstepA; const char* b2 = last ? nB : cB + (size_t)(t + 2) * kstep;
            const char* a3 = a2 + kstepA; const char* b3 = b2 + kstep;
            if (last && has_next) { S.a_ready(nxt); if constexpr (Epi::PREF) E.prefetch(nxt, wid, lane); }
            if constexpr (SP2) {
            PG8_LDB(B0, 0, 0); PG8_LDB(B1, 0, 1); PG8_SCHED; PG8_LDA(At, 0, 0); PG8_STAGE(PG8_SA(1, 1), a1 + hstepA, voffA);
            PG8_WAIT_V(8); PG8_WAIT_L(0); PG8_BAR; PG8_MMA(0, 0, At, B0); PG8_MMA(0, 1, At, B1); PG8_BAR; PG8_SCHED;
            PG8_LDA(At, 0, 1); PG8_STAGE(PG8_SB(0, 0), b2, voffB); PG8_STAGE(PG8_SB(0, 1), b2 + hstep, voffB); PG8_STAGE(PG8_SA(0, 0), a2, voffA);
            PG8_WAIT_V(8); PG8_WAIT_L(0); PG8_BAR; PG8_MMA(1, 0, At, B0); PG8_MMA(1, 1, At, B1); PG8_BAR; PG8_SCHED;
            PG8_LDB(B0, 1, 0); PG8_LDB(B1, 1, 1); PG8_SCHED; PG8_LDA(At, 1, 0); PG8_STAGE(PG8_SA(0, 1), a2 + hstepA, voffA);
            PG8_WAIT_V(8); PG8_WAIT_L(0); PG8_BAR; PG8_MMA(0, 0, At, B0); PG8_MMA(0, 1, At, B1); PG8_BAR; PG8_SCHED;
            PG8_LDA(At, 1, 1); PG8_STAGE(PG8_SB(1, 0), b3, voffB); PG8_STAGE(PG8_SB(1, 1), b3 + hstep, voffB); PG8_STAGE(PG8_SA(1, 0), a3, voffA);
            PG8_WAIT_V(8); PG8_WAIT_L(0); PG8_BAR; PG8_MMA(1, 0, At, B0); PG8_MMA(1, 1, At, B1); PG8_BAR; PG8_SCHED;
            } else {
            PG8_LDB(B0, 0, 0); PG8_SCHED; PG8_LDA(At, 0, 0); PG8_STAGE(PG8_SA(1, 1), a1 + hstepA, voffA);
            PG8_WAIT_L(8); PG8_BAR; PG8_WAIT_L(0); PG8_MMA(0, 0, At, B0); PG8_BAR; PG8_SCHED;
            PG8_LDB(B1, 0, 1); PG8_STAGE(PG8_SB(0, 0), b2, voffB);
            PG8_BAR; PG8_WAIT_L(0); PG8_MMA(0, 1, At, B1); PG8_BAR;
            PG8_LDA(At, 0, 1); PG8_STAGE(PG8_SA(0, 0), a2, voffA);
            PG8_BAR; PG8_WAIT_L(0); PG8_MMA(1, 0, At, B0); PG8_BAR; PG8_SCHED;
            PG8_STAGE(PG8_SB(0, 1), b2 + hstep, voffB);
            PG8_WAIT_V(6); PG8_BAR; PG8_MMA(1, 1, At, B1); PG8_BAR;
            PG8_LDB(B0, 1, 0); PG8_SCHED; PG8_LDA(At, 1, 0); PG8_STAGE(PG8_SA(0, 1), a2 + hstepA, voffA);
            PG8_WAIT_L(8); PG8_BAR; PG8_WAIT_L(0); PG8_MMA(0, 0, At, B0); PG8_BAR; PG8_SCHED;
            PG8_LDB(B1, 1, 1); PG8_STAGE(PG8_SB(1, 0), b3, voffB);
            PG8_BAR; PG8_WAIT_L(0); PG8_MMA(0, 1, At, B1); PG8_BAR;
            PG8_LDA(At, 1, 1); PG8_STAGE(PG8_SA(1, 0), a3, voffA);
            PG8_BAR; PG8_WAIT_L(0); PG8_MMA(1, 0, At, B0); PG8_BAR; PG8_SCHED;
            PG8_STAGE(PG8_SB(1, 1), b3 + hstep, voffB);
            PG8_WAIT_V(6); PG8_BAR; PG8_MMA(1, 1, At, B1); PG8_BAR;
            }
        }
        if constexpr (ALIGN_EPI) { if (wr == 0) PG8_BAR; }
        if constexpr (!Epi::AFTER_DRAIN) { E(acc, cur, wr, wc, fr, fq); S.done(cur); }
        if (!has_next) break;
        if (!(Epi::MID && cur.kh == 0))
#pragma unroll
        for (int a = 0; a < 2; ++a)
#pragma unroll
            for (int b = 0; b < 2; ++b)
#pragma unroll
                for (int m = 0; m < 4; ++m)
#pragma unroll
                    for (int n = 0; n < 2; ++n) acc[a][b][m][n] = (f32x4){0.f, 0.f, 0.f, 0.f};
        cur = nxt; cA = nA; cB = nB; ++ui;
        if constexpr (ALIGN_EPI) { if (wr == 1) PG8_BAR; }
    }
    PG8_WAIT_V(0);
    if constexpr (!ALIGN_EPI) { if (wr == 0) PG8_BAR; }
    PG8_BAR;
    if constexpr (Epi::AFTER_DRAIN) { E.fused(acc, cur, wr, wc, fr, fq, lds, wid, lane); S.done(cur); }
#undef PG8_SA
#undef PG8_SB
#undef PG8_STAGE
#undef PG8_LDA
#undef PG8_LDB
#undef PG8_MMA
#undef PG8_WAIT_V
#undef PG8_WAIT_L
#undef PG8_BAR
#undef PG8_SCHED
}
}
constexpr int NWAVES = 8, NTHREADS = 512;
constexpr int DM = 2048, NB = 8, SEQ = 4096, MROWS = NB * SEQ, FF = 5632, PLE = 256;
constexpr int SSMW = 1024, NG = 64, GH = 16, NP = 64, SBW = 1024, NHEAD = 8, HD = 128, NIN = 4096;
constexpr size_t MiB = 1u << 20;
constexpr size_t WS_STAT = 0;
constexpr size_t WS_BAR = 960 * 1024;
constexpr int BAR_WORDS = 3456;
constexpr size_t WS_LAM8 = 1 * MiB;
constexpr size_t WS_SSMMAT = 2 * MiB;
constexpr size_t WS_WGU1 = 8 * MiB, WS_WD1 = 52 * MiB, WS_WIN = 74 * MiB, WS_WGLU = 90 * MiB, WS_WOUT = 92 * MiB, WS_WGU2 = 100 * MiB, WS_WD2 = 144 * MiB, WS_WPG = 166 * MiB, WS_WPP = 174 * MiB;
constexpr size_t WS_PB = 176 * MiB;
constexpr size_t WS_XB = 192 * MiB;
constexpr size_t WS_YMIX = 320 * MiB;
constexpr size_t WS_ACT = 448 * MiB;
constexpr size_t WS_UG = WS_ACT, WS_Q = WS_ACT + 64 * MiB, WS_K = WS_ACT + 128 * MiB, WS_V = WS_ACT + 192 * MiB, WS_Z = WS_ACT + 256 * MiB, WS_E = WS_ACT;
constexpr size_t WS_XB8 = 832 * MiB;
constexpr size_t WS_END = 896 * MiB;
enum { ST_SS1 = 0, ST_SS2, ST_SSM, ST_SB, ST_SS3, ST_SS4, ST_SSE, ST_N };
constexpr int RING_BYTES = 131072, XCH_OFF = RING_BYTES, LDS_BYTES = 147456;

#define GAS __attribute__((address_space(1)))
#define LAS __attribute__((address_space(3)))
typedef unsigned short bf16;
typedef unsigned v4u __attribute__((ext_vector_type(4)));
typedef unsigned v2u __attribute__((ext_vector_type(2)));
typedef float f32x4 __attribute__((ext_vector_type(4)));
typedef short bf16x8 __attribute__((ext_vector_type(8)));
#define LDS_WAIT() asm volatile("s_waitcnt lgkmcnt(0)" ::: "memory")
using pg8::cvt_pk_bf16;
__device__ __forceinline__ float wave_sum(float v) {
#pragma unroll
    for (int o = 1; o < 64; o <<= 1) v += __shfl_xor(v, o);
    return v;
}
__device__ __forceinline__ f32x4 mfma16(bf16x8 a, bf16x8 b, f32x4 c) { return __builtin_amdgcn_mfma_f32_16x16x32_bf16(a, b, c, 0, 0, 0); }

#ifndef MK_DUP
#define MK_DUP 0u
#endif
constexpr int P0_REP = 1 + (int)(MK_DUP & 1u), P4_REP = 1 + (int)((MK_DUP >> 4) & 1u);
__device__ __forceinline__ void tr_item(const float* W, int K, int N, const float* gain, bf16* WT, int k0, int n0, int dstrow, LAS float* scr, int lane, float f8s) {
    const int c4 = lane & 15, r0 = lane >> 4;
#pragma unroll 4
    for (int i = 0; i < 16; ++i) { const int kk = 4 * i + r0; f32x4 v = *(const GAS f32x4*)(W + (size_t)(k0 + kk) * N + n0 + 4 * c4); if (gain) v = v * gain[k0 + kk];
        *(LAS f32x4*)(scr + kk * 64 + 4 * (c4 ^ (2 * ((kk >> 3) & 7)))) = v; }
    LDS_WAIT(); asm volatile("" ::: "memory");
    const int c = lane & 7;
#pragma unroll
    for (int ps = 0; ps < 2; ++ps) { const int ng = (lane >> 3) + 8 * ps; f32x4 v[8];
#pragma unroll
        for (int j = 0; j < 8; ++j) v[j] = *(const LAS f32x4*)(scr + (8 * c + j) * 64 + 4 * (ng ^ (2 * c)));
#pragma unroll
        for (int i = 0; i < 4; ++i) {
            if (f8s != 0.f) { v2u o8; o8.x = pg8::pack4_fp8(v[0][i] * f8s, v[1][i] * f8s, v[2][i] * f8s, v[3][i] * f8s); o8.y = pg8::pack4_fp8(v[4][i] * f8s, v[5][i] * f8s, v[6][i] * f8s, v[7][i] * f8s);
                *(GAS v2u*)((GAS unsigned char*)WT + (size_t)(dstrow + 4 * ng + i) * K + k0 + 8 * c) = o8; continue; }
            v4u o; o.x = cvt_pk_bf16(v[0][i], v[1][i]); o.y = cvt_pk_bf16(v[2][i], v[3][i]); o.z = cvt_pk_bf16(v[4][i], v[5][i]); o.w = cvt_pk_bf16(v[6][i], v[7][i]);
            *(GAS v4u*)(WT + (size_t)(dstrow + 4 * ng + i) * K + k0 + 8 * c) = o; } }
    LDS_WAIT(); asm volatile("" ::: "memory");
}

struct In {
    const float *x, *p, *ffn1_norm, *ffn1_wg, *ffn1_wu, *ffn1_wd, *mix_norm, *w_in, *lam_re, *lam_im, *b_re, *b_im, *c_re, *c_im, *log_dt, *ssm_d, *w_glu, *b_glu, *q_norm, *k_norm,
        *on_ssm, *on_sb, *w_out, *ffn2_norm, *ffn2_wg, *ffn2_wu, *ffn2_wd, *ple_norm, *w_pg, *w_pp, *ple_post;
};

__device__ __forceinline__ void ssm_build(const In& in, unsigned char* ws, LAS unsigned char* lds, int g, int tid) {
    LAS float* PW = (LAS float*)lds;
    LAS float* CO = PW + 9 * 64 * 2;
    LAS float* CB = CO + 64 * 2;
    LAS float* KT = CB + 64 * 16 * 2;
    LAS float* CR = KT + 2048; LAS float* CI = CR + 1024;
    for (int i = tid; i < 1024; i += NTHREADS) { CR[i] = in.c_re[g * 1024 + i]; CI[i] = in.c_im[g * 1024 + i]; }
    if (tid < 64) {
        const int p = tid; const float dt = expf(in.log_dt[g]); const float lr = fminf(in.lam_re[g * 64 + p], -1e-4f), li = in.lam_im[g * 64 + p];
        const float a = lr * dt, th = li * dt; float s1, c1; sincosf(th, &s1, &c1); const float ea = expf(a);
        const float l1r = ea * c1, l1i = ea * s1;
        float pr = 1.f, pi = 0.f;
#pragma unroll
        for (int t = 0; t <= 8; ++t) { PW[(t * 64 + p) * 2] = pr; PW[(t * 64 + p) * 2 + 1] = pi; const float nr = pr * l1r - pi * l1i, ni = pr * l1i + pi * l1r; pr = nr; pi = ni; }
        float* l8 = (float*)(ws + WS_LAM8) + (g * 64 + p) * 2; l8[0] = PW[(8 * 64 + p) * 2]; l8[1] = PW[(8 * 64 + p) * 2 + 1];
        const float sh = sinf(0.5f * th); const float nr = expm1f(a) * c1 - 2.f * sh * sh, ni = l1i;
        const float den = 1.f / (lr * lr + li * li);
        CO[p * 2] = (nr * lr + ni * li) * den; CO[p * 2 + 1] = (ni * lr - nr * li) * den;
    }
    __syncthreads();
    for (int i = tid; i < 1024; i += NTHREADS) { const int p = i >> 4; const float br = in.b_re[g * 1024 + i], bi = in.b_im[g * 1024 + i], cr = CO[p * 2], ci = CO[p * 2 + 1];
        CB[i * 2] = cr * br - ci * bi; CB[i * 2 + 1] = cr * bi + ci * br; }
    __syncthreads();
    for (int i = tid; i < 2048; i += NTHREADS) { const int tau = i >> 8, h = (i >> 4) & 15, h2 = i & 15; float s = 0.f;
        for (int p = 0; p < 64; ++p) { const float cr = CR[h * 64 + p], ci = CI[h * 64 + p], pr = PW[(tau * 64 + p) * 2], pi = PW[(tau * 64 + p) * 2 + 1];
            const float wr = cr * pr - ci * pi, wi = cr * pi + ci * pr; s += wr * CB[(p * 16 + h2) * 2] - wi * CB[(p * 16 + h2) * 2 + 1]; }
        KT[i] = s; }
    __syncthreads();
    bf16* Ms = (bf16*)(ws + WS_SSMMAT) + (size_t)g * 3 * 16384; bf16* Mi = Ms + 16384; bf16* Mo = Mi + 16384;
    for (int i = tid; i < 16384; i += NTHREADS) { const int r = i >> 7, c = i & 127;
        { const int p = r & 63, s = c >> 4, h2 = c & 15; const float pr = PW[((7 - s) * 64 + p) * 2], pi = PW[((7 - s) * 64 + p) * 2 + 1], br = CB[(p * 16 + h2) * 2], bi = CB[(p * 16 + h2) * 2 + 1];
          const float v = (r < 64) ? (pr * br - pi * bi) : (pr * bi + pi * br); Ms[i] = (bf16)(cvt_pk_bf16(v, 0.f) & 0xffffu); }
        { const int t = r >> 4, h = r & 15, s = c >> 4, h2 = c & 15; float v = 0.f; if (s <= t) { v = KT[((t - s) * 16 + h) * 16 + h2]; if (r == c) v += in.ssm_d[g * 16 + h]; } Mi[i] = (bf16)(cvt_pk_bf16(v, 0.f) & 0xffffu); }
        { const int t = r >> 4, h = r & 15, p = c & 63; const float cr = CR[h * 64 + p], ci = CI[h * 64 + p], pr = PW[((t + 1) * 64 + p) * 2], pi = PW[((t + 1) * 64 + p) * 2 + 1];
          const float v = (c < 64) ? (cr * pr - ci * pi) : -(cr * pi + ci * pr); Mo[i] = (bf16)(cvt_pk_bf16(v, 0.f) & 0xffffu); }
    }
    __syncthreads();
}

__device__ __forceinline__ void p0_prologue(const In& in, float* out, unsigned char* ws, LAS unsigned char* lds, int tid, int lane, int wave) {
    const int G = gridDim.x, bx = blockIdx.x;
    if (bx == 0) { unsigned* bw = (unsigned*)(ws + WS_BAR); for (int i = tid; i < BAR_WORDS; i += NTHREADS) bw[i] = 0u; }
    for (int g = bx; g < NG; g += G) ssm_build(in, ws, lds, g, tid);
    { float* st = (float*)(ws + WS_STAT) + MROWS; for (int i = bx * NTHREADS + tid; i < (ST_N - 1) * MROWS; i += G * NTHREADS) st[i] = 0.f; }
    LAS float* scr = (LAS float*)(lds + wave * 16384);
    const int gw = bx * NWAVES + wave, NGW = G * NWAVES;
    constexpr int I_GU = (DM / 64) * (FF / 64), I_D = (FF / 64) * (DM / 64), I_IN = (DM / 64) * (NIN / 64), I_GLU = (SSMW / 64) * (SSMW / 64), I_SQ = (DM / 64) * (DM / 64), I_PP = (PLE / 64) * (DM / 64);
    constexpr int NITEMS = 4 * I_GU + 2 * I_D + I_IN + I_GLU + 2 * I_SQ + I_PP;
#define TR_ITEM(NI, Wp, Kd, Nd, gainp, dstoff, MODE, F8S) \
        if (r < (NI)) { const int nbk = (Nd) / 64, kb = r / nbk, nb = r % nbk, k0 = 64 * kb, n0 = 64 * nb; \
            const int dr = (MODE) == 0 ? n0 : (n0 / 128) * 256 + (n0 % 128) + ((MODE) == 2 ? 128 : 0); \
            tr_item((Wp), (Kd), (Nd), (gainp), (bf16*)(ws + (dstoff)), k0, n0, dr, scr, lane, (F8S)); continue; } r -= (NI);
    for (int it = gw; it < NITEMS * P0_REP; it += NGW) {
        int r = it % NITEMS;
        TR_ITEM(I_GU, in.ffn1_wg, DM, FF, in.ffn1_norm, WS_WGU1, 1, 0.f)
        TR_ITEM(I_GU, in.ffn1_wu, DM, FF, in.ffn1_norm, WS_WGU1, 2, 0.f)
        TR_ITEM(I_D, in.ffn1_wd, FF, DM, (const float*)nullptr, WS_WD1, 0, 0.f)
        TR_ITEM(I_IN, in.w_in, DM, NIN, in.mix_norm, WS_WIN, 0, 0.f)
        TR_ITEM(I_GLU, in.w_glu, SSMW, SSMW, (const float*)nullptr, WS_WGLU, 0, 0.f)
        TR_ITEM(I_SQ, in.w_out, DM, DM, (k0 < 1024 ? in.on_ssm : in.on_sb - 1024), WS_WOUT, 0, 0.f)
        TR_ITEM(I_GU, in.ffn2_wg, DM, FF, in.ffn2_norm, WS_WGU2, 1, pg8::F8_W_SCALE)
        TR_ITEM(I_GU, in.ffn2_wu, DM, FF, in.ffn2_norm, WS_WGU2, 2, pg8::F8_W_SCALE)
        TR_ITEM(I_D, in.ffn2_wd, FF, DM, (const float*)nullptr, WS_WD2, 0, 0.f)
        TR_ITEM(I_SQ, in.w_pg, DM, DM, in.ple_norm, WS_WPG, 0, 0.f)
        TR_ITEM(I_PP, in.w_pp, PLE, DM, (const float*)nullptr, WS_WPP, 0, 0.f)
    }
#undef TR_ITEM
    { bf16* XB = (bf16*)(ws + WS_XB); float* ss1 = (float*)(ws + WS_STAT) + ST_SS1 * MROWS;
      for (int mm = gw; mm < MROWS * P0_REP; mm += NGW) { const int m = mm % MROWS; const GAS f32x4* xr = (const GAS f32x4*)(in.x + (size_t)m * DM) + lane; GAS v2u* o = (GAS v2u*)(XB + (size_t)m * DM) + lane; float s = 0.f;
#pragma unroll
          for (int j = 0; j < 8; ++j) { const f32x4 v = xr[64 * j]; s += (v.x * v.x + v.y * v.y) + (v.z * v.z + v.w * v.w); v2u w; w.x = cvt_pk_bf16(v.x, v.y); w.y = cvt_pk_bf16(v.z, v.w); o[64 * j] = w; }
          s = wave_sum(s); if (lane == 0) ss1[m] = s; } }
    { const GAS f32x4* ps = (const GAS f32x4*)in.p; GAS v2u* o = (GAS v2u*)(ws + WS_PB);
      for (int i = bx * NTHREADS + tid; i < MROWS * PLE / 4; i += G * NTHREADS) { const f32x4 v = ps[i]; v2u w; w.x = cvt_pk_bf16(v.x, v.y); w.y = cvt_pk_bf16(v.z, v.w); o[i] = w; } }
}

constexpr int SSM_DROW = 132, SSM_SROW = 136;
__device__ __forceinline__ void ssm_unit(unsigned char* ws, LAS unsigned char* lds, int b, int g, int lane, int wave) {
    const int r16 = lane & 15, q4 = lane >> 4;
    LAS float* DL = (LAS float*)lds; LAS bf16* S0 = (LAS bf16*)(lds + 64 * SSM_DROW * 4);
    const bf16* Ms = (const bf16*)(ws + WS_SSMMAT) + (size_t)g * 3 * 16384; const bf16* Mi = Ms + 16384; const bf16* Mo = Mi + 16384;
    bf16x8 aS[4], aI[4], aO[4];
#pragma unroll
    for (int ks = 0; ks < 4; ++ks) { const int o = (16 * wave + r16) * 128 + 32 * ks + 8 * q4; aS[ks] = *(const bf16x8*)(Ms + o); aI[ks] = *(const bf16x8*)(Mi + o); aO[ks] = *(const bf16x8*)(Mo + o); }
    const bf16* ug = (const bf16*)(ws + WS_UG) + (size_t)(b * 64 + g) * 4096 * 16;
    bf16* zb = (bf16*)(ws + WS_Z) + (size_t)b * 4096 * 1024 + g * 16;
    const float* l8 = (const float*)(ws + WS_LAM8) + (g * 64 + lane) * 2; const float l8r = l8[0], l8i = l8[1];
    float sre = 0.f, sim = 0.f;
    bf16x8 bu[4][4];
#define SSM_LOADU(SEG) do { _Pragma("unroll") for (int nt = 0; nt < 4; ++nt) { const int n = 64 * (SEG) + 16 * nt + r16; _Pragma("unroll") for (int ks = 0; ks < 4; ++ks) \
        bu[nt][ks] = *(const bf16x8*)(ug + (size_t)(n * 8 + 2 * ks + (q4 >> 1)) * 16 + 8 * (q4 & 1)); } } while (0)
    SSM_LOADU(0);
    for (int seg = 0; seg < 8; ++seg) {
        f32x4 ay[4];
#pragma unroll
        for (int nt = 0; nt < 4; ++nt) { f32x4 acc = {0.f, 0.f, 0.f, 0.f}, accy = {0.f, 0.f, 0.f, 0.f};
#pragma unroll
            for (int ks = 0; ks < 4; ++ks) { acc = mfma16(aS[ks], bu[nt][ks], acc); accy = mfma16(aI[ks], bu[nt][ks], accy); }
            *(LAS f32x4*)(DL + (16 * nt + r16) * SSM_DROW + 16 * wave + 4 * q4) = acc; ay[nt] = accy; }
        if (seg < 7) SSM_LOADU(seg + 1);
        __syncthreads();
        if (wave == 0) {
            for (int nb = 0; nb < 64; nb += 8) {
                float dr[8], di[8];
#pragma unroll
                for (int j = 0; j < 8; ++j) { dr[j] = DL[(nb + j) * SSM_DROW + lane]; di[j] = DL[(nb + j) * SSM_DROW + 64 + lane]; }
#pragma unroll
                for (int j = 0; j < 8; ++j) { S0[(nb + j) * SSM_SROW + lane] = (bf16)(cvt_pk_bf16(sre, 0.f) & 0xffffu); S0[(nb + j) * SSM_SROW + 64 + lane] = (bf16)(cvt_pk_bf16(sim, 0.f) & 0xffffu);
                    const float nr = l8r * sre - l8i * sim + dr[j], ni = l8r * sim + l8i * sre + di[j]; sre = nr; sim = ni; } }
        }
        __syncthreads();
#pragma unroll
        for (int nt = 0; nt < 4; ++nt) { const int n = 64 * seg + 16 * nt + r16; f32x4 acc = ay[nt];
            bf16x8 bs[4];
#pragma unroll
            for (int ks = 0; ks < 4; ++ks) bs[ks] = *(const LAS bf16x8*)(S0 + (16 * nt + r16) * SSM_SROW + 32 * ks + 8 * q4);
#pragma unroll
            for (int ks = 0; ks < 4; ++ks) acc = mfma16(aO[ks], bs[ks], acc);
            f32x4 z;
#pragma unroll
            for (int e = 0; e < 4; ++e) { const float y = acc[e]; const float t = 1.5957691216057308f * (y + 0.044715f * y * y * y); z[e] = y * __builtin_amdgcn_rcpf(1.0f + __builtin_amdgcn_exp2f(-1.4426950408889634f * t)); }
            v2u w; w.x = cvt_pk_bf16(z[0], z[1]); w.y = cvt_pk_bf16(z[2], z[3]);
            *(v2u*)(zb + (size_t)(n * 8 + wave) * 1024 + 4 * q4) = w; }
    }
#undef SSM_LOADU
    __syncthreads();
}

constexpr int AT_KROW = 136, AT_VROW = 152, AT_SROW = 68, AT_PROW = 72;
constexpr int AT_KB = 64 * AT_KROW * 2, AT_VB = 64 * AT_VROW * 2, AT_BUF = AT_KB + AT_VB;
constexpr int AT_S_OFF = 2 * AT_BUF, AT_P_OFF = AT_S_OFF + 8 * 16 * AT_SROW * 4, AT_FLAG_OFF = AT_P_OFF + 8 * 16 * AT_PROW * 2;
static_assert(AT_FLAG_OFF + 64 <= RING_BYTES, "attention LDS");
constexpr float AT_THR = -152.0f;
typedef short s16x4 __attribute__((ext_vector_type(4)));
__device__ __forceinline__ s16x4 lds_tr(const LAS bf16* p) { return __builtin_bit_cast(s16x4, __builtin_amdgcn_ds_read_tr16_b64_v4i16((LAS s16x4*)p)); }
__device__ __forceinline__ void attn_unit(unsigned char* ws, LAS unsigned char* lds, int b, int h, int qb, int tid, int lane, int wave, bool do_ss) {
    const int r16 = lane & 15, q4 = lane >> 4;
    LAS float* Sw = (LAS float*)(lds + AT_S_OFF) + wave * 16 * AT_SROW; LAS bf16* Pw = (LAS bf16*)(lds + AT_P_OFF) + wave * 16 * AT_PROW;
    volatile LAS unsigned* flag = (volatile LAS unsigned*)(lds + AT_FLAG_OFF);
    const bf16* Qg = (const bf16*)(ws + WS_Q) + (size_t)b * SEQ * 1024 + h * 128;
    const bf16* Kg = (const bf16*)(ws + WS_K) + (size_t)b * SEQ * 1024 + h * 128;
    const bf16* Vg = (const bf16*)(ws + WS_V) + (size_t)b * SEQ * 1024 + h * 128;
    const int qw0 = 128 * qb + 16 * wave, qrow = qw0 + r16;
    bf16x8 qf[4];
#pragma unroll
    for (int ks = 0; ks < 4; ++ks) qf[ks] = *(const bf16x8*)(Qg + (size_t)qrow * 1024 + 32 * ks + 8 * q4);
    f32x4 o[8];
#pragma unroll
    for (int i = 0; i < 8; ++i) o[i] = (f32x4){0.f, 0.f, 0.f, 0.f};
    float carry = 0.f; bool done = false;
    const int pr0 = tid >> 4, pc = tid & 15;
    v4u kr[2], vr[2];
    int kt = 2 * qb + 1, buf = 0, it = 0;
#define AT_LOAD(KT) do { _Pragma("unroll") for (int i = 0; i < 2; ++i) { const size_t go = (size_t)(64 * (KT) + pr0 + 32 * i) * 1024 + 8 * pc; kr[i] = *(const v4u*)(Kg + go); vr[i] = *(const v4u*)(Vg + go); } } while (0)
#define AT_STAGE(B) do { _Pragma("unroll") for (int i = 0; i < 2; ++i) { const int row = pr0 + 32 * i; *(LAS v4u*)((LAS bf16*)(lds + (B) * AT_BUF) + row * AT_KROW + 8 * pc) = kr[i]; \
        *(LAS v4u*)((LAS bf16*)(lds + (B) * AT_BUF + AT_KB) + row * AT_VROW + 8 * pc) = vr[i]; } } while (0)
    AT_LOAD(kt); AT_STAGE(0);
    if (kt > 0) AT_LOAD(kt - 1);
    __syncthreads();
    for (;;) {
        const LAS bf16* Ks = (const LAS bf16*)(lds + buf * AT_BUF); const LAS bf16* Vs = (const LAS bf16*)(lds + buf * AT_BUF + AT_KB);
        const int j0 = 64 * kt;
        if (!done && j0 < qw0 + 15) {
            {
                bf16x8 ak[2][4];
#pragma unroll
                for (int ks = 0; ks < 4; ++ks) ak[0][ks] = *(const LAS bf16x8*)(Ks + r16 * AT_KROW + 32 * ks + 8 * q4);
#pragma unroll
                for (int t4 = 0; t4 < 4; ++t4) {
                    if (t4 < 3) {
#pragma unroll
                        for (int ks = 0; ks < 4; ++ks) ak[(t4 + 1) & 1][ks] = *(const LAS bf16x8*)(Ks + (16 * (t4 + 1) + r16) * AT_KROW + 32 * ks + 8 * q4); }
                    __builtin_amdgcn_sched_barrier(0);
                    f32x4 acc = {0.f, 0.f, 0.f, 0.f};
#pragma unroll
                    for (int ks = 0; ks < 4; ++ks) acc = mfma16(ak[t4 & 1][ks], qf[ks], acc);
                    *(LAS f32x4*)(Sw + r16 * AT_SROW + 16 * t4 + 4 * q4) = acc;
                    __builtin_amdgcn_sched_barrier(0); } }
            LDS_WAIT(); __builtin_amdgcn_wave_barrier();
            float lk[16], ls[16];
#pragma unroll
            for (int c = 0; c < 4; ++c) { const f32x4 sv = *(const LAS f32x4*)(Sw + r16 * AT_SROW + 16 * q4 + 4 * c);
#pragma unroll
                for (int e = 0; e < 4; ++e) { const float z2 = sv[e]; const float az = __builtin_fabsf(z2); const float ex = __builtin_amdgcn_exp2f(-az); const float sp = fmaxf(z2, 0.f) + __builtin_amdgcn_logf(1.0f + ex);
                    const bool valid = (j0 + 16 * q4 + 4 * c + e) < qrow; lk[4 * c + e] = valid ? -sp : 0.f; ls[4 * c + e] = valid ? (z2 - sp) : -1.0e30f; } }
            float run = 0.f, ps[16];
#pragma unroll
            for (int i = 15; i >= 0; --i) { ps[i] = run; run += lk[i]; }
            const float t0 = __shfl(run, r16), t1 = __shfl(run, r16 + 16), t2 = __shfl(run, r16 + 32), t3 = __shfl(run, r16 + 48);
            const float offs = (q4 < 1 ? t1 : 0.f) + (q4 < 2 ? t2 : 0.f) + (q4 < 3 ? t3 : 0.f);
            const float base = carry + offs;
            float wv[16];
#pragma unroll
            for (int i = 0; i < 16; ++i) wv[i] = __builtin_amdgcn_exp2f(ls[i] + ps[i] + base);
            carry += (t0 + t1) + (t2 + t3);
            v4u p0, p1;
            p0.x = cvt_pk_bf16(wv[0], wv[1]); p0.y = cvt_pk_bf16(wv[2], wv[3]); p0.z = cvt_pk_bf16(wv[4], wv[5]); p0.w = cvt_pk_bf16(wv[6], wv[7]);
            p1.x = cvt_pk_bf16(wv[8], wv[9]); p1.y = cvt_pk_bf16(wv[10], wv[11]); p1.z = cvt_pk_bf16(wv[12], wv[13]); p1.w = cvt_pk_bf16(wv[14], wv[15]);
            *(LAS v4u*)(Pw + r16 * AT_PROW + 16 * q4) = p0; *(LAS v4u*)(Pw + r16 * AT_PROW + 16 * q4 + 8) = p1;
            LDS_WAIT(); __builtin_amdgcn_wave_barrier();
            bf16x8 bp[2];
#pragma unroll
            for (int ks = 0; ks < 2; ++ks) bp[ks] = *(const LAS bf16x8*)(Pw + r16 * AT_PROW + 32 * ks + 8 * q4);
            const LAS bf16* vb = Vs + (8 * q4 + (r16 >> 2)) * AT_VROW + 4 * (r16 & 3);
            {
                s16x4 vlo[2][2], vhi[2][2];
#pragma unroll
                for (int ks = 0; ks < 2; ++ks) { vlo[0][ks] = lds_tr(vb + 32 * ks * AT_VROW); vhi[0][ks] = lds_tr(vb + (32 * ks + 4) * AT_VROW); }
#pragma unroll
                for (int dt = 0; dt < 8; ++dt) {
                    if (dt < 7) {
#pragma unroll
                        for (int ks = 0; ks < 2; ++ks) { vlo[(dt + 1) & 1][ks] = lds_tr(vb + 32 * ks * AT_VROW + 16 * (dt + 1)); vhi[(dt + 1) & 1][ks] = lds_tr(vb + (32 * ks + 4) * AT_VROW + 16 * (dt + 1)); } }
                    __builtin_amdgcn_sched_barrier(0);
#pragma unroll
                    for (int ks = 0; ks < 2; ++ks) { const bf16x8 av = __builtin_shufflevector(vlo[dt & 1][ks], vhi[dt & 1][ks], 0, 1, 2, 3, 4, 5, 6, 7); o[dt] = mfma16(av, bp[ks], o[dt]); }
                    __builtin_amdgcn_sched_barrier(0); } }
            done = __all(carry < AT_THR);
        }
        if (kt > 0) { AT_STAGE(buf ^ 1); if (kt > 1) AT_LOAD(kt - 2); }
        if (lane == 0) flag[(it & 1) * 8 + wave] = (!done && kt > 0) ? 1u : 0u;
        __syncthreads();
        unsigned any = 0;
#pragma unroll
        for (int i = 0; i < 8; ++i) any |= flag[(it & 1) * 8 + i];
        if (!any) break;
        --kt; buf ^= 1; ++it;
    }
#undef AT_LOAD
#undef AT_STAGE
    bf16* Y = (bf16*)(ws + WS_YMIX) + (size_t)(b * SEQ + qrow) * 2048 + 1024 + h * 128 + 4 * q4;
    float q = 0.f;
#pragma unroll
    for (int dt = 0; dt < 8; ++dt) { v2u w; w.x = cvt_pk_bf16(o[dt][0], o[dt][1]); w.y = cvt_pk_bf16(o[dt][2], o[dt][3]); *(v2u*)(Y + 16 * dt) = w; q += (o[dt][0] * o[dt][0] + o[dt][1] * o[dt][1]) + (o[dt][2] * o[dt][2] + o[dt][3] * o[dt][3]); }
    q += __shfl_xor(q, 16); q += __shfl_xor(q, 32);
    if (q4 == 0 && do_ss) atomicAdd((float*)(ws + WS_STAT) + ST_SB * MROWS + b * SEQ + qrow, q);
    __syncthreads();
}

#define XB_TMO      128
#define XB_XCNT(j)  (256  + 64 * (j))
#define XB_XSUB(j)  (1280 + 64 * (j))
#define XB_XGEN(j)  (2304 + 64 * (j))
#define XB_TOP      3328
#define XB_TOPGEN   3392
#define XCD_BAR_WORDS 3456
#define XB_SPIN_CAP (1u << 18)

__device__ __forceinline__ unsigned xb_ld(unsigned* p)              { return __hip_atomic_load(p, __ATOMIC_RELAXED, __HIP_MEMORY_SCOPE_AGENT); }
__device__ __forceinline__ unsigned xb_add(unsigned* p, unsigned v) { return __hip_atomic_fetch_add(p, v, __ATOMIC_RELAXED, __HIP_MEMORY_SCOPE_AGENT); }
__device__ __forceinline__ unsigned xb_xcc_id() { return (unsigned)__builtin_amdgcn_s_getreg((3 << 11) | 20) & 0xFu; }
#define XB_SPIN(cond, bar) do { unsigned _sp = 0; while (cond) { __builtin_amdgcn_s_sleep(1); \
    if ((++_sp & 255u) == 0u) { if (xb_ld(&(bar)[XB_TMO])) break; if (_sp > XB_SPIN_CAP) { atomicAdd(&(bar)[XB_TMO], 1u); break; } } } } while (0)

struct XcdBarrier {
    unsigned* bar; unsigned x;
    volatile LAS unsigned* st;
};

__device__ __forceinline__ XcdBarrier xcd_barrier_post(unsigned* bar, volatile LAS unsigned* st) {
    XcdBarrier b; b.bar = bar; b.x = xb_xcc_id(); b.st = st;
    if (threadIdx.x == 0) (void)xb_add(&bar[XB_XCNT(b.x)], 1u);
    return b;
}
__device__ __forceinline__ void xcd_barrier_complete(unsigned* bar, unsigned x, unsigned& nloc, unsigned& nx) {
    const unsigned G = gridDim.x * gridDim.y * gridDim.z;
    unsigned sum, cnt, mine, sp = 0u;
    for (;;) {
        sum = 0u; cnt = 0u; mine = 0u;
#pragma unroll
        for (unsigned j = 0; j < 16; ++j) { const unsigned c = xb_ld(&bar[XB_XCNT(j)]); sum += c; cnt += (c > 0u) ? 1u : 0u; mine = (j == x) ? c : mine; }
        if (sum == G) break;
        __builtin_amdgcn_s_sleep(1);
        if ((++sp & 255u) == 0u) { if (xb_ld(&bar[XB_TMO])) break; if (sp > XB_SPIN_CAP) { atomicAdd(&bar[XB_TMO], 1u); break; } }
    }
    nloc = mine > 0u ? mine : 1u; nx = cnt > 0u ? cnt : 1u;
}

__device__ __forceinline__ void xcd_barrier(const XcdBarrier& b) {
    asm volatile("s_waitcnt vmcnt(0)" ::: "memory");
    __syncthreads();
    if (threadIdx.x == 0) {
        unsigned* bar = b.bar;
        __builtin_amdgcn_s_waitcnt(0);
        unsigned nloc = b.st[0], nx = b.st[1];
        if (nloc == 0u) { xcd_barrier_complete(bar, b.x, nloc, nx); b.st[0] = nloc; b.st[1] = nx; }
        const unsigned old = xb_add(&bar[XB_XSUB(b.x)], 1u);
        const unsigned gen = old / nloc;
        if (old + 1u == (gen + 1u) * nloc) {
            __builtin_amdgcn_fence(__ATOMIC_RELEASE, "agent");
            asm volatile("s_waitcnt vmcnt(0)" ::: "memory");
            const unsigned og = xb_add(&bar[XB_TOP], 1u);
            const unsigned tg = og / nx;
            if (og + 1u == (tg + 1u) * nx) xb_add(&bar[XB_TOPGEN], 1u);
            else XB_SPIN(xb_ld(&bar[XB_TOPGEN]) == tg, bar);
            __builtin_amdgcn_fence(__ATOMIC_ACQUIRE, "agent");
            xb_add(&bar[XB_XGEN(b.x)], 1u);
            asm volatile("s_waitcnt vmcnt(0)" ::: "memory");
        } else {
            XB_SPIN(xb_ld(&bar[XB_XGEN(b.x)]) == gen, bar);
            __builtin_amdgcn_fence(__ATOMIC_ACQUIRE, "agent");
            asm volatile("s_waitcnt vmcnt(0)" ::: "memory");
        }
    }
    __syncthreads();
}

static_assert(BAR_WORDS == XCD_BAR_WORDS, "barrier words");
struct Args { const float* in[31]; float* out; unsigned char* ws; };
#ifndef MK_PHASE_MASK
#define MK_PHASE_MASK 0xFFFFFFFFu
#endif
__global__ void __launch_bounds__(NTHREADS, 2) mk_fwd(Args args) {
    extern __shared__ __attribute__((aligned(16))) unsigned char lds_raw[];
    LAS unsigned char* lds = (LAS unsigned char*)lds_raw;
    cg::grid_group grid = cg::this_grid();
    volatile LAS unsigned* bar_st = (volatile LAS unsigned*)(lds + XCH_OFF + 12288);
    if (threadIdx.x < 2) bar_st[threadIdx.x] = 0u;
    __syncthreads();
    const int wave_s = __builtin_amdgcn_readfirstlane(threadIdx.x >> 6);
#define FRESH_IDS unsigned ones_ = ~0u; asm volatile("" : "+s"(ones_)); const int lane = (int)__builtin_amdgcn_mbcnt_hi(ones_, __builtin_amdgcn_mbcnt_lo(ones_, 0u)), wave = wave_s, tid = wave * 64 + lane; (void)tid; (void)lane; (void)wave;
    const int G = gridDim.x, bx = blockIdx.x;
    unsigned char* ws = args.ws; float* out = args.out;
    In in;
    in.x = args.in[0]; in.p = args.in[1]; in.ffn1_norm = args.in[2]; in.ffn1_wg = args.in[3]; in.ffn1_wu = args.in[4]; in.ffn1_wd = args.in[5]; in.mix_norm = args.in[6]; in.w_in = args.in[7];
    in.lam_re = args.in[8]; in.lam_im = args.in[9]; in.b_re = args.in[10]; in.b_im = args.in[11]; in.c_re = args.in[12]; in.c_im = args.in[13]; in.log_dt = args.in[14]; in.ssm_d = args.in[15];
    in.w_glu = args.in[16]; in.b_glu = args.in[17]; in.q_norm = args.in[18]; in.k_norm = args.in[19]; in.on_ssm = args.in[20]; in.on_sb = args.in[21]; in.w_out = args.in[22];
    in.ffn2_norm = args.in[23]; in.ffn2_wg = args.in[24]; in.ffn2_wu = args.in[25]; in.ffn2_wd = args.in[26]; in.ple_norm = args.in[27]; in.w_pg = args.in[28]; in.w_pp = args.in[29]; in.ple_post = args.in[30];
    float* stat = (float*)(ws + WS_STAT);
    bf16* XB = (bf16*)(ws + WS_XB); bf16* ACT = (bf16*)(ws + WS_ACT); bf16* YMIX = (bf16*)(ws + WS_YMIX);
#define PH(k) ((MK_PHASE_MASK >> (k)) & 1u)
#ifndef MK_DUP
#define MK_DUP 0u
#endif
#define NREP(k) (1 + (int)((MK_DUP >> (k)) & 1u))

    { FRESH_IDS p0_prologue(in, out, ws, lds, tid, lane, wave); }
    grid.sync();
    const XcdBarrier xbar = xcd_barrier_post((unsigned*)(ws + WS_BAR), bar_st);
    for (int rep_ = 0; rep_ < NREP(1); ++rep_) { pg8::Gemm g{XB, (const bf16*)(ws + WS_WGU1), MROWS, 2 * FF, DM, DM}; pg8::StaticOrder S; S.init(MROWS, 2 * FF, G, bx);
        pg8::EpiSwiGLU<false> E{ACT, stat + ST_SS1 * MROWS, FF, (LAS float*)(lds + XCH_OFF), 1.0f}; pg8::gemm_phase<pg8::EpiSwiGLU<false>, pg8::StaticOrder, true, true>(lds, g, S, E, wave_s); }
    xcd_barrier(xbar);
    for (int rep_ = 0; rep_ < NREP(2); ++rep_) { pg8::Gemm g{ACT, (const bf16*)(ws + WS_WD1), MROWS, DM, FF, FF}; pg8::StaticOrder S; S.init(MROWS, DM, G, bx);
        pg8::EpiResid<0, false> E{nullptr, XB, (rep_ + 1 < NREP(2)) ? nullptr : stat + ST_SS2 * MROWS, nullptr, nullptr, nullptr, 0.5f}; pg8::gemm_phase<pg8::EpiResid<0, false>, pg8::StaticOrder, true, true, true>(lds, g, S, E, wave_s); }
    xcd_barrier(xbar);
    for (int rep_ = 0; rep_ < NREP(3); ++rep_) { pg8::Gemm g{XB, (const bf16*)(ws + WS_WIN), MROWS, NIN, DM, DM}; pg8::StaticOrder S; S.init(MROWS, NIN, G, bx);
        pg8::EpiWin E{stat + ST_SS2 * MROWS, (bf16*)(ws + WS_UG), (bf16*)(ws + WS_Q), (bf16*)(ws + WS_K), (bf16*)(ws + WS_V), in.q_norm, in.k_norm, (LAS float*)(lds + XCH_OFF)};
        pg8::gemm_phase<pg8::EpiWin, pg8::StaticOrder, true, true>(lds, g, S, E, wave_s); }
    xcd_barrier(xbar);
    { FRESH_IDS
        for (int itt = bx; itt < (512 + 2048) * P4_REP; itt += G) { const int it = itt % (512 + 2048);
            if (it < 512) ssm_unit(ws, lds, it >> 6, it & 63, lane, wave);
            else { const int a = it - 512; attn_unit(ws, lds, a >> 8, (a >> 5) & 7, a & 31, tid, lane, wave, itt >= (512 + 2048) * (P4_REP - 1)); }
        }
    }
    xcd_barrier(xbar);
    if (PH(5)) { pg8::Gemm g{(const bf16*)(ws + WS_Z), (const bf16*)(ws + WS_WGLU), MROWS, SSMW, SSMW, SSMW}; pg8::StaticOrder S; S.init(MROWS, SSMW, G, bx);
        pg8::EpiGlu E{(const bf16*)(ws + WS_Z), in.b_glu, YMIX, stat + ST_SSM * MROWS}; pg8::gemm_phase<pg8::EpiGlu, pg8::StaticOrder, true, true>(lds, g, S, E, wave_s); }
    xcd_barrier(xbar);
    if (PH(6)) { pg8::Gemm g{YMIX, (const bf16*)(ws + WS_WOUT), MROWS, DM, DM, DM / 2}; pg8::SplitOrder S; S.base.init(MROWS, DM, G, bx);
        pg8::EpiResid<1, false, false, true> E{nullptr, XB, stat + ST_SS3 * MROWS, stat + ST_SSM * MROWS, stat + ST_SB * MROWS, ws + WS_XB8, 0.f}; pg8::gemm_phase<pg8::EpiResid<1, false, false, true>, pg8::SplitOrder, true, true>(lds, g, S, E, wave_s); }
    xcd_barrier(xbar);
    if (PH(7)) { pg8::Gemm g{(const bf16*)(ws + WS_XB8), (const bf16*)(ws + WS_WGU2), MROWS, 2 * FF, DM / 2, DM / 2}; pg8::StaticOrder S; S.init(MROWS, 2 * FF, G, bx);
        pg8::EpiSwiGLU<false, true> E{ACT, stat + ST_SS3 * MROWS, FF, (LAS float*)(lds + XCH_OFF), 1.0f / (pg8::F8_X_SCALE * pg8::F8_W_SCALE)}; pg8::gemm_phase<pg8::EpiSwiGLU<false, true>, pg8::StaticOrder, true, true, false, true>(lds, g, S, E, wave_s); }
    xcd_barrier(xbar);
    if (PH(8)) { pg8::Gemm g{ACT, (const bf16*)(ws + WS_WD2), MROWS, DM, FF, FF}; pg8::StaticOrder S; S.init(MROWS, DM, G, bx);
        pg8::EpiResid<0, false> E{nullptr, XB, stat + ST_SS4 * MROWS, nullptr, nullptr, nullptr, 0.5f}; pg8::gemm_phase<pg8::EpiResid<0, false>, pg8::StaticOrder, true, true, true>(lds, g, S, E, wave_s); }
    xcd_barrier(xbar);
    if (PH(9)) { pg8::Gemm g{(const bf16*)(ws + WS_PB), (const bf16*)(ws + WS_WPP), MROWS, DM, PLE, PLE}; pg8::StaticOrder S; S.init(MROWS, DM, G, bx);
        pg8::EpiPlain E{YMIX, DM}; pg8::gemm_phase<pg8::EpiPlain, pg8::StaticOrder, true, true>(lds, g, S, E, wave_s); }
    asm volatile("s_waitcnt vmcnt(0)" ::: "memory"); __syncthreads();
    if (PH(10)) { pg8::Gemm g{XB, (const bf16*)(ws + WS_WPG), MROWS, DM, DM, DM}; pg8::StaticOrder S; S.init(MROWS, DM, G, bx);
        pg8::EpiPle E{YMIX, stat + ST_SS4 * MROWS, (bf16*)(ws + WS_E), stat + ST_SSE * MROWS}; pg8::gemm_phase<pg8::EpiPle, pg8::StaticOrder, true, true>(lds, g, S, E, wave_s); }
    xcd_barrier(xbar);
    if (PH(11)) { FRESH_IDS const bf16* E = (const bf16*)(ws + WS_E); const float* sse = stat + ST_SSE * MROWS; const int gw = bx * NWAVES + wave, NGW = G * NWAVES;
        for (int m = gw; m < MROWS; m += NGW) { const float r = pg8::rstd_of(sse[m], 1.0f / 2048.0f); GAS f32x4* xr = (GAS f32x4*)(out + (size_t)m * DM) + lane; const GAS v2u* xbr = (const GAS v2u*)(XB + (size_t)m * DM) + lane; const GAS v2u* er = (const GAS v2u*)(E + (size_t)m * DM) + lane;
            const GAS f32x4* gp = (const GAS f32x4*)in.ple_post + lane;
#pragma unroll
            for (int j = 0; j < 8; ++j) { const v2u xw = xbr[64 * j]; const v2u w = er[64 * j]; const f32x4 gg = gp[64 * j]; f32x4 v;
                v.x = pg8::bf_lo(xw.x) + pg8::bf_lo(w.x) * r * gg.x; v.y = pg8::bf_hi(xw.x) + pg8::bf_hi(w.x) * r * gg.y; v.z = pg8::bf_lo(xw.y) + pg8::bf_lo(w.y) * r * gg.z; v.w = pg8::bf_hi(xw.y) + pg8::bf_hi(w.y) * r * gg.w; xr[64 * j] = v; } } }
#undef PH
}

extern "C" void kernel_launch(void* const* d_in, const int* in_sizes, int n_in, void* d_out, int out_size, void* d_ws, size_t ws_size, hipStream_t stream) {
    static int grid = 0;
    if (grid == 0) {
        if (n_in != 31 || out_size != MROWS * DM || ws_size < WS_END) { fprintf(stderr, "kernel_launch: unexpected shapes (n_in %d, out %d, ws %zu)\n", n_in, out_size, ws_size); grid = -1; return; }
        int dev = 0, cus = 0, per_cu = 0;
        hipGetDevice(&dev); hipDeviceGetAttribute(&cus, hipDeviceAttributeMultiprocessorCount, dev);
        if (hipFuncSetAttribute((const void*)mk_fwd, hipFuncAttributeMaxDynamicSharedMemorySize, LDS_BYTES) != hipSuccess) { fprintf(stderr, "kernel_launch: hipFuncSetAttribute failed\n"); grid = -1; return; }
        if (hipOccupancyMaxActiveBlocksPerMultiprocessor(&per_cu, (const void*)mk_fwd, NTHREADS, LDS_BYTES) != hipSuccess || per_cu < 1) { fprintf(stderr, "kernel_launch: occupancy query gives %d\n", per_cu); per_cu = 1; }
        (void)hipGetLastError();
        grid = cus * 1;
    }
    if (grid < 0) return;
    Args a{};
    for (int i = 0; i < 31; ++i) a.in[i] = (const float*)d_in[i];
    a.out = (float*)d_out; a.ws = (unsigned char*)d_ws;
    void* kargs[] = {&a};
    hipError_t e = hipLaunchCooperativeKernel((const void*)mk_fwd, dim3(grid), dim3(NTHREADS), kargs, LDS_BYTES, stream);
    if (e != hipSuccess) fprintf(stderr, "kernel_launch: cooperative launch failed: %s (grid %d)\n", hipGetErrorString(e), grid);
}
```

```cpp
#include <hip/hip_runtime.h>
#include <hip/hip_cooperative_groups.h>
#include <cstdio>
#include <cstdint>
namespace cg = cooperative_groups;
namespace pg8 {
#define PG8_LAS __attribute__((address_space(3)))
typedef unsigned short bf16_t;
typedef short bf16x8 __attribute__((ext_vector_type(8)));
typedef float f32x4 __attribute__((ext_vector_type(4)));
typedef unsigned u32x4 __attribute__((ext_vector_type(4)));
constexpr int BM = 256, BK = 64, HALF = 128, HTB = HALF * BK * 2  , STAGE_BYTES = 8 * HTB, NXCD = 8, WGM = 8;

__host__ __device__ __forceinline__ int lds_byte(int r, int c) { const int st = (r >> 4) * 2 + (c >> 5), rr = r & 15, cc = c & 31, ob = rr * 64 + cc * 2; return st * 1024 + (ob ^ (((ob >> 9) & 1) << 5)); }
__host__ __device__ __forceinline__ void stage_rc(int b, int& R, int& C) { const int st = b / 1024, sb = b % 1024, swz = sb ^ (((sb >> 9) & 1) << 5); R = (st >> 1) * 16 + swz / 64; C = (st & 1) * 32 + (swz % 64) / 2; }
__host__ __device__ __forceinline__ int perm32(int rho) { const int n = rho >> 4, i = rho & 15; return 8 * (i >> 2) + 4 * n + (i & 3); }

struct Unit { int pm, pn, kh, par; };
struct Gemm { const bf16_t* A; const bf16_t* Bt; int M, N, K, KU; };

struct StaticOrder {
    int nM, nN, nwg, G, c;
    __host__ __device__ void init(int M, int N, int G_, int c_) { nM = M / BM; nN = N / BM; nwg = nM * nN; G = G_; c = c_; }
    __host__ __device__ bool next(int i, Unit& u) const {
        const long L = (long)i * G + c; if (L >= nwg) return false;
        int wgid = (int)L; { const int q = nwg / NXCD, r = nwg % NXCD, xcd = wgid % NXCD, off = wgid / NXCD; wgid = (xcd < r ? xcd * (q + 1) : r * (q + 1) + (xcd - r) * q) + off; }
        const int nig = WGM * nN, gid = wgid / nig, fm = gid * WGM, gsz = (nM - fm) < WGM ? (nM - fm) : WGM;
        u.pm = fm + ((wgid % nig) % gsz); u.pn = (wgid % nig) / gsz; u.kh = 0; return true;
    }
    __device__ __forceinline__ void a_ready(const Unit&) const {}
    __device__ __forceinline__ void done(const Unit&) const {}
};

__device__ __forceinline__ unsigned cvt_pk_bf16(float lo, float hi) { unsigned r; asm volatile("v_cvt_pk_bf16_f32 %0, %1, %2" : "=v"(r) : "v"(lo), "v"(hi)); return r; }
typedef int i32x4 __attribute__((ext_vector_type(4)));
typedef int i32x8 __attribute__((ext_vector_type(8)));
__device__ __forceinline__ i32x8 cat8(bf16x8 a, bf16x8 b) { return __builtin_shufflevector(__builtin_bit_cast(i32x4, a), __builtin_bit_cast(i32x4, b), 0, 1, 2, 3, 4, 5, 6, 7); }
__device__ __forceinline__ unsigned pack4_fp8(float a, float b, float c, float d) {
    a = __builtin_fminf(__builtin_fmaxf(a, -448.f), 448.f); b = __builtin_fminf(__builtin_fmaxf(b, -448.f), 448.f); c = __builtin_fminf(__builtin_fmaxf(c, -448.f), 448.f); d = __builtin_fminf(__builtin_fmaxf(d, -448.f), 448.f);
    int w = __builtin_amdgcn_cvt_pk_fp8_f32(a, b, 0, false); w = __builtin_amdgcn_cvt_pk_fp8_f32(c, d, w, true); return (unsigned)w; }
constexpr float F8_ACT_SCALE = 8.0f, F8_W_SCALE = 64.0f, F8_X_SCALE = 16.0f;
struct SplitOrder {
    StaticOrder base;
    __device__ bool next(int i, Unit& u) const { const bool r = base.next(i >> 1, u); u.kh = i & 1; return r; }
    __device__ __forceinline__ void a_ready(const Unit&) const {}
    __device__ __forceinline__ void done(const Unit&) const {}
};
typedef float f32x2 __attribute__((ext_vector_type(2)));
__device__ __forceinline__ float rstd_of(float ss, float inv_n) { return __builtin_amdgcn_rsqf(ss * inv_n + 1e-6f); }
__device__ __forceinline__ float sigmoid_f(float v) { return __builtin_amdgcn_rcpf(1.0f + __builtin_amdgcn_exp2f(-1.4426950408889634f * v)); }
__device__ __forceinline__ float bf_lo(unsigned w) { return __uint_as_float(w << 16); }
__device__ __forceinline__ float bf_hi(unsigned w) { return __uint_as_float(w & 0xffff0000u); }
__device__ __forceinline__ u32x4 pack8(const f32x4 a, const f32x4 b) { u32x4 w; w.x = cvt_pk_bf16(a[0], a[1]); w.y = cvt_pk_bf16(a[2], a[3]); w.z = cvt_pk_bf16(b[0], b[1]); w.w = cvt_pk_bf16(b[2], b[3]); return w; }
__device__ __forceinline__ float sumsq4(const f32x4 a) { return (a[0] * a[0] + a[1] * a[1]) + (a[2] * a[2] + a[3] * a[3]); }

template <bool F8OUT, bool OPQ = false> struct EpiSwiGLU {
    static constexpr bool PERM = true, AFTER_DRAIN = false, MID = false, PREF = true;
    bf16_t* O; const float* ss; int ldo; PG8_LAS float* sl; float ascale;
    __device__ __forceinline__ void prefetch(const Unit& u, int wid, int lane) const {
        if (wid < 4) __builtin_amdgcn_global_load_lds((const unsigned*)(ss + u.pm * BM + 64 * wid + lane), (PG8_LAS unsigned*)(sl + u.par * 256 + 64 * wid), 4, 0, 0);
    }
    __device__ __forceinline__ void operator()(f32x4 (&acc)[2][2][4][2], const Unit& u_, int wr, int wc, int fr, int fq) const {
        Unit u = u_; if constexpr (OPQ) { unsigned o1_ = ~0u; asm volatile("" : "+s"(u.pm), "+s"(u.pn), "+s"(o1_)); const int l_ = (int)__builtin_amdgcn_mbcnt_hi(o1_, __builtin_amdgcn_mbcnt_lo(o1_, 0u)); fr = l_ & 15; fq = l_ >> 4; }
        const int row0 = u.pm * BM + wr * 64 + fr, col0 = u.pn * HALF + wc * 32 + 8 * fq;
#pragma unroll
        for (int ai = 0; ai < 2; ++ai)
#pragma unroll
            for (int m = 0; m < 4; ++m) {
                const int row = row0 + ai * HALF + m * 16; const float r = rstd_of(sl[u.par * 256 + ai * HALF + wr * 64 + m * 16 + fr], 1.0f / 2048.0f) * ascale;
                f32x4 o[2];
#pragma unroll
                for (int n = 0; n < 2; ++n) { const f32x4 g = acc[ai][0][m][n] * r, uu = acc[ai][1][m][n] * r;
#pragma unroll
                    for (int e = 0; e < 4; ++e) o[n][e] = g[e] * uu[e] * sigmoid_f(g[e]); }
                if constexpr (F8OUT) {
                    typedef unsigned u32x2 __attribute__((ext_vector_type(2))); u32x2 w8; w8.x = pack4_fp8(o[0][0] * F8_ACT_SCALE, o[0][1] * F8_ACT_SCALE, o[0][2] * F8_ACT_SCALE, o[0][3] * F8_ACT_SCALE);
                    w8.y = pack4_fp8(o[1][0] * F8_ACT_SCALE, o[1][1] * F8_ACT_SCALE, o[1][2] * F8_ACT_SCALE, o[1][3] * F8_ACT_SCALE);
                    *(u32x2*)((unsigned char*)O + (((size_t)u.pm * (ldo / 128) + (col0 >> 7)) * BM + (ai * HALF + wr * 64 + m * 16 + fr)) * 128 + (col0 & 127)) = w8;
                } else
                *(u32x4*)(O + (((size_t)u.pm * (ldo / 64) + (col0 >> 6)) * BM + (ai * HALF + wr * 64 + m * 16 + fr)) * 64 + (col0 & 63)) = pack8(o[0], o[1]);
            }
    }
    __device__ __forceinline__ void mid(f32x4 (&)[2][2][4][2], const Unit&, int, int) const {}
};

template <int MODE, bool XF32, bool BATCH = true, bool OPQ = false> struct EpiResid {
    static constexpr bool PERM = true, AFTER_DRAIN = false, MID = (MODE == 1), PREF = false;
    const float* xin; bf16_t* xb; float* ssout; const float* ssa; const float* ssb; unsigned char* x8; float alpha;
    __device__ __forceinline__ void mid(f32x4 (&acc)[2][2][4][2], const Unit& u, int wr, int fr) const {
        {
            const int row0 = u.pm * BM + wr * 64 + fr;
#pragma unroll
            for (int ai = 0; ai < 2; ++ai)
#pragma unroll
                for (int m = 0; m < 4; ++m) { const int row = row0 + ai * HALF + m * 16;
                    const float ra = rstd_of(ssa[row], 1.0f / 1024.0f), rb = rstd_of(ssb[row], 1.0f / 1024.0f), ratio = ra * __builtin_amdgcn_rcpf(rb);
#pragma unroll
                    for (int bj = 0; bj < 2; ++bj)
#pragma unroll
                        for (int n = 0; n < 2; ++n) acc[ai][bj][m][n] = acc[ai][bj][m][n] * ratio;
                    asm volatile("" ::: "memory"); }
        }
    }
    __device__ __forceinline__ void operator()(f32x4 (&acc)[2][2][4][2], const Unit& u_, int wr, int wc, int fr, int fq) const {
        Unit u = u_; if constexpr (OPQ) { unsigned o1_ = ~0u; asm volatile("" : "+s"(u.pm), "+s"(u.pn), "+s"(o1_)); const int l_ = (int)__builtin_amdgcn_mbcnt_hi(o1_, __builtin_amdgcn_mbcnt_lo(o1_, 0u)); fr = l_ & 15; fq = l_ >> 4; }
        if (MODE == 1 && u.kh == 0) { mid(acc, u, wr, fr); return; }
        const int row0 = u.pm * BM + wr * 64 + fr, col0 = u.pn * BM + wc * 32 + 8 * fq;
        u32x4 xw[2][4][2]; f32x4 xf[XF32 ? 16 : 1][2];
#pragma unroll
        for (int ai = 0; ai < 2; ++ai)
#pragma unroll
            for (int m = 0; m < 4; ++m)
#pragma unroll
                for (int bj = 0; bj < 2; ++bj) { const size_t off = (size_t)(row0 + ai * HALF + m * 16) * 2048 + col0 + bj * HALF;
                    if constexpr (XF32) { xf[(ai * 4 + m) * 2 + bj][0] = *(const f32x4*)(xin + off); xf[(ai * 4 + m) * 2 + bj][1] = *(const f32x4*)(xin + off + 4); }
                    else if constexpr (BATCH) xw[ai][m][bj] = *(const u32x4*)(xb + off); }
#pragma unroll
        for (int ai = 0; ai < 2; ++ai)
#pragma unroll
            for (int m = 0; m < 4; ++m) {
                const int row = row0 + ai * HALF + m * 16; const size_t off = (size_t)row * 2048 + col0;
                float sc = alpha; if constexpr (MODE == 1) sc = rstd_of(ssb[row], 1.0f / 1024.0f);
                float q = 0.f;
#pragma unroll
                for (int bj = 0; bj < 2; ++bj) {
                    f32x4 x0, x1;
                    if constexpr (XF32) { x0 = xf[(ai * 4 + m) * 2 + bj][0]; x1 = xf[(ai * 4 + m) * 2 + bj][1]; }
                    else { const u32x4 w = BATCH ? xw[ai][m][bj] : *(const u32x4*)(xb + off + bj * HALF); x0 = (f32x4){bf_lo(w.x), bf_hi(w.x), bf_lo(w.y), bf_hi(w.y)}; x1 = (f32x4){bf_lo(w.z), bf_hi(w.z), bf_lo(w.w), bf_hi(w.w)}; }
                    const f32x4 v0 = x0 + acc[ai][bj][m][0] * sc, v1 = x1 + acc[ai][bj][m][1] * sc;
                    *(u32x4*)(xb + off + bj * HALF) = pack8(v0, v1);
                    if (x8) { typedef unsigned u32x2 __attribute__((ext_vector_type(2))); u32x2 w8; w8.x = pack4_fp8(v0[0] * F8_X_SCALE, v0[1] * F8_X_SCALE, v0[2] * F8_X_SCALE, v0[3] * F8_X_SCALE);
                        w8.y = pack4_fp8(v1[0] * F8_X_SCALE, v1[1] * F8_X_SCALE, v1[2] * F8_X_SCALE, v1[3] * F8_X_SCALE); *(u32x2*)(x8 + off + bj * HALF) = w8; }
                    q += sumsq4(v0) + sumsq4(v1);
                }
                q += __shfl_xor(q, 16); q += __shfl_xor(q, 32);
                if (fq == 0 && ssout) atomicAdd(ssout + row, q);
                if constexpr (!BATCH) { if (m == 3) asm volatile("" ::: "memory"); }
            }
    }
};

struct EpiWin {
    static constexpr bool PERM = true, AFTER_DRAIN = false, MID = false, PREF = false;
    const float* ss; bf16_t *UG, *Q, *K, *V; const float *gq, *gk; PG8_LAS float* xch;
    __device__ __forceinline__ void mid(f32x4 (&)[2][2][4][2], const Unit&, int, int) const {}
    __device__ __forceinline__ void operator()(f32x4 (&acc)[2][2][4][2], const Unit& u, int wr, int wc, int fr, int fq) const {
        const int row0 = u.pm * BM + wr * 64 + fr, seg = u.pn >> 2, lc0 = (u.pn & 3) * BM + wc * 32 + 8 * fq; const float* ssr = ss + row0;
        if (seg == 0) {
#pragma unroll
            for (int ai = 0; ai < 2; ++ai)
#pragma unroll
                for (int m = 0; m < 4; ++m) { const float r = rstd_of(ssr[ai * HALF + m * 16], 1.0f / 2048.0f); const int row = row0 + ai * HALF + m * 16, b = row >> 12, t = row & 4095;
#pragma unroll
                    for (int bj = 0; bj < 2; ++bj) { const int col = lc0 + bj * HALF, g = col >> 4, half = (col >> 3) & 1;
                        *(u32x4*)(UG + ((size_t)((b * 64 + g) * 4096 + t) * 16 + 8 * half)) = pack8(acc[ai][bj][m][0] * r, acc[ai][bj][m][1] * r); } }
        } else if (seg == 3) {
#pragma unroll
            for (int ai = 0; ai < 2; ++ai)
#pragma unroll
                for (int m = 0; m < 4; ++m) { const float r = rstd_of(ssr[ai * HALF + m * 16], 1.0f / 2048.0f); const int row = row0 + ai * HALF + m * 16;
#pragma unroll
                    for (int bj = 0; bj < 2; ++bj) *(u32x4*)(V + (size_t)row * 1024 + lc0 + bj * HALF) = pack8(acc[ai][bj][m][0] * r, acc[ai][bj][m][1] * r); }
        } else {
#pragma unroll
            for (int ai = 0; ai < 2; ++ai)
#pragma unroll
                for (int m = 0; m < 4; ++m) { const int rl = ai * HALF + wr * 64 + m * 16 + fr;
#pragma unroll
                    for (int bj = 0; bj < 2; ++bj) { float q = sumsq4(acc[ai][bj][m][0]) + sumsq4(acc[ai][bj][m][1]); q += __shfl_xor(q, 16); q += __shfl_xor(q, 32);
                        if (fq == 0) xch[rl * 8 + bj * 4 + wc] = q; } }
            asm volatile("s_waitcnt lgkmcnt(0)" ::: "memory"); __builtin_amdgcn_s_barrier(); asm volatile("" ::: "memory");
            const float* gain = (seg == 1) ? gq : gk; bf16_t* dst = (seg == 1) ? Q : K;
            const float osc = (seg == 1) ? (0.08838834764831845f * 1.4426950408889634f) : 1.0f;
            const int d0 = wc * 32 + 8 * fq;
            const f32x4 g0 = *(const f32x4*)(gain + d0) * osc, g1 = *(const f32x4*)(gain + d0 + 4) * osc;
#pragma unroll
            for (int ai = 0; ai < 2; ++ai)
#pragma unroll
                for (int m = 0; m < 4; ++m) { const int rl = ai * HALF + wr * 64 + m * 16 + fr, row = u.pm * BM + rl;
                    const float epr = 1e-6f * (ssr[ai * HALF + m * 16] * (1.0f / 2048.0f) + 1e-6f);
#pragma unroll
                    for (int bj = 0; bj < 2; ++bj) { const f32x4 p = *(const PG8_LAS f32x4*)(xch + rl * 8 + bj * 4);
                        const float rq = __builtin_amdgcn_rsqf(((p[0] + p[1]) + (p[2] + p[3])) * (1.0f / 128.0f) + epr);
                        *(u32x4*)(dst + (size_t)row * 1024 + lc0 + bj * HALF) = pack8(acc[ai][bj][m][0] * g0 * rq, acc[ai][bj][m][1] * g1 * rq); } }
        }
    }
};

struct EpiGlu {
    static constexpr bool PERM = true, AFTER_DRAIN = false, MID = false, PREF = false;
    const bf16_t* Z; const float* bias; bf16_t* Y; float* ssout;
    __device__ __forceinline__ void mid(f32x4 (&)[2][2][4][2], const Unit&, int, int) const {}
    __device__ __forceinline__ void operator()(f32x4 (&acc)[2][2][4][2], const Unit& u, int wr, int wc, int fr, int fq) const {
        const int row0 = u.pm * BM + wr * 64 + fr, col0 = u.pn * BM + wc * 32 + 8 * fq;
        f32x4 bv[2][2];
#pragma unroll
        for (int bj = 0; bj < 2; ++bj)
#pragma unroll
            for (int n = 0; n < 2; ++n) bv[bj][n] = *(const f32x4*)(bias + col0 + bj * HALF + 4 * n);
        u32x4 zw[2][4][2];
#pragma unroll
        for (int ai = 0; ai < 2; ++ai)
#pragma unroll
            for (int m = 0; m < 4; ++m)
#pragma unroll
                for (int bj = 0; bj < 2; ++bj) zw[ai][m][bj] = *(const u32x4*)(Z + (size_t)(row0 + ai * HALF + m * 16) * 1024 + col0 + bj * HALF);
#pragma unroll
        for (int ai = 0; ai < 2; ++ai)
#pragma unroll
            for (int m = 0; m < 4; ++m) { const int row = row0 + ai * HALF + m * 16; float q = 0.f;
#pragma unroll
                for (int bj = 0; bj < 2; ++bj) { const u32x4 zb = zw[ai][m][bj];
                    const f32x4 z0 = {bf_lo(zb.x), bf_hi(zb.x), bf_lo(zb.y), bf_hi(zb.y)}, z1 = {bf_lo(zb.z), bf_hi(zb.z), bf_lo(zb.w), bf_hi(zb.w)};
                    const f32x4 a0 = acc[ai][bj][m][0] + bv[bj][0], a1 = acc[ai][bj][m][1] + bv[bj][1]; f32x4 y0, y1;
#pragma unroll
                    for (int e = 0; e < 4; ++e) { y0[e] = z0[e] * sigmoid_f(a0[e]); y1[e] = z1[e] * sigmoid_f(a1[e]); }
                    *(u32x4*)(Y + (size_t)row * 2048 + col0 + bj * HALF) = pack8(y0, y1); q += sumsq4(y0) + sumsq4(y1); }
                q += __shfl_xor(q, 16); q += __shfl_xor(q, 32);
                if (fq == 0) atomicAdd(ssout + row, q); }
    }
};

struct EpiPle {
    static constexpr bool PERM = true, AFTER_DRAIN = false, MID = false, PREF = false;
    const bf16_t* PP; const float* ss; bf16_t* E; float* ssout;
    __device__ __forceinline__ void mid(f32x4 (&)[2][2][4][2], const Unit&, int, int) const {}
    __device__ __forceinline__ void operator()(f32x4 (&acc)[2][2][4][2], const Unit& u, int wr, int wc, int fr, int fq) const {
        const int row0 = u.pm * BM + wr * 64 + fr, col0 = u.pn * BM + wc * 32 + 8 * fq;
        u32x4 pw[2][4][2];
#pragma unroll
        for (int ai = 0; ai < 2; ++ai)
#pragma unroll
            for (int m = 0; m < 4; ++m)
#pragma unroll
                for (int bj = 0; bj < 2; ++bj) pw[ai][m][bj] = *(const u32x4*)(PP + (size_t)(row0 + ai * HALF + m * 16) * 2048 + col0 + bj * HALF);
#pragma unroll
        for (int ai = 0; ai < 2; ++ai)
#pragma unroll
            for (int m = 0; m < 4; ++m) { const int row = row0 + ai * HALF + m * 16; const float r = rstd_of(ss[row], 1.0f / 2048.0f); float q = 0.f;
#pragma unroll
                for (int bj = 0; bj < 2; ++bj) { const u32x4 pb = pw[ai][m][bj];
                    const f32x4 p0 = {bf_lo(pb.x), bf_hi(pb.x), bf_lo(pb.y), bf_hi(pb.y)}, p1 = {bf_lo(pb.z), bf_hi(pb.z), bf_lo(pb.w), bf_hi(pb.w)};
                    const f32x4 a0 = acc[ai][bj][m][0] * r, a1 = acc[ai][bj][m][1] * r; f32x4 y0, y1;
#pragma unroll
                    for (int e = 0; e < 4; ++e) { y0[e] = p0[e] * sigmoid_f(a0[e]); y1[e] = p1[e] * sigmoid_f(a1[e]); }
                    *(u32x4*)(E + (size_t)row * 2048 + col0 + bj * HALF) = pack8(y0, y1); q += sumsq4(y0) + sumsq4(y1); }
                q += __shfl_xor(q, 16); q += __shfl_xor(q, 32);
                if (fq == 0) atomicAdd(ssout + row, q); }
    }
};

struct EpiPlain {
    static constexpr bool PERM = true, AFTER_DRAIN = false, MID = false, PREF = false;
    bf16_t* O; int ldo;
    __device__ __forceinline__ void mid(f32x4 (&)[2][2][4][2], const Unit&, int, int) const {}
    __device__ __forceinline__ void operator()(f32x4 (&acc)[2][2][4][2], const Unit& u, int wr, int wc, int fr, int fq) const {
        const int row0 = u.pm * BM + wr * 64 + fr, col0 = u.pn * BM + wc * 32 + 8 * fq;
#pragma unroll
        for (int ai = 0; ai < 2; ++ai)
#pragma unroll
            for (int m = 0; m < 4; ++m) { const int row = row0 + ai * HALF + m * 16;
#pragma unroll
                for (int bj = 0; bj < 2; ++bj) *(u32x4*)(O + (size_t)row * ldo + col0 + bj * HALF) = pack8(acc[ai][bj][m][0], acc[ai][bj][m][1]); }
    }
};
template <class Epi, class Sched, bool ALIGN_EPI = false, bool SP2 = false, bool ABLK = false, bool F8 = false>
__device__ __forceinline__ void gemm_phase(PG8_LAS unsigned char* lds, const Gemm g, const Sched& S, const Epi& E, const int wave_s) {
    unsigned ones_ = ~0u; asm volatile("" : "+s"(ones_));
    const int lane = (int)__builtin_amdgcn_mbcnt_hi(ones_, __builtin_amdgcn_mbcnt_lo(ones_, 0u)), wid = wave_s, tid = wid * 64 + lane, wr = wid >> 2, wc = wid & 3, fr = lane & 15, fq = lane >> 4;
    const int K = g.K, nt = g.KU / BK;
    unsigned voffA[2], voffB[2];
#pragma unroll
    for (int i = 0; i < 2; ++i) { int R, C; stage_rc(tid * 16 + i * 8192, R, C); const int Rb = Epi::PERM ? ((R & ~31) + perm32(R & 31)) : R;
        voffA[i] = ABLK ? (unsigned)(R * BK + C) * 2u : (unsigned)(R * K + C) * 2u; voffB[i] = (unsigned)(Rb * K + C) * 2u; }
    const size_t kstep = (size_t)(BK * 2);
    const size_t hstep = (size_t)HALF * K * 2;
    const size_t tstep = 2 * hstep;
    const size_t kstepA = ABLK ? (size_t)(BM * BK * 2) : kstep, hstepA = ABLK ? (size_t)(HALF * BK * 2) : hstep;
    const unsigned ldsw = (unsigned)wid * 1024u;
    const int aoff = lds_byte(wr * 64 + fr, fq * 8), boff = lds_byte(wc * 32 + fr, fq * 8);
#define PG8_SA(b, h) (((b) * 2 + (h)) * HTB)
#define PG8_SB(b, h) ((4 + (b) * 2 + (h)) * HTB)
#define PG8_STAGE(bufoff, gbase, voff) do { _Pragma("unroll") for (int _i = 0; _i < 2; ++_i) \
        { unsigned _vo = (voff)[_i]; asm volatile("" : "+v"(_vo));     \
        __builtin_amdgcn_global_load_lds((const unsigned*)((const char*)(gbase) + _vo), (PG8_LAS unsigned*)(lds + (bufoff) + ldsw + _i * 8192), 16, 0, 0); } } while (0)
#define PG8_LDA(dst, b, h) do { _Pragma("unroll") for (int m = 0; m < 4; ++m) _Pragma("unroll") for (int k = 0; k < 2; ++k) dst[m][k] = *(const PG8_LAS bf16x8*)(lds + PG8_SA(b, h) + aoff + m * 2048 + k * 1024); } while (0)
#define PG8_LDB(dst, b, h) do { _Pragma("unroll") for (int n = 0; n < 2; ++n) _Pragma("unroll") for (int k = 0; k < 2; ++k) dst[n][k] = *(const PG8_LAS bf16x8*)(lds + PG8_SB(b, h) + boff + n * 2048 + k * 1024); } while (0)
#define PG8_MMA(ai, bj, At, Bt) do { __builtin_amdgcn_s_setprio(1); if constexpr (F8) { _Pragma("unroll") for (int m = 0; m < 4; ++m) _Pragma("unroll") for (int n = 0; n < 2; ++n) \
        acc[ai][bj][m][n] = __builtin_amdgcn_mfma_scale_f32_16x16x128_f8f6f4(cat8(Bt[n][0], Bt[n][1]), cat8(At[m][0], At[m][1]), acc[ai][bj][m][n], 0, 0, 0, 0x7F7F7F7F, 0, 0x7F7F7F7F); } \
    else { _Pragma("unroll") for (int m = 0; m < 4; ++m) _Pragma("unroll") for (int n = 0; n < 2; ++n) _Pragma("unroll") for (int k = 0; k < 2; ++k) \
        acc[ai][bj][m][n] = __builtin_amdgcn_mfma_f32_16x16x32_bf16(Bt[n][k], At[m][k], acc[ai][bj][m][n], 0, 0, 0); } __builtin_amdgcn_s_setprio(0); } while (0)
#define PG8_WAIT_V(n) asm volatile("s_waitcnt vmcnt(" #n ")" ::: "memory")
#define PG8_WAIT_L(n) asm volatile("s_waitcnt lgkmcnt(" #n ")" ::: "memory")
#define PG8_BAR __builtin_amdgcn_s_barrier()
#define PG8_SCHED __builtin_amdgcn_sched_barrier(0)
    Unit cur, nxt; int ui = 0;
    if (!S.next(0, cur)) return;
    cur.par = 0;
    if constexpr (Epi::PREF) E.prefetch(cur, wid, lane);
    f32x4 acc[2][2][4][2];
#pragma unroll
    for (int a = 0; a < 2; ++a)
#pragma unroll
        for (int b = 0; b < 2; ++b)
#pragma unroll
            for (int m = 0; m < 4; ++m)
#pragma unroll
                for (int n = 0; n < 2; ++n) acc[a][b][m][n] = (f32x4){0.f, 0.f, 0.f, 0.f};
    bf16x8 At[4][2], B0[2][2], B1[2][2];
    const size_t khb = (size_t)g.KU * 2, khbA = ABLK ? (size_t)(g.KU / BK) * kstepA : khb; const char* cA = (const char*)g.A + (size_t)cur.pm * tstep + cur.kh * khbA; const char* cB = (const char*)g.Bt + (size_t)cur.pn * tstep + cur.kh * khb;
    S.a_ready(cur);
    if constexpr (SP2) {
        PG8_STAGE(PG8_SB(0, 0), cB, voffB); PG8_STAGE(PG8_SB(0, 1), cB + hstep, voffB); PG8_STAGE(PG8_SA(0, 0), cA, voffA); PG8_STAGE(PG8_SA(0, 1), cA + hstepA, voffA);
        if (wr == 1) PG8_BAR;
        PG8_WAIT_V(2); PG8_BAR;
        PG8_STAGE(PG8_SB(1, 0), cB + kstep, voffB); PG8_STAGE(PG8_SA(1, 0), cA + kstepA, voffA); PG8_STAGE(PG8_SB(1, 1), cB + hstep + kstep, voffB);
        PG8_WAIT_V(6); PG8_BAR;
    } else {
        PG8_STAGE(PG8_SB(0, 0), cB, voffB); PG8_STAGE(PG8_SA(0, 0), cA, voffA); PG8_STAGE(PG8_SB(0, 1), cB + hstep, voffB); PG8_STAGE(PG8_SA(0, 1), cA + hstepA, voffA);
        if (wr == 1) PG8_BAR;
        PG8_WAIT_V(4); PG8_BAR;
        PG8_STAGE(PG8_SB(1, 0), cB + kstep, voffB); PG8_STAGE(PG8_SA(1, 0), cA + kstepA, voffA); PG8_STAGE(PG8_SB(1, 1), cB + hstep + kstep, voffB);
        PG8_WAIT_V(6); PG8_BAR;
    }
    for (;;) {
        const bool has_next = S.next(ui + 1, nxt); nxt.par = (ui + 1) & 1;
        const char* nA = has_next ? (const char*)g.A + (size_t)nxt.pm * tstep + nxt.kh * khbA : cA; const char* nB = has_next ? (const char*)g.Bt + (size_t)nxt.pn * tstep + nxt.kh * khb : cB;
        for (int t = 0; t < nt; t += 2) {
            const bool last = (t == nt - 2);
            const char* a1 = cA + (size_t)(t + 1) * kstepA;
            const char* a2 = last ? nA : cA + (size_t)(t + 2) * kstepA; const char* b2 = last ? nB : cB + (size_t)(t + 2) * kstep;
            const char* a3 = a2 + kstepA; const char* b3 = b2 + kstep;
            if (last && has_next) { S.a_ready(nxt); if constexpr (Epi::PREF) E.prefetch(nxt, wid, lane); }
            if constexpr (SP2) {
            PG8_LDB(B0, 0, 0); PG8_LDB(B1, 0, 1); PG8_SCHED; PG8_LDA(At, 0, 0); PG8_STAGE(PG8_SA(1, 1), a1 + hstepA, voffA);
            PG8_WAIT_V(8); PG8_WAIT_L(0); PG8_BAR; PG8_MMA(0, 0, At, B0); PG8_MMA(0, 1, At, B1); PG8_BAR; PG8_SCHED;
            PG8_LDA(At, 0, 1); PG8_STAGE(PG8_SB(0, 0), b2, voffB); PG8_STAGE(PG8_SB(0, 1), b2 + hstep, voffB); PG8_STAGE(PG8_SA(0, 0), a2, voffA);
            PG8_WAIT_V(8); PG8_WAIT_L(0); PG8_BAR; PG8_MMA(1, 0, At, B0); PG8_MMA(1, 1, At, B1); PG8_BAR; PG8_SCHED;
            PG8_LDB(B0, 1, 0); PG8_LDB(B1, 1, 1); PG8_SCHED; PG8_LDA(At, 1, 0); PG8_STAGE(PG8_SA(0, 1), a2 + hstepA, voffA);
            PG8_WAIT_V(8); PG8_WAIT_L(0); PG8_BAR; PG8_MMA(0, 0, At, B0); PG8_MMA(0, 1, At, B1); PG8_BAR; PG8_SCHED;
            PG8_LDA(At, 1, 1); PG8_STAGE(PG8_SB(1, 0), b3, voffB); PG8_STAGE(PG8_SB(1, 1), b3 + hstep, voffB); PG8_STAGE(PG8_SA(1, 0), a3, voffA);
            PG8_WAIT_V(8); PG8_WAIT_L(0); PG8_BAR; PG8_MMA(1, 0, At, B0); PG8_MMA(1, 1, At, B1); PG8_BAR; PG8_SCHED;
            } else {
            PG8_LDB(B0, 0, 0); PG8_SCHED; PG8_LDA(At, 0, 0); PG8_STAGE(PG8_SA(1, 1), a1 + hstepA, voffA);
            PG8_WAIT_L(8); PG8_BAR; PG8_WAIT_L(0); PG8_MMA(0, 0, At, B0); PG8_BAR; PG8_SCHED;
            PG8_LDB(B1, 0, 1); PG8_STAGE(PG8_SB(0, 0), b2, voffB);
            PG8_BAR; PG8_WAIT_L(0); PG8_MMA(0, 1, At, B1); PG8_BAR;
            PG8_LDA(At, 0, 1); PG8_STAGE(PG8_SA(0, 0), a2, voffA);
            PG8_BAR; PG8_WAIT_L(0); PG8_MMA(1, 0, At, B0); PG8_BAR; PG8_SCHED;
            PG8_STAGE(PG8_SB(0, 1), b2 + hstep, voffB);
            PG8_WAIT_V(6); PG8_BAR; PG8_MMA(1, 1, At, B1); PG8_BAR;
            PG8_LDB(B0, 1, 0); PG8_SCHED; PG8_LDA(At, 1, 0); PG8_STAGE(PG8_SA(0, 1), a2 + hstepA, voffA);
            PG8_WAIT_L(8); PG8_BAR; PG8_WAIT_L(0); PG8_MMA(0, 0, At, B0); PG8_BAR; PG8_SCHED;
            PG8_LDB(B1, 1, 1); PG8_STAGE(PG8_SB(1, 0), b3, voffB);
            PG8_BAR; PG8_WAIT_L(0); PG8_MMA(0, 1, At, B1); PG8_BAR;
            PG8_LDA(At, 1, 1); PG8_STAGE(PG8_SA(1, 0), a3, voffA);
            PG8_BAR; PG8_WAIT_L(0); PG8_MMA(1, 0, At, B0); PG8_BAR; PG8_SCHED;
            PG8_STAGE(PG8_SB(1, 1), b3 + hstep, voffB);
            PG8_WAIT_V(6); PG8_BAR; PG8_MMA(1, 1, At, B1); PG8_BAR;
            }
        }
        if constexpr (ALIGN_EPI) { if (wr == 0) PG8_BAR; }
        if constexpr (!Epi::AFTER_DRAIN) { E(acc, cur, wr, wc, fr, fq); S.done(cur); }
        if (!has_next) break;
        if (!(Epi::MID && cur.kh == 0))
#pragma unroll
        for (int a = 0; a < 2; ++a)
#pragma unroll
            for (int b = 0; b < 2; ++b)
#pragma unroll
                for (int m = 0; m < 4; ++m)
#pragma unroll
                    for (int n = 0; n < 2; ++n) acc[a][b][m][n] = (f32x4){0.f, 0.f, 0.f, 0.f};
        cur = nxt; cA = nA; cB = nB; ++ui;
        if constexpr (ALIGN_EPI) { if (wr == 1) PG8_BAR; }
    }
    PG8_WAIT_V(0);
    if constexpr (!ALIGN_EPI) { if (wr == 0) PG8_BAR; }
    PG8_BAR;
    if constexpr (Epi::AFTER_DRAIN) { E.fused(acc, cur, wr, wc, fr, fq, lds, wid, lane); S.done(cur); }
#undef PG8_SA
#undef PG8_SB
#undef PG8_STAGE
#undef PG8_LDA
#undef PG8_LDB
#undef PG8_MMA
#undef PG8_WAIT_V
#undef PG8_WAIT_L
#undef PG8_BAR
#undef PG8_SCHED
}
}
constexpr int NWAVES = 8, NTHREADS = 512;
constexpr int DM = 2048, NB = 8, SEQ = 4096, MROWS = NB * SEQ, FF = 5632, PLE = 256;
constexpr int SSMW = 1024, NG = 64, GH = 16, NP = 64, SBW = 1024, NHEAD = 8, HD = 128, NIN = 4096;
constexpr size_t MiB = 1u << 20;
constexpr size_t WS_STAT = 0;
constexpr size_t WS_BAR = 960 * 1024;
constexpr int BAR_WORDS = 3456;
constexpr size_t WS_LAM8 = 1 * MiB;
constexpr size_t WS_SSMMAT = 2 * MiB;
constexpr size_t WS_WGU1 = 8 * MiB, WS_WD1 = 52 * MiB, WS_WIN = 74 * MiB, WS_WGLU = 90 * MiB, WS_WOUT = 92 * MiB, WS_WGU2 = 100 * MiB, WS_WD2 = 144 * MiB, WS_WPG = 166 * MiB, WS_WPP = 174 * MiB;
constexpr size_t WS_PB = 176 * MiB;
constexpr size_t WS_XB = 192 * MiB;
constexpr size_t WS_YMIX = 320 * MiB;
constexpr size_t WS_ACT = 448 * MiB;
constexpr size_t WS_UG = WS_ACT, WS_Q = WS_ACT + 64 * MiB, WS_K = WS_ACT + 128 * MiB, WS_V = WS_ACT + 192 * MiB, WS_Z = WS_ACT + 256 * MiB, WS_E = WS_ACT;
constexpr size_t WS_XB8 = 832 * MiB;
constexpr size_t WS_END = 896 * MiB;
enum { ST_SS1 = 0, ST_SS2, ST_SSM, ST_SB, ST_SS3, ST_SS4, ST_SSE, ST_N };
constexpr int RING_BYTES = 131072, XCH_OFF = RING_BYTES, LDS_BYTES = 147456;

#define GAS __attribute__((address_space(1)))
#define LAS __attribute__((address_space(3)))
typedef unsigned short bf16;
typedef unsigned v4u __attribute__((ext_vector_type(4)));
typedef unsigned v2u __attribute__((ext_vector_type(2)));
typedef float f32x4 __attribute__((ext_vector_type(4)));
typedef short bf16x8 __attribute__((ext_vector_type(8)));
#define LDS_WAIT() asm volatile("s_waitcnt lgkmcnt(0)" ::: "memory")
using pg8::cvt_pk_bf16;
__device__ __forceinline__ float wave_sum(float v) {
#pragma unroll
    for (int o = 1; o < 64; o <<= 1) v += __shfl_xor(v, o);
    return v;
}
__device__ __forceinline__ f32x4 mfma16(bf16x8 a, bf16x8 b, f32x4 c) { return __builtin_amdgcn_mfma_f32_16x16x32_bf16(a, b, c, 0, 0, 0); }

#ifndef MK_DUP
#define MK_DUP 0u
#endif
constexpr int P0_REP = 1 + (int)(MK_DUP & 1u), P4_REP = 1 + (int)((MK_DUP >> 4) & 1u);
__device__ __forceinline__ void tr_item(const float* W, int K, int N, const float* gain, bf16* WT, int k0, int n0, int dstrow, LAS float* scr, int lane, float f8s) {
    const int c4 = lane & 15, r0 = lane >> 4;
#pragma unroll 4
    for (int i = 0; i < 16; ++i) { const int kk = 4 * i + r0; f32x4 v = *(const GAS f32x4*)(W + (size_t)(k0 + kk) * N + n0 + 4 * c4); if (gain) v = v * gain[k0 + kk];
        *(LAS f32x4*)(scr + kk * 64 + 4 * (c4 ^ (2 * ((kk >> 3) & 7)))) = v; }
    LDS_WAIT(); asm volatile("" ::: "memory");
    const int c = lane & 7;
#pragma unroll
    for (int ps = 0; ps < 2; ++ps) { const int ng = (lane >> 3) + 8 * ps; f32x4 v[8];
#pragma unroll
        for (int j = 0; j < 8; ++j) v[j] = *(const LAS f32x4*)(scr + (8 * c + j) * 64 + 4 * (ng ^ (2 * c)));
#pragma unroll
        for (int i = 0; i < 4; ++i) {
            if (f8s != 0.f) { v2u o8; o8.x = pg8::pack4_fp8(v[0][i] * f8s, v[1][i] * f8s, v[2][i] * f8s, v[3][i] * f8s); o8.y = pg8::pack4_fp8(v[4][i] * f8s, v[5][i] * f8s, v[6][i] * f8s, v[7][i] * f8s);
                *(GAS v2u*)((GAS unsigned char*)WT + (size_t)(dstrow + 4 * ng + i) * K + k0 + 8 * c) = o8; continue; }
            v4u o; o.x = cvt_pk_bf16(v[0][i], v[1][i]); o.y = cvt_pk_bf16(v[2][i], v[3][i]); o.z = cvt_pk_bf16(v[4][i], v[5][i]); o.w = cvt_pk_bf16(v[6][i], v[7][i]);
            *(GAS v4u*)(WT + (size_t)(dstrow + 4 * ng + i) * K + k0 + 8 * c) = o; } }
    LDS_WAIT(); asm volatile("" ::: "memory");
}

struct In {
    const float *x, *p, *ffn1_norm, *ffn1_wg, *ffn1_wu, *ffn1_wd, *mix_norm, *w_in, *lam_re, *lam_im, *b_re, *b_im, *c_re, *c_im, *log_dt, *ssm_d, *w_glu, *b_glu, *q_norm, *k_norm,
        *on_ssm, *on_sb, *w_out, *ffn2_norm, *ffn2_wg, *ffn2_wu, *ffn2_wd, *ple_norm, *w_pg, *w_pp, *ple_post;
};

__device__ __forceinline__ void ssm_build(const In& in, unsigned char* ws, LAS unsigned char* lds, int g, int tid) {
    LAS float* PW = (LAS float*)lds;
    LAS float* CO = PW + 9 * 64 * 2;
    LAS float* CB = CO + 64 * 2;
    LAS float* KT = CB + 64 * 16 * 2;
    LAS float* CR = KT + 2048; LAS float* CI = CR + 1024;
    for (int i = tid; i < 1024; i += NTHREADS) { CR[i] = in.c_re[g * 1024 + i]; CI[i] = in.c_im[g * 1024 + i]; }
    if (tid < 64) {
        const int p = tid; const float dt = expf(in.log_dt[g]); const float lr = fminf(in.lam_re[g * 64 + p], -1e-4f), li = in.lam_im[g * 64 + p];
        const float a = lr * dt, th = li * dt; float s1, c1; sincosf(th, &s1, &c1); const float ea = expf(a);
        const float l1r = ea * c1, l1i = ea * s1;
        float pr = 1.f, pi = 0.f;
#pragma unroll
        for (int t = 0; t <= 8; ++t) { PW[(t * 64 + p) * 2] = pr; PW[(t * 64 + p) * 2 + 1] = pi; const float nr = pr * l1r - pi * l1i, ni = pr * l1i + pi * l1r; pr = nr; pi = ni; }
        float* l8 = (float*)(ws + WS_LAM8) + (g * 64 + p) * 2; l8[0] = PW[(8 * 64 + p) * 2]; l8[1] = PW[(8 * 64 + p) * 2 + 1];
        const float sh = sinf(0.5f * th); const float nr = expm1f(a) * c1 - 2.f * sh * sh, ni = l1i;
        const float den = 1.f / (lr * lr + li * li);
        CO[p * 2] = (nr * lr + ni * li) * den; CO[p * 2 + 1] = (ni * lr - nr * li) * den;
    }
    __syncthreads();
    for (int i = tid; i < 1024; i += NTHREADS) { const int p = i >> 4; const float br = in.b_re[g * 1024 + i], bi = in.b_im[g * 1024 + i], cr = CO[p * 2], ci = CO[p * 2 + 1];
        CB[i * 2] = cr * br - ci * bi; CB[i * 2 + 1] = cr * bi + ci * br; }
    __syncthreads();
    for (int i = tid; i < 2048; i += NTHREADS) { const int tau = i >> 8, h = (i >> 4) & 15, h2 = i & 15; float s = 0.f;
        for (int p = 0; p < 64; ++p) { const float cr = CR[h * 64 + p], ci = CI[h * 64 + p], pr = PW[(tau * 64 + p) * 2], pi = PW[(tau * 64 + p) * 2 + 1];
            const float wr = cr * pr - ci * pi, wi = cr * pi + ci * pr; s += wr * CB[(p * 16 + h2) * 2] - wi * CB[(p * 16 + h2) * 2 + 1]; }
        KT[i] = s; }
    __syncthreads();
    bf16* Ms = (bf16*)(ws + WS_SSMMAT) + (size_t)g * 3 * 16384; bf16* Mi = Ms + 16384; bf16* Mo = Mi + 16384;
    for (int i = tid; i < 16384; i += NTHREADS) { const int r = i >> 7, c = i & 127;
        { const int p = r & 63, s = c >> 4, h2 = c & 15; const float pr = PW[((7 - s) * 64 + p) * 2], pi = PW[((7 - s) * 64 + p) * 2 + 1], br = CB[(p * 16 + h2) * 2], bi = CB[(p * 16 + h2) * 2 + 1];
          const float v = (r < 64) ? (pr * br - pi * bi) : (pr * bi + pi * br); Ms[i] = (bf16)(cvt_pk_bf16(v, 0.f) & 0xffffu); }
        { const int t = r >> 4, h = r & 15, s = c >> 4, h2 = c & 15; float v = 0.f; if (s <= t) { v = KT[((t - s) * 16 + h) * 16 + h2]; if (r == c) v += in.ssm_d[g * 16 + h]; } Mi[i] = (bf16)(cvt_pk_bf16(v, 0.f) & 0xffffu); }
        { const int t = r >> 4, h = r & 15, p = c & 63; const float cr = CR[h * 64 + p], ci = CI[h * 64 + p], pr = PW[((t + 1) * 64 + p) * 2], pi = PW[((t + 1) * 64 + p) * 2 + 1];
          const float v = (c < 64) ? (cr * pr - ci * pi) : -(cr * pi + ci * pr); Mo[i] = (bf16)(cvt_pk_bf16(v, 0.f) & 0xffffu); }
    }
    __syncthreads();
}

__device__ __forceinline__ void p0_prologue(const In& in, float* out, unsigned char* ws, LAS unsigned char* lds, int tid, int lane, int wave) {
    const int G = gridDim.x, bx = blockIdx.x;
    if (bx == 0) { unsigned* bw = (unsigned*)(ws + WS_BAR); for (int i = tid; i < BAR_WORDS; i += NTHREADS) bw[i] = 0u; }
    for (int g = bx; g < NG; g += G) ssm_build(in, ws, lds, g, tid);
    { float* st = (float*)(ws + WS_STAT) + MROWS; for (int i = bx * NTHREADS + tid; i < (ST_N - 1) * MROWS; i += G * NTHREADS) st[i] = 0.f; }
    LAS float* scr = (LAS float*)(lds + wave * 16384);
    const int gw = bx * NWAVES + wave, NGW = G * NWAVES;
    constexpr int I_GU = (DM / 64) * (FF / 64), I_D = (FF / 64) * (DM / 64), I_IN = (DM / 64) * (NIN / 64), I_GLU = (SSMW / 64) * (SSMW / 64), I_SQ = (DM / 64) * (DM / 64), I_PP = (PLE / 64) * (DM / 64);
    constexpr int NITEMS = 4 * I_GU + 2 * I_D + I_IN + I_GLU + 2 * I_SQ + I_PP;
#define TR_ITEM(NI, Wp, Kd, Nd, gainp, dstoff, MODE, F8S) \
        if (r < (NI)) { const int nbk = (Nd) / 64, kb = r / nbk, nb = r % nbk, k0 = 64 * kb, n0 = 64 * nb; \
            const int dr = (MODE) == 0 ? n0 : (n0 / 128) * 256 + (n0 % 128) + ((MODE) == 2 ? 128 : 0); \
            tr_item((Wp), (Kd), (Nd), (gainp), (bf16*)(ws + (dstoff)), k0, n0, dr, scr, lane, (F8S)); continue; } r -= (NI);
    for (int it = gw; it < NITEMS * P0_REP; it += NGW) {
        int r = it % NITEMS;
        TR_ITEM(I_GU, in.ffn1_wg, DM, FF, in.ffn1_norm, WS_WGU1, 1, 0.f)
        TR_ITEM(I_GU, in.ffn1_wu, DM, FF, in.ffn1_norm, WS_WGU1, 2, 0.f)
        TR_ITEM(I_D, in.ffn1_wd, FF, DM, (const float*)nullptr, WS_WD1, 0, 0.f)
        TR_ITEM(I_IN, in.w_in, DM, NIN, in.mix_norm, WS_WIN, 0, 0.f)
        TR_ITEM(I_GLU, in.w_glu, SSMW, SSMW, (const float*)nullptr, WS_WGLU, 0, 0.f)
        TR_ITEM(I_SQ, in.w_out, DM, DM, (k0 < 1024 ? in.on_ssm : in.on_sb - 1024), WS_WOUT, 0, 0.f)
        TR_ITEM(I_GU, in.ffn2_wg, DM, FF, in.ffn2_norm, WS_WGU2, 1, pg8::F8_W_SCALE)
        TR_ITEM(I_GU, in.ffn2_wu, DM, FF, in.ffn2_norm, WS_WGU2, 2, pg8::F8_W_SCALE)
        TR_ITEM(I_D, in.ffn2_wd, FF, DM, (const float*)nullptr, WS_WD2, 0, 0.f)
        TR_ITEM(I_SQ, in.w_pg, DM, DM, in.ple_norm, WS_WPG, 0, 0.f)
        TR_ITEM(I_PP, in.w_pp, PLE, DM, (const float*)nullptr, WS_WPP, 0, 0.f)
    }
#undef TR_ITEM
    { bf16* XB = (bf16*)(ws + WS_XB); float* ss1 = (float*)(ws + WS_STAT) + ST_SS1 * MROWS;
      for (int mm = gw; mm < MROWS * P0_REP; mm += NGW) { const int m = mm % MROWS; const GAS f32x4* xr = (const GAS f32x4*)(in.x + (size_t)m * DM) + lane; GAS v2u* o = (GAS v2u*)(XB + (size_t)m * DM) + lane; float s = 0.f;
#pragma unroll
          for (int j = 0; j < 8; ++j) { const f32x4 v = xr[64 * j]; s += (v.x * v.x + v.y * v.y) + (v.z * v.z + v.w * v.w); v2u w; w.x = cvt_pk_bf16(v.x, v.y); w.y = cvt_pk_bf16(v.z, v.w); o[64 * j] = w; }
          s = wave_sum(s); if (lane == 0) ss1[m] = s; } }
    { const GAS f32x4* ps = (const GAS f32x4*)in.p; GAS v2u* o = (GAS v2u*)(ws + WS_PB);
      for (int i = bx * NTHREADS + tid; i < MROWS * PLE / 4; i += G * NTHREADS) { const f32x4 v = ps[i]; v2u w; w.x = cvt_pk_bf16(v.x, v.y); w.y = cvt_pk_bf16(v.z, v.w); o[i] = w; } }
}

constexpr int SSM_DROW = 132, SSM_SROW = 136;
__device__ __forceinline__ void ssm_unit(unsigned char* ws, LAS unsigned char* lds, int b, int g, int lane, int wave) {
    const int r16 = lane & 15, q4 = lane >> 4;
    LAS float* DL = (LAS float*)lds; LAS bf16* S0 = (LAS bf16*)(lds + 64 * SSM_DROW * 4);
    const bf16* Ms = (const bf16*)(ws + WS_SSMMAT) + (size_t)g * 3 * 16384; const bf16* Mi = Ms + 16384; const bf16* Mo = Mi + 16384;
    bf16x8 aS[4], aI[4], aO[4];
#pragma unroll
    for (int ks = 0; ks < 4; ++ks) { const int o = (16 * wave + r16) * 128 + 32 * ks + 8 * q4; aS[ks] = *(const bf16x8*)(Ms + o); aI[ks] = *(const bf16x8*)(Mi + o); aO[ks] = *(const bf16x8*)(Mo + o); }
    const bf16* ug = (const bf16*)(ws + WS_UG) + (size_t)(b * 64 + g) * 4096 * 16;
    bf16* zb = (bf16*)(ws + WS_Z) + (size_t)b * 4096 * 1024 + g * 16;
    const float* l8 = (const float*)(ws + WS_LAM8) + (g * 64 + lane) * 2; const float l8r = l8[0], l8i = l8[1];
    float sre = 0.f, sim = 0.f;
    bf16x8 bu[4][4];
#define SSM_LOADU(SEG) do { _Pragma("unroll") for (int nt = 0; nt < 4; ++nt) { const int n = 64 * (SEG) + 16 * nt + r16; _Pragma("unroll") for (int ks = 0; ks < 4; ++ks) \
        bu[nt][ks] = *(const bf16x8*)(ug + (size_t)(n * 8 + 2 * ks + (q4 >> 1)) * 16 + 8 * (q4 & 1)); } } while (0)
    SSM_LOADU(0);
    for (int seg = 0; seg < 8; ++seg) {
        f32x4 ay[4];
#pragma unroll
        for (int nt = 0; nt < 4; ++nt) { f32x4 acc = {0.f, 0.f, 0.f, 0.f}, accy = {0.f, 0.f, 0.f, 0.f};
#pragma unroll
            for (int ks = 0; ks < 4; ++ks) { acc = mfma16(aS[ks], bu[nt][ks], acc); accy = mfma16(aI[ks], bu[nt][ks], accy); }
            *(LAS f32x4*)(DL + (16 * nt + r16) * SSM_DROW + 16 * wave + 4 * q4) = acc; ay[nt] = accy; }
        if (seg < 7) SSM_LOADU(seg + 1);
        __syncthreads();
        if (wave == 0) {
            for (int nb = 0; nb < 64; nb += 8) {
                float dr[8], di[8];
#pragma unroll
                for (int j = 0; j < 8; ++j) { dr[j] = DL[(nb + j) * SSM_DROW + lane]; di[j] = DL[(nb + j) * SSM_DROW + 64 + lane]; }
#pragma unroll
                for (int j = 0; j < 8; ++j) { S0[(nb + j) * SSM_SROW + lane] = (bf16)(cvt_pk_bf16(sre, 0.f) & 0xffffu); S0[(nb + j) * SSM_SROW + 64 + lane] = (bf16)(cvt_pk_bf16(sim, 0.f) & 0xffffu);
                    const float nr = l8r * sre - l8i * sim + dr[j], ni = l8r * sim + l8i * sre + di[j]; sre = nr; sim = ni; } }
        }
        __syncthreads();
#pragma unroll
        for (int nt = 0; nt < 4; ++nt) { const int n = 64 * seg + 16 * nt + r16; f32x4 acc = ay[nt];
            bf16x8 bs[4];
#pragma unroll
            for (int ks = 0; ks < 4; ++ks) bs[ks] = *(const LAS bf16x8*)(S0 + (16 * nt + r16) * SSM_SROW + 32 * ks + 8 * q4);
#pragma unroll
            for (int ks = 0; ks < 4; ++ks) acc = mfma16(aO[ks], bs[ks], acc);
            f32x4 z;
#pragma unroll
            for (int e = 0; e < 4; ++e) { const float y = acc[e]; const float t = 1.5957691216057308f * (y + 0.044715f * y * y * y); z[e] = y * __builtin_amdgcn_rcpf(1.0f + __builtin_amdgcn_exp2f(-1.4426950408889634f * t)); }
            v2u w; w.x = cvt_pk_bf16(z[0], z[1]); w.y = cvt_pk_bf16(z[2], z[3]);
            *(v2u*)(zb + (size_t)(n * 8 + wave) * 1024 + 4 * q4) = w; }
    }
#undef SSM_LOADU
    __syncthreads();
}

constexpr int AT_KROW = 136, AT_VROW = 152, AT_SROW = 68, AT_PROW = 72;
constexpr int AT_KB = 64 * AT_KROW * 2, AT_VB = 64 * AT_VROW * 2, AT_BUF = AT_KB + AT_VB;
constexpr int AT_S_OFF = 2 * AT_BUF, AT_P_OFF = AT_S_OFF + 8 * 16 * AT_SROW * 4, AT_FLAG_OFF = AT_P_OFF + 8 * 16 * AT_PROW * 2;
static_assert(AT_FLAG_OFF + 64 <= RING_BYTES, "attention LDS");
constexpr float AT_THR = -152.0f;
typedef short s16x4 __attribute__((ext_vector_type(4)));
__device__ __forceinline__ s16x4 lds_tr(const LAS bf16* p) { return __builtin_bit_cast(s16x4, __builtin_amdgcn_ds_read_tr16_b64_v4i16((LAS s16x4*)p)); }
__device__ __forceinline__ void attn_unit(unsigned char* ws, LAS unsigned char* lds, int b, int h, int qb, int tid, int lane, int wave, bool do_ss) {
    const int r16 = lane & 15, q4 = lane >> 4;
    LAS float* Sw = (LAS float*)(lds + AT_S_OFF) + wave * 16 * AT_SROW; LAS bf16* Pw = (LAS bf16*)(lds + AT_P_OFF) + wave * 16 * AT_PROW;
    volatile LAS unsigned* flag = (volatile LAS unsigned*)(lds + AT_FLAG_OFF);
    const bf16* Qg = (const bf16*)(ws + WS_Q) + (size_t)b * SEQ * 1024 + h * 128;
    const bf16* Kg = (const bf16*)(ws + WS_K) + (size_t)b * SEQ * 1024 + h * 128;
    const bf16* Vg = (const bf16*)(ws + WS_V) + (size_t)b * SEQ * 1024 + h * 128;
    const int qw0 = 128 * qb + 16 * wave, qrow = qw0 + r16;
    bf16x8 qf[4];
#pragma unroll
    for (int ks = 0; ks < 4; ++ks) qf[ks] = *(const bf16x8*)(Qg + (size_t)qrow * 1024 + 32 * ks + 8 * q4);
    f32x4 o[8];
#pragma unroll
    for (int i = 0; i < 8; ++i) o[i] = (f32x4){0.f, 0.f, 0.f, 0.f};
    float carry = 0.f; bool done = false;
    const int pr0 = tid >> 4, pc = tid & 15;
    v4u kr[2], vr[2];
    int kt = 2 * qb + 1, buf = 0, it = 0;
#define AT_LOAD(KT) do { _Pragma("unroll") for (int i = 0; i < 2; ++i) { const size_t go = (size_t)(64 * (KT) + pr0 + 32 * i) * 1024 + 8 * pc; kr[i] = *(const v4u*)(Kg + go); vr[i] = *(const v4u*)(Vg + go); } } while (0)
#define AT_STAGE(B) do { _Pragma("unroll") for (int i = 0; i < 2; ++i) { const int row = pr0 + 32 * i; *(LAS v4u*)((LAS bf16*)(lds + (B) * AT_BUF) + row * AT_KROW + 8 * pc) = kr[i]; \
        *(LAS v4u*)((LAS bf16*)(lds + (B) * AT_BUF + AT_KB) + row * AT_VROW + 8 * pc) = vr[i]; } } while (0)
    AT_LOAD(kt); AT_STAGE(0);
    if (kt > 0) AT_LOAD(kt - 1);
    __syncthreads();
    for (;;) {
        const LAS bf16* Ks = (const LAS bf16*)(lds + buf * AT_BUF); const LAS bf16* Vs = (const LAS bf16*)(lds + buf * AT_BUF + AT_KB);
        const int j0 = 64 * kt;
        if (!done && j0 < qw0 + 15) {
            {
                bf16x8 ak[2][4];
#pragma unroll
                for (int ks = 0; ks < 4; ++ks) ak[0][ks] = *(const LAS bf16x8*)(Ks + r16 * AT_KROW + 32 * ks + 8 * q4);
#pragma unroll
                for (int t4 = 0; t4 < 4; ++t4) {
                    if (t4 < 3) {
#pragma unroll
                        for (int ks = 0; ks < 4; ++ks) ak[(t4 + 1) & 1][ks] = *(const LAS bf16x8*)(Ks + (16 * (t4 + 1) + r16) * AT_KROW + 32 * ks + 8 * q4); }
                    __builtin_amdgcn_sched_barrier(0);
                    f32x4 acc = {0.f, 0.f, 0.f, 0.f};
#pragma unroll
                    for (int ks = 0; ks < 4; ++ks) acc = mfma16(ak[t4 & 1][ks], qf[ks], acc);
                    *(LAS f32x4*)(Sw + r16 * AT_SROW + 16 * t4 + 4 * q4) = acc;
                    __builtin_amdgcn_sched_barrier(0); } }
            LDS_WAIT(); __builtin_amdgcn_wave_barrier();
            float lk[16], ls[16];
#pragma unroll
            for (int c = 0; c < 4; ++c) { const f32x4 sv = *(const LAS f32x4*)(Sw + r16 * AT_SROW + 16 * q4 + 4 * c);
#pragma unroll
                for (int e = 0; e < 4; ++e) { const float z2 = sv[e]; const float az = __builtin_fabsf(z2); const float ex = __builtin_amdgcn_exp2f(-az); const float sp = fmaxf(z2, 0.f) + __builtin_amdgcn_logf(1.0f + ex);
                    const bool valid = (j0 + 16 * q4 + 4 * c + e) < qrow; lk[4 * c + e] = valid ? -sp : 0.f; ls[4 * c + e] = valid ? (z2 - sp) : -1.0e30f; } }
            float run = 0.f, ps[16];
#pragma unroll
            for (int i = 15; i >= 0; --i) { ps[i] = run; run += lk[i]; }
            const float t0 = __shfl(run, r16), t1 = __shfl(run, r16 + 16), t2 = __shfl(run, r16 + 32), t3 = __shfl(run, r16 + 48);
            const float offs = (q4 < 1 ? t1 : 0.f) + (q4 < 2 ? t2 : 0.f) + (q4 < 3 ? t3 : 0.f);
            const float base = carry + offs;
            float wv[16];
#pragma unroll
            for (int i = 0; i < 16; ++i) wv[i] = __builtin_amdgcn_exp2f(ls[i] + ps[i] + base);
            carry += (t0 + t1) + (t2 + t3);
            v4u p0, p1;
            p0.x = cvt_pk_bf16(wv[0], wv[1]); p0.y = cvt_pk_bf16(wv[2], wv[3]); p0.z = cvt_pk_bf16(wv[4], wv[5]); p0.w = cvt_pk_bf16(wv[6], wv[7]);
            p1.x = cvt_pk_bf16(wv[8], wv[9]); p1.y = cvt_pk_bf16(wv[10], wv[11]); p1.z = cvt_pk_bf16(wv[12], wv[13]); p1.w = cvt_pk_bf16(wv[14], wv[15]);
            *(LAS v4u*)(Pw + r16 * AT_PROW + 16 * q4) = p0; *(LAS v4u*)(Pw + r16 * AT_PROW + 16 * q4 + 8) = p1;
            LDS_WAIT(); __builtin_amdgcn_wave_barrier();
            bf16x8 bp[2];
#pragma unroll
            for (int ks = 0; ks < 2; ++ks) bp[ks] = *(const LAS bf16x8*)(Pw + r16 * AT_PROW + 32 * ks + 8 * q4);
            const LAS bf16* vb = Vs + (8 * q4 + (r16 >> 2)) * AT_VROW + 4 * (r16 & 3);
            {
                s16x4 vlo[2][2], vhi[2][2];
#pragma unroll
                for (int ks = 0; ks < 2; ++ks) { vlo[0][ks] = lds_tr(vb + 32 * ks * AT_VROW); vhi[0][ks] = lds_tr(vb + (32 * ks + 4) * AT_VROW); }
#pragma unroll
                for (int dt = 0; dt < 8; ++dt) {
                    if (dt < 7) {
#pragma unroll
                        for (int ks = 0; ks < 2; ++ks) { vlo[(dt + 1) & 1][ks] = lds_tr(vb + 32 * ks * AT_VROW + 16 * (dt + 1)); vhi[(dt + 1) & 1][ks] = lds_tr(vb + (32 * ks + 4) * AT_VROW + 16 * (dt + 1)); } }
                    __builtin_amdgcn_sched_barrier(0);
#pragma unroll
                    for (int ks = 0; ks < 2; ++ks) { const bf16x8 av = __builtin_shufflevector(vlo[dt & 1][ks], vhi[dt & 1][ks], 0, 1, 2, 3, 4, 5, 6, 7); o[dt] = mfma16(av, bp[ks], o[dt]); }
                    __builtin_amdgcn_sched_barrier(0); } }
            done = __all(carry < AT_THR);
        }
        if (kt > 0) { AT_STAGE(buf ^ 1); if (kt > 1) AT_LOAD(kt - 2); }
        if (lane == 0) flag[(it & 1) * 8 + wave] = (!done && kt > 0) ? 1u : 0u;
        __syncthreads();
        unsigned any = 0;
#pragma unroll
        for (int i = 0; i < 8; ++i) any |= flag[(it & 1) * 8 + i];
        if (!any) break;
        --kt; buf ^= 1; ++it;
    }
#undef AT_LOAD
#undef AT_STAGE
    bf16* Y = (bf16*)(ws + WS_YMIX) + (size_t)(b * SEQ + qrow) * 2048 + 1024 + h * 128 + 4 * q4;
    float q = 0.f;
#pragma unroll
    for (int dt = 0; dt < 8; ++dt) { v2u w; w.x = cvt_pk_bf16(o[dt][0], o[dt][1]); w.y = cvt_pk_bf16(o[dt][2], o[dt][3]); *(v2u*)(Y + 16 * dt) = w; q += (o[dt][0] * o[dt][0] + o[dt][1] * o[dt][1]) + (o[dt][2] * o[dt][2] + o[dt][3] * o[dt][3]); }
    q += __shfl_xor(q, 16); q += __shfl_xor(q, 32);
    if (q4 == 0 && do_ss) atomicAdd((float*)(ws + WS_STAT) + ST_SB * MROWS + b * SEQ + qrow, q);
    __syncthreads();
}

#define XB_TMO      128
#define XB_XCNT(j)  (256  + 64 * (j))
#define XB_XSUB(j)  (1280 + 64 * (j))
#define XB_XGEN(j)  (2304 + 64 * (j))
#define XB_TOP      3328
#define XB_TOPGEN   3392
#define XCD_BAR_WORDS 3456
#define XB_SPIN_CAP (1u << 18)

__device__ __forceinline__ unsigned xb_ld(unsigned* p)              { return __hip_atomic_load(p, __ATOMIC_RELAXED, __HIP_MEMORY_SCOPE_AGENT); }
__device__ __forceinline__ unsigned xb_add(unsigned* p, unsigned v) { return __hip_atomic_fetch_add(p, v, __ATOMIC_RELAXED, __HIP_MEMORY_SCOPE_AGENT); }
__device__ __forceinline__ unsigned xb_xcc_id() { return (unsigned)__builtin_amdgcn_s_getreg((3 << 11) | 20) & 0xFu; }
#define XB_SPIN(cond, bar) do { unsigned _sp = 0; while (cond) { __builtin_amdgcn_s_sleep(1); \
    if ((++_sp & 255u) == 0u) { if (xb_ld(&(bar)[XB_TMO])) break; if (_sp > XB_SPIN_CAP) { atomicAdd(&(bar)[XB_TMO], 1u); break; } } } } while (0)

struct XcdBarrier {
    unsigned* bar; unsigned x;
    volatile LAS unsigned* st;
};

__device__ __forceinline__ XcdBarrier xcd_barrier_post(unsigned* bar, volatile LAS unsigned* st) {
    XcdBarrier b; b.bar = bar; b.x = xb_xcc_id(); b.st = st;
    if (threadIdx.x == 0) (void)xb_add(&bar[XB_XCNT(b.x)], 1u);
    return b;
}
__device__ __forceinline__ void xcd_barrier_complete(unsigned* bar, unsigned x, unsigned& nloc, unsigned& nx) {
    const unsigned G = gridDim.x * gridDim.y * gridDim.z;
    unsigned sum, cnt, mine, sp = 0u;
    for (;;) {
        sum = 0u; cnt = 0u; mine = 0u;
#pragma unroll
        for (unsigned j = 0; j < 16; ++j) { const unsigned c = xb_ld(&bar[XB_XCNT(j)]); sum += c; cnt += (c > 0u) ? 1u : 0u; mine = (j == x) ? c : mine; }
        if (sum == G) break;
        __builtin_amdgcn_s_sleep(1);
        if ((++sp & 255u) == 0u) { if (xb_ld(&bar[XB_TMO])) break; if (sp > XB_SPIN_CAP) { atomicAdd(&bar[XB_TMO], 1u); break; } }
    }
    nloc = mine > 0u ? mine : 1u; nx = cnt > 0u ? cnt : 1u;
}

__device__ __forceinline__ void xcd_barrier(const XcdBarrier& b) {
    asm volatile("s_waitcnt vmcnt(0)" ::: "memory");
    __syncthreads();
    if (threadIdx.x == 0) {
        unsigned* bar = b.bar;
        __builtin_amdgcn_s_waitcnt(0);
        unsigned nloc = b.st[0], nx = b.st[1];
        if (nloc == 0u) { xcd_barrier_complete(bar, b.x, nloc, nx); b.st[0] = nloc; b.st[1] = nx; }
        const unsigned old = xb_add(&bar[XB_XSUB(b.x)], 1u);
        const unsigned gen = old / nloc;
        if (old + 1u == (gen + 1u) * nloc) {
            __builtin_amdgcn_fence(__ATOMIC_RELEASE, "agent");
            asm volatile("s_waitcnt vmcnt(0)" ::: "memory");
            const unsigned og = xb_add(&bar[XB_TOP], 1u);
            const unsigned tg = og / nx;
            if (og + 1u == (tg + 1u) * nx) xb_add(&bar[XB_TOPGEN], 1u);
            else XB_SPIN(xb_ld(&bar[XB_TOPGEN]) == tg, bar);
            __builtin_amdgcn_fence(__ATOMIC_ACQUIRE, "agent");
            xb_add(&bar[XB_XGEN(b.x)], 1u);
            asm volatile("s_waitcnt vmcnt(0)" ::: "memory");
        } else {
            XB_SPIN(xb_ld(&bar[XB_XGEN(b.x)]) == gen, bar);
            __builtin_amdgcn_fence(__ATOMIC_ACQUIRE, "agent");
            asm volatile("s_waitcnt vmcnt(0)" ::: "memory");
        }
    }
    __syncthreads();
}

static_assert(BAR_WORDS == XCD_BAR_WORDS, "barrier words");
struct Args { const float* in[31]; float* out; unsigned char* ws; };
#ifndef MK_PHASE_MASK
#define MK_PHASE_MASK 0xFFFFFFFFu
#endif
__global__ void __launch_bounds__(NTHREADS, 2) mk_fwd(Args args) {
    extern __shared__ __attribute__((aligned(16))) unsigned char lds_raw[];
    LAS unsigned char* lds = (LAS unsigned char*)lds_raw;
    cg::grid_group grid = cg::this_grid();
    volatile LAS unsigned* bar_st = (volatile LAS unsigned*)(lds + XCH_OFF + 12288);
    if (threadIdx.x < 2) bar_st[threadIdx.x] = 0u;
    __syncthreads();
    const int wave_s = __builtin_amdgcn_readfirstlane(threadIdx.x >> 6);
#define FRESH_IDS unsigned ones_ = ~0u; asm volatile("" : "+s"(ones_)); const int lane = (int)__builtin_amdgcn_mbcnt_hi(ones_, __builtin_amdgcn_mbcnt_lo(ones_, 0u)), wave = wave_s, tid = wave * 64 + lane; (void)tid; (void)lane; (void)wave;
    const int G = gridDim.x, bx = blockIdx.x;
    unsigned char* ws = args.ws; float* out = args.out;
    In in;
    in.x = args.in[0]; in.p = args.in[1]; in.ffn1_norm = args.in[2]; in.ffn1_wg = args.in[3]; in.ffn1_wu = args.in[4]; in.ffn1_wd = args.in[5]; in.mix_norm = args.in[6]; in.w_in = args.in[7];
    in.lam_re = args.in[8]; in.lam_im = args.in[9]; in.b_re = args.in[10]; in.b_im = args.in[11]; in.c_re = args.in[12]; in.c_im = args.in[13]; in.log_dt = args.in[14]; in.ssm_d = args.in[15];
    in.w_glu = args.in[16]; in.b_glu = args.in[17]; in.q_norm = args.in[18]; in.k_norm = args.in[19]; in.on_ssm = args.in[20]; in.on_sb = args.in[21]; in.w_out = args.in[22];
    in.ffn2_norm = args.in[23]; in.ffn2_wg = args.in[24]; in.ffn2_wu = args.in[25]; in.ffn2_wd = args.in[26]; in.ple_norm = args.in[27]; in.w_pg = args.in[28]; in.w_pp = args.in[29]; in.ple_post = args.in[30];
    float* stat = (float*)(ws + WS_STAT);
    bf16* XB = (bf16*)(ws + WS_XB); bf16* ACT = (bf16*)(ws + WS_ACT); bf16* YMIX = (bf16*)(ws + WS_YMIX);
#define PH(k) ((MK_PHASE_MASK >> (k)) & 1u)
#ifndef MK_DUP
#define MK_DUP 0u
#endif
#define NREP(k) (1 + (int)((MK_DUP >> (k)) & 1u))

    { FRESH_IDS p0_prologue(in, out, ws, lds, tid, lane, wave); }
    grid.sync();
    const XcdBarrier xbar = xcd_barrier_post((unsigned*)(ws + WS_BAR), bar_st);
    for (int rep_ = 0; rep_ < NREP(1); ++rep_) { pg8::Gemm g{XB, (const bf16*)(ws + WS_WGU1), MROWS, 2 * FF, DM, DM}; pg8::StaticOrder S; S.init(MROWS, 2 * FF, G, bx);
        pg8::EpiSwiGLU<false> E{ACT, stat + ST_SS1 * MROWS, FF, (LAS float*)(lds + XCH_OFF), 1.0f}; pg8::gemm_phase<pg8::EpiSwiGLU<false>, pg8::StaticOrder, true, true>(lds, g, S, E, wave_s); }
    xcd_barrier(xbar);
    for (int rep_ = 0; rep_ < NREP(2); ++rep_) { pg8::Gemm g{ACT, (const bf16*)(ws + WS_WD1), MROWS, DM, FF, FF}; pg8::StaticOrder S; S.init(MROWS, DM, G, bx);
        pg8::EpiResid<0, false> E{nullptr, XB, (rep_ + 1 < NREP(2)) ? nullptr : stat + ST_SS2 * MROWS, nullptr, nullptr, nullptr, 0.5f}; pg8::gemm_phase<pg8::EpiResid<0, false>, pg8::StaticOrder, true, true, true>(lds, g, S, E, wave_s); }
    xcd_barrier(xbar);
    for (int rep_ = 0; rep_ < NREP(3); ++rep_) { pg8::Gemm g{XB, (const bf16*)(ws + WS_WIN), MROWS, NIN, DM, DM}; pg8::StaticOrder S; S.init(MROWS, NIN, G, bx);
        pg8::EpiWin E{stat + ST_SS2 * MROWS, (bf16*)(ws + WS_UG), (bf16*)(ws + WS_Q), (bf16*)(ws + WS_K), (bf16*)(ws + WS_V), in.q_norm, in.k_norm, (LAS float*)(lds + XCH_OFF)};
        pg8::gemm_phase<pg8::EpiWin, pg8::StaticOrder, true, true>(lds, g, S, E, wave_s); }
    xcd_barrier(xbar);
    { FRESH_IDS
        for (int itt = bx; itt < (512 + 2048) * P4_REP; itt += G) { const int it = itt % (512 + 2048);
            if (it < 512) ssm_unit(ws, lds, it >> 6, it & 63, lane, wave);
            else { const int a = it - 512; attn_unit(ws, lds, a >> 8, (a >> 5) & 7, a & 31, tid, lane, wave, itt >= (512 + 2048) * (P4_REP - 1)); }
        }
    }
    xcd_barrier(xbar);
    if (PH(5)) { pg8::Gemm g{(const bf16*)(ws + WS_Z), (const bf16*)(ws + WS_WGLU), MROWS, SSMW, SSMW, SSMW}; pg8::StaticOrder S; S.init(MROWS, SSMW, G, bx);
        pg8::EpiGlu E{(const bf16*)(ws + WS_Z), in.b_glu, YMIX, stat + ST_SSM * MROWS}; pg8::gemm_phase<pg8::EpiGlu, pg8::StaticOrder, true, true>(lds, g, S, E, wave_s); }
    xcd_barrier(xbar);
    if (PH(6)) { pg8::Gemm g{YMIX, (const bf16*)(ws + WS_WOUT), MROWS, DM, DM, DM / 2}; pg8::SplitOrder S; S.base.init(MROWS, DM, G, bx);
        pg8::EpiResid<1, false, false, true> E{nullptr, XB, stat + ST_SS3 * MROWS, stat + ST_SSM * MROWS, stat + ST_SB * MROWS, ws + WS_XB8, 0.f}; pg8::gemm_phase<pg8::EpiResid<1, false, false, true>, pg8::SplitOrder, true, true>(lds, g, S, E, wave_s); }
    xcd_barrier(xbar);
    if (PH(7)) { pg8::Gemm g{(const bf16*)(ws + WS_XB8), (const bf16*)(ws + WS_WGU2), MROWS, 2 * FF, DM / 2, DM / 2}; pg8::StaticOrder S; S.init(MROWS, 2 * FF, G, bx);
        pg8::EpiSwiGLU<false, true> E{ACT, stat + ST_SS3 * MROWS, FF, (LAS float*)(lds + XCH_OFF), 1.0f / (pg8::F8_X_SCALE * pg8::F8_W_SCALE)}; pg8::gemm_phase<pg8::EpiSwiGLU<false, true>, pg8::StaticOrder, true, true, false, true>(lds, g, S, E, wave_s); }
    xcd_barrier(xbar);
    if (PH(8)) { pg8::Gemm g{ACT, (const bf16*)(ws + WS_WD2), MROWS, DM, FF, FF}; pg8::StaticOrder S; S.init(MROWS, DM, G, bx);
        pg8::EpiResid<0, false> E{nullptr, XB, stat + ST_SS4 * MROWS, nullptr, nullptr, nullptr, 0.5f}; pg8::gemm_phase<pg8::EpiResid<0, false>, pg8::StaticOrder, true, true, true>(lds, g, S, E, wave_s); }
    xcd_barrier(xbar);
    if (PH(9)) { pg8::Gemm g{(const bf16*)(ws + WS_PB), (const bf16*)(ws + WS_WPP), MROWS, DM, PLE, PLE}; pg8::StaticOrder S; S.init(MROWS, DM, G, bx);
        pg8::EpiPlain E{YMIX, DM}; pg8::gemm_phase<pg8::EpiPlain, pg8::StaticOrder, true, true>(lds, g, S, E, wave_s); }
    asm volatile("s_waitcnt vmcnt(0)" ::: "memory"); __syncthreads();
    if (PH(10)) { pg8::Gemm g{XB, (const bf16*)(ws + WS_WPG), MROWS, DM, DM, DM}; pg8::StaticOrder S; S.init(MROWS, DM, G, bx);
        pg8::EpiPle E{YMIX, stat + ST_SS4 * MROWS, (bf16*)(ws + WS_E), stat + ST_SSE * MROWS}; pg8::gemm_phase<pg8::EpiPle, pg8::StaticOrder, true, true>(lds, g, S, E, wave_s); }
    xcd_barrier(xbar);
    if (PH(11)) { FRESH_IDS const bf16* E = (const bf16*)(ws + WS_E); const float* sse = stat + ST_SSE * MROWS; const int gw = bx * NWAVES + wave, NGW = G * NWAVES;
        for (int m = gw; m < MROWS; m += NGW) { const float r = pg8::rstd_of(sse[m], 1.0f / 2048.0f); GAS f32x4* xr = (GAS f32x4*)(out + (size_t)m * DM) + lane; const GAS v2u* xbr = (const GAS v2u*)(XB + (size_t)m * DM) + lane; const GAS v2u* er = (const GAS v2u*)(E + (size_t)m * DM) + lane;
            const GAS f32x4* gp = (const GAS f32x4*)in.ple_post + lane;
#pragma unroll
            for (int j = 0; j < 8; ++j) { const v2u xw = xbr[64 * j]; const v2u w = er[64 * j]; const f32x4 gg = gp[64 * j]; f32x4 v;
                v.x = pg8::bf_lo(xw.x) + pg8::bf_lo(w.x) * r * gg.x; v.y = pg8::bf_hi(xw.x) + pg8::bf_hi(w.x) * r * gg.y; v.z = pg8::bf_lo(xw.y) + pg8::bf_lo(w.y) * r * gg.z; v.w = pg8::bf_hi(xw.y) + pg8::bf_hi(w.y) * r * gg.w; xr[64 * j] = v; } } }
#undef PH
}

extern "C" void kernel_launch(void* const* d_in, const int* in_sizes, int n_in, void* d_out, int out_size, void* d_ws, size_t ws_size, hipStream_t stream) {
    static int grid = 0;
    if (grid == 0) {
        if (n_in != 31 || out_size != MROWS * DM || ws_size < WS_END) { fprintf(stderr, "kernel_launch: unexpected shapes (n_in %d, out %d, ws %zu)\n", n_in, out_size, ws_size); grid = -1; return; }
        int dev = 0, cus = 0, per_cu = 0;
        hipGetDevice(&dev); hipDeviceGetAttribute(&cus, hipDeviceAttributeMultiprocessorCount, dev);
        if (hipFuncSetAttribute((const void*)mk_fwd, hipFuncAttributeMaxDynamicSharedMemorySize, LDS_BYTES) != hipSuccess) { fprintf(stderr, "kernel_launch: hipFuncSetAttribute failed\n"); grid = -1; return; }
        if (hipOccupancyMaxActiveBlocksPerMultiprocessor(&per_cu, (const void*)mk_fwd, NTHREADS, LDS_BYTES) != hipSuccess || per_cu < 1) { fprintf(stderr, "kernel_launch: occupancy query gives %d\n", per_cu); per_cu = 1; }
        (void)hipGetLastError();
        grid = cus * 1;
    }
    if (grid < 0) return;
    Args a{};
    for (int i = 0; i < 31; ++i) a.in[i] = (const float*)d_in[i];
    a.out = (float*)d_out; a.ws = (unsigned char*)d_ws;
    void* kargs[] = {&a};
    hipError_t e = hipLaunchCooperativeKernel((const void*)mk_fwd, dim3(grid), dim3(NTHREADS), kargs, LDS_BYTES, stream);
    if (e != hipSuccess) fprintf(stderr, "kernel_launch: cooperative launch failed: %s (grid %d)\n", hipGetErrorString(e), grid);
}
```

```cpp
#include <hip/hip_runtime.h>
#include <hip/hip_cooperative_groups.h>
#include <cstdio>
#include <cstdint>
namespace cg = cooperative_groups;
namespace pg8 {
#define PG8_LAS __attribute__((address_space(3)))
typedef unsigned short bf16_t;
typedef short bf16x8 __attribute__((ext_vector_type(8)));
typedef float f32x4 __attribute__((ext_vector_type(4)));
typedef unsigned u32x4 __attribute__((ext_vector_type(4)));
constexpr int BM = 256, BK = 64, HALF = 128, HTB = HALF * BK * 2  , STAGE_BYTES = 8 * HTB, NXCD = 8, WGM = 8;

__host__ __device__ __forceinline__ int lds_byte(int r, int c) { const int st = (r >> 4) * 2 + (c >> 5), rr = r & 15, cc = c & 31, ob = rr * 64 + cc * 2; return st * 1024 + (ob ^ (((ob >> 9) & 1) << 5)); }
__host__ __device__ __forceinline__ void stage_rc(int b, int& R, int& C) { const int st = b / 1024, sb = b % 1024, swz = sb ^ (((sb >> 9) & 1) << 5); R = (st >> 1) * 16 + swz / 64; C = (st & 1) * 32 + (swz % 64) / 2; }
__host__ __device__ __forceinline__ int perm32(int rho) { const int n = rho >> 4, i = rho & 15; return 8 * (i >> 2) + 4 * n + (i & 3); }

struct Unit { int pm, pn, kh, par; };
struct Gemm { const bf16_t* A; const bf16_t* Bt; int M, N, K, KU; };

struct StaticOrder {
    int nM, nN, nwg, G, c;
    __host__ __device__ void init(int M, int N, int G_, int c_) { nM = M / BM; nN = N / BM; nwg = nM * nN; G = G_; c = c_; }
    __host__ __device__ bool next(int i, Unit& u) const {
        const long L = (long)i * G + c; if (L >= nwg) return false;
        int wgid = (int)L; { const int q = nwg / NXCD, r = nwg % NXCD, xcd = wgid % NXCD, off = wgid / NXCD; wgid = (xcd < r ? xcd * (q + 1) : r * (q + 1) + (xcd - r) * q) + off; }
        const int nig = WGM * nN, gid = wgid / nig, fm = gid * WGM, gsz = (nM - fm) < WGM ? (nM - fm) : WGM;
        u.pm = fm + ((wgid % nig) % gsz); u.pn = (wgid % nig) / gsz; u.kh = 0; return true;
    }
    __device__ __forceinline__ void a_ready(const Unit&) const {}
    __device__ __forceinline__ void done(const Unit&) const {}
};

__device__ __forceinline__ unsigned cvt_pk_bf16(float lo, float hi) { unsigned r; asm volatile("v_cvt_pk_bf16_f32 %0, %1, %2" : "=v"(r) : "v"(lo), "v"(hi)); return r; }
typedef int i32x4 __attribute__((ext_vector_type(4)));
typedef int i32x8 __attribute__((ext_vector_type(8)));
__device__ __forceinline__ i32x8 cat8(bf16x8 a, bf16x8 b) { return __builtin_shufflevector(__builtin_bit_cast(i32x4, a), __builtin_bit_cast(i32x4, b), 0, 1, 2, 3, 4, 5, 6, 7); }
__device__ __forceinline__ unsigned pack4_fp8(float a, float b, float c, float d) {
    a = __builtin_fminf(__builtin_fmaxf(a, -448.f), 448.f); b = __builtin_fminf(__builtin_fmaxf(b, -448.f), 448.f); c = __builtin_fminf(__builtin_fmaxf(c, -448.f), 448.f); d = __builtin_fminf(__builtin_fmaxf(d, -448.f), 448.f);
    int w = __builtin_amdgcn_cvt_pk_fp8_f32(a, b, 0, false); w = __builtin_amdgcn_cvt_pk_fp8_f32(c, d, w, true); return (unsigned)w; }
constexpr float F8_ACT_SCALE = 8.0f, F8_W_SCALE = 64.0f, F8_X_SCALE = 16.0f;
struct SplitOrder {
    StaticOrder base;
    __device__ bool next(int i, Unit& u) const { const bool r = base.next(i >> 1, u); u.kh = i & 1; return r; }
    __device__ __forceinline__ void a_ready(const Unit&) const {}
    __device__ __forceinline__ void done(const Unit&) const {}
};
typedef float f32x2 __attribute__((ext_vector_type(2)));
__device__ __forceinline__ float rstd_of(float ss, float inv_n) { return __builtin_amdgcn_rsqf(ss * inv_n + 1e-6f); }
__device__ __forceinline__ float sigmoid_f(float v) { return __builtin_amdgcn_rcpf(1.0f + __builtin_amdgcn_exp2f(-1.4426950408889634f * v)); }
__device__ __forceinline__ float bf_lo(unsigned w) { return __uint_as_float(w << 16); }
__device__ __forceinline__ float bf_hi(unsigned w) { return __uint_as_float(w & 0xffff0000u); }
__device__ __forceinline__ u32x4 pack8(const f32x4 a, const f32x4 b) { u32x4 w; w.x = cvt_pk_bf16(a[0], a[1]); w.y = cvt_pk_bf16(a[2], a[3]); w.z = cvt_pk_bf16(b[0], b[1]); w.w = cvt_pk_bf16(b[2], b[3]); return w; }
__device__ __forceinline__ float sumsq4(const f32x4 a) { return (a[0] * a[0] + a[1] * a[1]) + (a[2] * a[2] + a[3] * a[3]); }

template <bool F8OUT, bool OPQ = false> struct EpiSwiGLU {
    static constexpr bool PERM = true, AFTER_DRAIN = false, MID = false, PREF = true;
    bf16_t* O; const float* ss; int ldo; PG8_LAS float* sl; float ascale;
    __device__ __forceinline__ void prefetch(const Unit& u, int wid, int lane) const {
        if (wid < 4) __builtin_amdgcn_global_load_lds((const unsigned*)(ss + u.pm * BM + 64 * wid + lane), (PG8_LAS unsigned*)(sl + u.par * 256 + 64 * wid), 4, 0, 0);
    }
    __device__ __forceinline__ void operator()(f32x4 (&acc)[2][2][4][2], const Unit& u_, int wr, int wc, int fr, int fq) const {
        Unit u = u_; if constexpr (OPQ) { unsigned o1_ = ~0u; asm volatile("" : "+s"(u.pm), "+s"(u.pn), "+s"(o1_)); const int l_ = (int)__builtin_amdgcn_mbcnt_hi(o1_, __builtin_amdgcn_mbcnt_lo(o1_, 0u)); fr = l_ & 15; fq = l_ >> 4; }
        const int row0 = u.pm * BM + wr * 64 + fr, col0 = u.pn * HALF + wc * 32 + 8 * fq;
#pragma unroll
        for (int ai = 0; ai < 2; ++ai)
#pragma unroll
            for (int m = 0; m < 4; ++m) {
                const int row = row0 + ai * HALF + m * 16; const float r = rstd_of(sl[u.par * 256 + ai * HALF + wr * 64 + m * 16 + fr], 1.0f / 2048.0f) * ascale;
                f32x4 o[2];
#pragma unroll
                for (int n = 0; n < 2; ++n) { const f32x4 g = acc[ai][0][m][n] * r, uu = acc[ai][1][m][n] * r;
#pragma unroll
                    for (int e = 0; e < 4; ++e) o[n][e] = g[e] * uu[e] * sigmoid_f(g[e]); }
                if constexpr (F8OUT) {
                    typedef unsigned u32x2 __attribute__((ext_vector_type(2))); u32x2 w8; w8.x = pack4_fp8(o[0][0] * F8_ACT_SCALE, o[0][1] * F8_ACT_SCALE, o[0][2] * F8_ACT_SCALE, o[0][3] * F8_ACT_SCALE);
                    w8.y = pack4_fp8(o[1][0] * F8_ACT_SCALE, o[1][1] * F8_ACT_SCALE, o[1][2] * F8_ACT_SCALE, o[1][3] * F8_ACT_SCALE);
                    *(u32x2*)((unsigned char*)O + (((size_t)u.pm * (ldo / 128) + (col0 >> 7)) * BM + (ai * HALF + wr * 64 + m * 16 + fr)) * 128 + (col0 & 127)) = w8;
                } else
                *(u32x4*)(O + (((size_t)u.pm * (ldo / 64) + (col0 >> 6)) * BM + (ai * HALF + wr * 64 + m * 16 + fr)) * 64 + (col0 & 63)) = pack8(o[0], o[1]);
            }
    }
    __device__ __forceinline__ void mid(f32x4 (&)[2][2][4][2], const Unit&, int, int) const {}
};

template <int MODE, bool XF32, bool BATCH = true, bool OPQ = false> struct EpiResid {
    static constexpr bool PERM = true, AFTER_DRAIN = false, MID = (MODE == 1), PREF = false;
    const float* xin; bf16_t* xb; float* ssout; const float* ssa; const float* ssb; unsigned char* x8; float alpha;
    __device__ __forceinline__ void mid(f32x4 (&acc)[2][2][4][2], const Unit& u, int wr, int fr) const {
        {
            const int row0 = u.pm * BM + wr * 64 + fr;
#pragma unroll
            for (int ai = 0; ai < 2; ++ai)
#pragma unroll
                for (int m = 0; m < 4; ++m) { const int row = row0 + ai * HALF + m * 16;
                    const float ra = rstd_of(ssa[row], 1.0f / 1024.0f), rb = rstd_of(ssb[row], 1.0f / 1024.0f), ratio = ra * __builtin_amdgcn_rcpf(rb);
#pragma unroll
                    for (int bj = 0; bj < 2; ++bj)
#pragma unroll
                        for (int n = 0; n < 2; ++n) acc[ai][bj][m][n] = acc[ai][bj][m][n] * ratio;
                    asm volatile("" ::: "memory"); }
        }
    }
    __device__ __forceinline__ void operator()(f32x4 (&acc)[2][2][4][2], const Unit& u_, int wr, int wc, int fr, int fq) const {
        Unit u = u_; if constexpr (OPQ) { unsigned o1_ = ~0u; asm volatile("" : "+s"(u.pm), "+s"(u.pn), "+s"(o1_)); const int l_ = (int)__builtin_amdgcn_mbcnt_hi(o1_, __builtin_amdgcn_mbcnt_lo(o1_, 0u)); fr = l_ & 15; fq = l_ >> 4; }
        if (MODE == 1 && u.kh == 0) { mid(acc, u, wr, fr); return; }
        const int row0 = u.pm * BM + wr * 64 + fr, col0 = u.pn * BM + wc * 32 + 8 * fq;
        u32x4 xw[2][4][2]; f32x4 xf[XF32 ? 16 : 1][2];
#pragma unroll
        for (int ai = 0; ai < 2; ++ai)
#pragma unroll
            for (int m = 0; m < 4; ++m)
#pragma unroll
                for (int bj = 0; bj < 2; ++bj) { const size_t off = (size_t)(row0 + ai * HALF + m * 16) * 2048 + col0 + bj * HALF;
                    if constexpr (XF32) { xf[(ai * 4 + m) * 2 + bj][0] = *(const f32x4*)(xin + off); xf[(ai * 4 + m) * 2 + bj][1] = *(const f32x4*)(xin + off + 4); }
                    else if constexpr (BATCH) xw[ai][m][bj] = *(const u32x4*)(xb + off); }
#pragma unroll
        for (int ai = 0; ai < 2; ++ai)
#pragma unroll
            for (int m = 0; m < 4; ++m) {
                const int row = row0 + ai * HALF + m * 16; const size_t off = (size_t)row * 2048 + col0;
                float sc = alpha; if constexpr (MODE == 1) sc = rstd_of(ssb[row], 1.0f / 1024.0f);
                float q = 0.f;
#pragma unroll
                for (int bj = 0; bj < 2; ++bj) {
                    f32x4 x0, x1;
                    if constexpr (XF32) { x0 = xf[(ai * 4 + m) * 2 + bj][0]; x1 = xf[(ai * 4 + m) * 2 + bj][1]; }
                    else { const u32x4 w = BATCH ? xw[ai][m][bj] : *(const u32x4*)(xb + off + bj * HALF); x0 = (f32x4){bf_lo(w.x), bf_hi(w.x), bf_lo(w.y), bf_hi(w.y)}; x1 = (f32x4){bf_lo(w.z), bf_hi(w.z), bf_lo(w.w), bf_hi(w.w)}; }
                    const f32x4 v0 = x0 + acc[ai][bj][m][0] * sc, v1 = x1 + acc[ai][bj][m][1] * sc;
                    *(u32x4*)(xb + off + bj * HALF) = pack8(v0, v1);
                    if (x8) { typedef unsigned u32x2 __attribute__((ext_vector_type(2))); u32x2 w8; w8.x = pack4_fp8(v0[0] * F8_X_SCALE, v0[1] * F8_X_SCALE, v0[2] * F8_X_SCALE, v0[3] * F8_X_SCALE);
                        w8.y = pack4_fp8(v1[0] * F8_X_SCALE, v1[1] * F8_X_SCALE, v1[2] * F8_X_SCALE, v1[3] * F8_X_SCALE); *(u32x2*)(x8 + off + bj * HALF) = w8; }
                    q += sumsq4(v0) + sumsq4(v1);
                }
                q += __shfl_xor(q, 16); q += __shfl_xor(q, 32);
                if (fq == 0 && ssout) atomicAdd(ssout + row, q);
                if constexpr (!BATCH) { if (m == 3) asm volatile("" ::: "memory"); }
            }
    }
};

struct EpiWin {
    static constexpr bool PERM = true, AFTER_DRAIN = false, MID = false, PREF = false;
    const float* ss; bf16_t *UG, *Q, *K, *V; const float *gq, *gk; PG8_LAS float* xch;
    __device__ __forceinline__ void mid(f32x4 (&)[2][2][4][2], const Unit&, int, int) const {}
    __device__ __forceinline__ void operator()(f32x4 (&acc)[2][2][4][2], const Unit& u, int wr, int wc, int fr, int fq) const {
        const int row0 = u.pm * BM + wr * 64 + fr, seg = u.pn >> 2, lc0 = (u.pn & 3) * BM + wc * 32 + 8 * fq; const float* ssr = ss + row0;
        if (seg == 0) {
#pragma unroll
            for (int ai = 0; ai < 2; ++ai)
#pragma unroll
                for (int m = 0; m < 4; ++m) { const float r = rstd_of(ssr[ai * HALF + m * 16], 1.0f / 2048.0f); const int row = row0 + ai * HALF + m * 16, b = row >> 12, t = row & 4095;
#pragma unroll
                    for (int bj = 0; bj < 2; ++bj) { const int col = lc0 + bj * HALF, g = col >> 4, half = (col >> 3) & 1;
                        *(u32x4*)(UG + ((size_t)((b * 64 + g) * 4096 + t) * 16 + 8 * half)) = pack8(acc[ai][bj][m][0] * r, acc[ai][bj][m][1] * r); } }
        } else if (seg == 3) {
#pragma unroll
            for (int ai = 0; ai < 2; ++ai)
#pragma unroll
                for (int m = 0; m < 4; ++m) { const float r = rstd_of(ssr[ai * HALF + m * 16], 1.0f / 2048.0f); const int row = row0 + ai * HALF + m * 16;
#pragma unroll
                    for (int bj = 0; bj < 2; ++bj) *(u32x4*)(V + (size_t)row * 1024 + lc0 + bj * HALF) = pack8(acc[ai][bj][m][0] * r, acc[ai][bj][m][1] * r); }
        } else {
#pragma unroll
            for (int ai = 0; ai < 2; ++ai)
#pragma unroll
                for (int m = 0; m < 4; ++m) { const int rl = ai * HALF + wr * 64 + m * 16 + fr;
#pragma unroll
                    for (int bj = 0; bj < 2; ++bj) { float q = sumsq4(acc[ai][bj][m][0]) + sumsq4(acc[ai][bj][m][1]); q += __shfl_xor(q, 16); q += __shfl_xor(q, 32);
                        if (fq == 0) xch[rl * 8 + bj * 4 + wc] = q; } }
            asm volatile("s_waitcnt lgkmcnt(0)" ::: "memory"); __builtin_amdgcn_s_barrier(); asm volatile("" ::: "memory");
            const float* gain = (seg == 1) ? gq : gk; bf16_t* dst = (seg == 1) ? Q : K;
            const float osc = (seg == 1) ? (0.08838834764831845f * 1.4426950408889634f) : 1.0f;
            const int d0 = wc * 32 + 8 * fq;
            const f32x4 g0 = *(const f32x4*)(gain + d0) * osc, g1 = *(const f32x4*)(gain + d0 + 4) * osc;
#pragma unroll
            for (int ai = 0; ai < 2; ++ai)
#pragma unroll
                for (int m = 0; m < 4; ++m) { const int rl = ai * HALF + wr * 64 + m * 16 + fr, row = u.pm * BM + rl;
                    const float epr = 1e-6f * (ssr[ai * HALF + m * 16] * (1.0f / 2048.0f) + 1e-6f);
#pragma unroll
                    for (int bj = 0; bj < 2; ++bj) { const f32x4 p = *(const PG8_LAS f32x4*)(xch + rl * 8 + bj * 4);
                        const float rq = __builtin_amdgcn_rsqf(((p[0] + p[1]) + (p[2] + p[3])) * (1.0f / 128.0f) + epr);
                        *(u32x4*)(dst + (size_t)row * 1024 + lc0 + bj * HALF) = pack8(acc[ai][bj][m][0] * g0 * rq, acc[ai][bj][m][1] * g1 * rq); } }
        }
    }
};

struct EpiGlu {
    static constexpr bool PERM = true, AFTER_DRAIN = false, MID = false, PREF = false;
    const bf16_t* Z; const float* bias; bf16_t* Y; float* ssout;
    __device__ __forceinline__ void mid(f32x4 (&)[2][2][4][2], const Unit&, int, int) const {}
    __device__ __forceinline__ void operator()(f32x4 (&acc)[2][2][4][2], const Unit& u, int wr, int wc, int fr, int fq) const {
        const int row0 = u.pm * BM + wr * 64 + fr, col0 = u.pn * BM + wc * 32 + 8 * fq;
        f32x4 bv[2][2];
#pragma unroll
        for (int bj = 0; bj < 2; ++bj)
#pragma unroll
            for (int n = 0; n < 2; ++n) bv[bj][n] = *(const f32x4*)(bias + col0 + bj * HALF + 4 * n);
        u32x4 zw[2][4][2];
#pragma unroll
        for (int ai = 0; ai < 2; ++ai)
#pragma unroll
            for (int m = 0; m < 4; ++m)
#pragma unroll
                for (int bj = 0; bj < 2; ++bj) zw[ai][m][bj] = *(const u32x4*)(Z + (size_t)(row0 + ai * HALF + m * 16) * 1024 + col0 + bj * HALF);
#pragma unroll
        for (int ai = 0; ai < 2; ++ai)
#pragma unroll
            for (int m = 0; m < 4; ++m) { const int row = row0 + ai * HALF + m * 16; float q = 0.f;
#pragma unroll
                for (int bj = 0; bj < 2; ++bj) { const u32x4 zb = zw[ai][m][bj];
                    const f32x4 z0 = {bf_lo(zb.x), bf_hi(zb.x), bf_lo(zb.y), bf_hi(zb.y)}, z1 = {bf_lo(zb.z), bf_hi(zb.z), bf_lo(zb.w), bf_hi(zb.w)};
                    const f32x4 a0 = acc[ai][bj][m][0] + bv[bj][0], a1 = acc[ai][bj][m][1] + bv[bj][1]; f32x4 y0, y1;
#pragma unroll
                    for (int e = 0; e < 4; ++e) { y0[e] = z0[e] * sigmoid_f(a0[e]); y1[e] = z1[e] * sigmoid_f(a1[e]); }
                    *(u32x4*)(Y + (size_t)row * 2048 + col0 + bj * HALF) = pack8(y0, y1); q += sumsq4(y0) + sumsq4(y1); }
                q += __shfl_xor(q, 16); q += __shfl_xor(q, 32);
                if (fq == 0) atomicAdd(ssout + row, q); }
    }
};

struct EpiPle {
    static constexpr bool PERM = true, AFTER_DRAIN = false, MID = false, PREF = false;
    const bf16_t* PP; const float* ss; bf16_t* E; float* ssout;
    __device__ __forceinline__ void mid(f32x4 (&)[2][2][4][2], const Unit&, int, int) const {}
    __device__ __forceinline__ void operator()(f32x4 (&acc)[2][2][4][2], const Unit& u, int wr, int wc, int fr, int fq) const {
        const int row0 = u.pm * BM + wr * 64 + fr, col0 = u.pn * BM + wc * 32 + 8 * fq;
        u32x4 pw[2][4][2];
#pragma unroll
        for (int ai = 0; ai < 2; ++ai)
#pragma unroll
            for (int m = 0; m < 4; ++m)
#pragma unroll
                for (int bj = 0; bj < 2; ++bj) pw[ai][m][bj] = *(const u32x4*)(PP + (size_t)(row0 + ai * HALF + m * 16) * 2048 + col0 + bj * HALF);
#pragma unroll
        for (int ai = 0; ai < 2; ++ai)
#pragma unroll
            for (int m = 0; m < 4; ++m) { const int row = row0 + ai * HALF + m * 16; const float r = rstd_of(ss[row], 1.0f / 2048.0f); float q = 0.f;
#pragma unroll
                for (int bj = 0; bj < 2; ++bj) { const u32x4 pb = pw[ai][m][bj];
                    const f32x4 p0 = {bf_lo(pb.x), bf_hi(pb.x), bf_lo(pb.y), bf_hi(pb.y)}, p1 = {bf_lo(pb.z), bf_hi(pb.z), bf_lo(pb.w), bf_hi(pb.w)};
                    const f32x4 a0 = acc[ai][bj][m][0] * r, a1 = acc[ai][bj][m][1] * r; f32x4 y0, y1;
#pragma unroll
                    for (int e = 0; e < 4; ++e) { y0[e] = p0[e] * sigmoid_f(a0[e]); y1[e] = p1[e] * sigmoid_f(a1[e]); }
                    *(u32x4*)(E + (size_t)row * 2048 + col0 + bj * HALF) = pack8(y0, y1); q += sumsq4(y0) + sumsq4(y1); }
                q += __shfl_xor(q, 16); q += __shfl_xor(q, 32);
                if (fq == 0) atomicAdd(ssout + row, q); }
    }
};

struct EpiPlain {
    static constexpr bool PERM = true, AFTER_DRAIN = false, MID = false, PREF = false;
    bf16_t* O; int ldo;
    __device__ __forceinline__ void mid(f32x4 (&)[2][2][4][2], const Unit&, int, int) const {}
    __device__ __forceinline__ void operator()(f32x4 (&acc)[2][2][4][2], const Unit& u, int wr, int wc, int fr, int fq) const {
        const int row0 = u.pm * BM + wr * 64 + fr, col0 = u.pn * BM + wc * 32 + 8 * fq;
#pragma unroll
        for (int ai = 0; ai < 2; ++ai)
#pragma unroll
            for (int m = 0; m < 4; ++m) { const int row = row0 + ai * HALF + m * 16;
#pragma unroll
                for (int bj = 0; bj < 2; ++bj) *(u32x4*)(O + (size_t)row * ldo + col0 + bj * HALF) = pack8(acc[ai][bj][m][0], acc[ai][bj][m][1]); }
    }
};
template <class Epi, class Sched, bool ALIGN_EPI = false, bool SP2 = false, bool ABLK = false, bool F8 = false>
__device__ __forceinline__ void gemm_phase(PG8_LAS unsigned char* lds, const Gemm g, const Sched& S, const Epi& E, const int wave_s) {
    unsigned ones_ = ~0u; asm volatile("" : "+s"(ones_));
    const int lane = (int)__builtin_amdgcn_mbcnt_hi(ones_, __builtin_amdgcn_mbcnt_lo(ones_, 0u)), wid = wave_s, tid = wid * 64 + lane, wr = wid >> 2, wc = wid & 3, fr = lane & 15, fq = lane >> 4;
    const int K = g.K, nt = g.KU / BK;
    unsigned voffA[2], voffB[2];
#pragma unroll
    for (int i = 0; i < 2; ++i) { int R, C; stage_rc(tid * 16 + i * 8192, R, C); const int Rb = Epi::PERM ? ((R & ~31) + perm32(R & 31)) : R;
        voffA[i] = ABLK ? (unsigned)(R * BK + C) * 2u : (unsigned)(R * K + C) * 2u; voffB[i] = (unsigned)(Rb * K + C) * 2u; }
    const size_t kstep = (size_t)(BK * 2);
    const size_t hstep = (size_t)HALF * K * 2;
    const size_t tstep = 2 * hstep;
    const size_t kstepA = ABLK ? (size_t)(BM * BK * 2) : kstep, hstepA = ABLK ? (size_t)(HALF * BK * 2) : hstep;
    const unsigned ldsw = (unsigned)wid * 1024u;
    const int aoff = lds_byte(wr * 64 + fr, fq * 8), boff = lds_byte(wc * 32 + fr, fq * 8);
#define PG8_SA(b, h) (((b) * 2 + (h)) * HTB)
#define PG8_SB(b, h) ((4 + (b) * 2 + (h)) * HTB)
#define PG8_STAGE(bufoff, gbase, voff) do { _Pragma("unroll") for (int _i = 0; _i < 2; ++_i) \
        { unsigned _vo = (voff)[_i]; asm volatile("" : "+v"(_vo));     \
        __builtin_amdgcn_global_load_lds((const unsigned*)((const char*)(gbase) + _vo), (PG8_LAS unsigned*)(lds + (bufoff) + ldsw + _i * 8192), 16, 0, 0); } } while (0)
#define PG8_LDA(dst, b, h) do { _Pragma("unroll") for (int m = 0; m < 4; ++m) _Pragma("unroll") for (int k = 0; k < 2; ++k) dst[m][k] = *(const PG8_LAS bf16x8*)(lds + PG8_SA(b, h) + aoff + m * 2048 + k * 1024); } while (0)
#define PG8_LDB(dst, b, h) do { _Pragma("unroll") for (int n = 0; n < 2; ++n) _Pragma("unroll") for (int k = 0; k < 2; ++k) dst[n][k] = *(const PG8_LAS bf16x8*)(lds + PG8_SB(b, h) + boff + n * 2048 + k * 1024); } while (0)
#define PG8_MMA(ai, bj, At, Bt) do { __builtin_amdgcn_s_setprio(1); if constexpr (F8) { _Pragma("unroll") for (int m = 0; m < 4; ++m) _Pragma("unroll") for (int n = 0; n < 2; ++n) \
        acc[ai][bj][m][n] = __builtin_amdgcn_mfma_scale_f32_16x16x128_f8f6f4(cat8(Bt[n][0], Bt[n][1]), cat8(At[m][0], At[m][1]), acc[ai][bj][m][n], 0, 0, 0, 0x7F7F7F7F, 0, 0x7F7F7F7F); } \
    else { _Pragma("unroll") for (int m = 0; m < 4; ++m) _Pragma("unroll") for (int n = 0; n < 2; ++n) _Pragma("unroll") for (int k = 0; k < 2; ++k) \
        acc[ai][bj][m][n] = __builtin_amdgcn_mfma_f32_16x16x32_bf16(Bt[n][k], At[m][k], acc[ai][bj][m][n], 0, 0, 0); } __builtin_amdgcn_s_setprio(0); } while (0)
#define PG8_WAIT_V(n) asm volatile("s_waitcnt vmcnt(" #n ")" ::: "memory")
#define PG8_WAIT_L(n) asm volatile("s_waitcnt lgkmcnt(" #n ")" ::: "memory")
#define PG8_BAR __builtin_amdgcn_s_barrier()
#define PG8_SCHED __builtin_amdgcn_sched_barrier(0)
    Unit cur, nxt; int ui = 0;
    if (!S.next(0, cur)) return;
    cur.par = 0;
    if constexpr (Epi::PREF) E.prefetch(cur, wid, lane);
    f32x4 acc[2][2][4][2];
#pragma unroll
    for (int a = 0; a < 2; ++a)
#pragma unroll
        for (int b = 0; b < 2; ++b)
#pragma unroll
            for (int m = 0; m < 4; ++m)
#pragma unroll
                for (int n = 0; n < 2; ++n) acc[a][b][m][n] = (f32x4){0.f, 0.f, 0.f, 0.f};
    bf16x8 At[4][2], B0[2][2], B1[2][2];
    const size_t khb = (size_t)g.KU * 2, khbA = ABLK ? (size_t)(g.KU / BK) * kstepA : khb; const char* cA = (const char*)g.A + (size_t)cur.pm * tstep + cur.kh * khbA; const char* cB = (const char*)g.Bt + (size_t)cur.pn * tstep + cur.kh * khb;
    S.a_ready(cur);
    if constexpr (SP2) {
        PG8_STAGE(PG8_SB(0, 0), cB, voffB); PG8_STAGE(PG8_SB(0, 1), cB + hstep, voffB); PG8_STAGE(PG8_SA(0, 0), cA, voffA); PG8_STAGE(PG8_SA(0, 1), cA + hstepA, voffA);
        if (wr == 1) PG8_BAR;
        PG8_WAIT_V(2); PG8_BAR;
        PG8_STAGE(PG8_SB(1, 0), cB + kstep, voffB); PG8_STAGE(PG8_SA(1, 0), cA + kstepA, voffA); PG8_STAGE(PG8_SB(1, 1), cB + hstep + kstep, voffB);
        PG8_WAIT_V(6); PG8_BAR;
    } else {
        PG8_STAGE(PG8_SB(0, 0), cB, voffB); PG8_STAGE(PG8_SA(0, 0), cA, voffA); PG8_STAGE(PG8_SB(0, 1), cB + hstep, voffB); PG8_STAGE(PG8_SA(0, 1), cA + hstepA, voffA);
        if (wr == 1) PG8_BAR;
        PG8_WAIT_V(4); PG8_BAR;
        PG8_STAGE(PG8_SB(1, 0), cB + kstep, voffB); PG8_STAGE(PG8_SA(1, 0), cA + kstepA, voffA); PG8_STAGE(PG8_SB(1, 1), cB + hstep + kstep, voffB);
        PG8_WAIT_V(6); PG8_BAR;
    }
    for (;;) {
        const bool has_next = S.next(ui + 1, nxt); nxt.par = (ui + 1) & 1;
        const char* nA = has_next ? (const char*)g.A + (size_t)nxt.pm * tstep + nxt.kh * khbA : cA; const char* nB = has_next ? (const char*)g.Bt + (size_t)nxt.pn * tstep + nxt.kh * khb : cB;
        for (int t = 0; t < nt; t += 2) {
            const bool last = (t == nt - 2);
            const char* a1 = cA + (size_t)(t + 1) * kstepA;
            const char* a2 = last ? nA : cA + (size_t)(t + 2) * kstepA; const char* b2 = last ? nB : cB + (size_t)(t + 2) * kstep;
            const char* a3 = a2 + kstepA; const char* b3 = b2 + kstep;
            if (last && has_next) { S.a_ready(nxt); if constexpr (Epi::PREF) E.prefetch(nxt, wid, lane); }
            if constexpr (SP2) {
            PG8_LDB(B0, 0, 0); PG8_LDB(B1, 0, 1); PG8_SCHED; PG8_LDA(At, 0, 0); PG8_STAGE(PG8_SA(1, 1), a1 + hstepA, voffA);
            PG8_WAIT_V(8); PG8_WAIT_L(0); PG8_BAR; PG8_MMA(0, 0, At, B0); PG8_MMA(0, 1, At, B1); PG8_BAR; PG8_SCHED;
            PG8_LDA(At, 0, 1); PG8_STAGE(PG8_SB(0, 0), b2, voffB); PG8_STAGE(PG8_SB(0, 1), b2 + hstep, voffB); PG8_STAGE(PG8_SA(0, 0), a2, voffA);
            PG8_WAIT_V(8); PG8_WAIT_L(0); PG8_BAR; PG8_MMA(1, 0, At, B0); PG8_MMA(1, 1, At, B1); PG8_BAR; PG8_SCHED;
            PG8_LDB(B0, 1, 0); PG8_LDB(B1, 1, 1); PG8_SCHED; PG8_LDA(At, 1, 0); PG8_STAGE(PG8_SA(0, 1), a2 + hstepA, voffA);
            PG8_WAIT_V(8); PG8_WAIT_L(0); PG8_BAR; PG8_MMA(0, 0, At, B0); PG8_MMA(0, 1, At, B1); PG8_BAR; PG8_SCHED;
            PG8_LDA(At, 1, 1); PG8_STAGE(PG8_SB(1, 0), b3, voffB); PG8_STAGE(PG8_SB(1, 1), b3 + hstep, voffB); PG8_STAGE(PG8_SA(1, 0), a3, voffA);
            PG8_WAIT_V(8); PG8_WAIT_L(0); PG8_BAR; PG8_MMA(1, 0, At, B0); PG8_MMA(1, 1, At, B1); PG8_BAR; PG8_SCHED;
            } else {
            PG8_LDB(B0, 0, 0); PG8_SCHED; PG8_LDA(At, 0, 0); PG8_STAGE(PG8_SA(1, 1), a1 + hstepA, voffA);
            PG8_WAIT_L(8); PG8_BAR; PG8_WAIT_L(0); PG8_MMA(0, 0, At, B0); PG8_BAR; PG8_SCHED;
            PG8_LDB(B1, 0, 1); PG8_STAGE(PG8_SB(0, 0), b2, voffB);
            PG8_BAR; PG8_WAIT_L(0); PG8_MMA(0, 1, At, B1); PG8_BAR;
            PG8_LDA(At, 0, 1); PG8_STAGE(PG8_SA(0, 0), a2, voffA);
            PG8_BAR; PG8_WAIT_L(0); PG8_MMA(1, 0, At, B0); PG8_BAR; PG8_SCHED;
            PG8_STAGE(PG8_SB(0, 1), b2 + hstep, voffB);
            PG8_WAIT_V(6); PG8_BAR; PG8_MMA(1, 1, At, B1); PG8_BAR;
            PG8_LDB(B0, 1, 0); PG8_SCHED; PG8_LDA(At, 1, 0); PG8_STAGE(PG8_SA(0, 1), a2 + hstepA, voffA);
            PG8_WAIT_L(8); PG8_BAR; PG8_WAIT_L(0); PG8_MMA(0, 0, At, B0); PG8_BAR; PG8_SCHED;
            PG8_LDB(B1, 1, 1); PG8_STAGE(PG8_SB(1, 0), b3, voffB);
            PG8_BAR; PG8_WAIT_L(0); PG8_MMA(0, 1, At, B1); PG8_BAR;
            PG8_LDA(At, 1, 1); PG8_STAGE(PG8_SA(1, 0), a3, voffA);
            PG8_BAR; PG8_WAIT_L(0); PG8_MMA(1, 0, At, B0); PG8_BAR; PG8_SCHED;
            PG8_STAGE(PG8_SB(1, 1), b3 + hstep, voffB);
            PG8_WAIT_V(6); PG8_BAR; PG8_MMA(1, 1, At, B1); PG8_BAR;
            }
        }
        if constexpr (ALIGN_EPI) { if (wr == 0) PG8_BAR; }
        if constexpr (!Epi::AFTER_DRAIN) { E(acc, cur, wr, wc, fr, fq); S.done(cur); }
        if (!has_next) break;
        if (!(Epi::MID && cur.kh == 0))
#pragma unroll
        for (int a = 0; a < 2; ++a)
#pragma unroll
            for (int b = 0; b < 2; ++b)
#pragma unroll
                for (int m = 0; m < 4; ++m)
#pragma unroll
                    for (int n = 0; n < 2; ++n) acc[a][b][m][n] = (f32x4){0.f, 0.f, 0.f, 0.f};
        cur = nxt; cA = nA; cB = nB; ++ui;
        if constexpr (ALIGN_EPI) { if (wr == 1) PG8_BAR; }
    }
    PG8_WAIT_V(0);
    if constexpr (!ALIGN_EPI) { if (wr == 0) PG8_BAR; }
    PG8_BAR;
    if constexpr (Epi::AFTER_DRAIN) { E.fused(acc, cur, wr, wc, fr, fq, lds, wid, lane); S.done(cur); }
#undef PG8_SA
#undef PG8_SB
#undef PG8_STAGE
#undef PG8_LDA
#undef PG8_LDB
#undef PG8_MMA
#undef PG8_WAIT_V
#undef PG8_WAIT_L
#undef PG8_BAR
#undef PG8_SCHED
}
}
constexpr int NWAVES = 8, NTHREADS = 512;
constexpr int DM = 2048, NB = 8, SEQ = 4096, MROWS = NB * SEQ, FF = 5632, PLE = 256;
constexpr int SSMW = 1024, NG = 64, GH = 16, NP = 64, SBW = 1024, NHEAD = 8, HD = 128, NIN = 4096;
constexpr size_t MiB = 1u << 20;
constexpr size_t WS_STAT = 0;
constexpr size_t WS_BAR = 960 * 1024;
constexpr int BAR_WORDS = 3456;
constexpr size_t WS_LAM8 = 1 * MiB;
constexpr size_t WS_SSMMAT = 2 * MiB;
constexpr size_t WS_WGU1 = 8 * MiB, WS_WD1 = 52 * MiB, WS_WIN = 74 * MiB, WS_WGLU = 90 * MiB, WS_WOUT = 92 * MiB, WS_WGU2 = 100 * MiB, WS_WD2 = 144 * MiB, WS_WPG = 166 * MiB, WS_WPP = 174 * MiB;
constexpr size_t WS_PB = 176 * MiB;
constexpr size_t WS_XB = 192 * MiB;
constexpr size_t WS_YMIX = 320 * MiB;
constexpr size_t WS_ACT = 448 * MiB;
constexpr size_t WS_UG = WS_ACT, WS_Q = WS_ACT + 64 * MiB, WS_K = WS_ACT + 128 * MiB, WS_V = WS_ACT + 192 * MiB, WS_Z = WS_ACT + 256 * MiB, WS_E = WS_ACT;
constexpr size_t WS_XB8 = 832 * MiB;
constexpr size_t WS_END = 896 * MiB;
enum { ST_SS1 = 0, ST_SS2, ST_SSM, ST_SB, ST_SS3, ST_SS4, ST_SSE, ST_N };
constexpr int RING_BYTES = 131072, XCH_OFF = RING_BYTES, LDS_BYTES = 147456;

#define GAS __attribute__((address_space(1)))
#define LAS __attribute__((address_space(3)))
typedef unsigned short bf16;
typedef unsigned v4u __attribute__((ext_vector_type(4)));
typedef unsigned v2u __attribute__((ext_vector_type(2)));
typedef float f32x4 __attribute__((ext_vector_type(4)));
typedef short bf16x8 __attribute__((ext_vector_type(8)));
#define LDS_WAIT() asm volatile("s_waitcnt lgkmcnt(0)" ::: "memory")
using pg8::cvt_pk_bf16;
__device__ __forceinline__ float wave_sum(float v) {
#pragma unroll
    for (int o = 1; o < 64; o <<= 1) v += __shfl_xor(v, o);
    return v;
}
__device__ __forceinline__ f32x4 mfma16(bf16x8 a, bf16x8 b, f32x4 c) { return __builtin_amdgcn_mfma_f32_16x16x32_bf16(a, b, c, 0, 0, 0); }

#ifndef MK_DUP
#define MK_DUP 0u
#endif
constexpr int P0_REP = 1 + (int)(MK_DUP & 1u), P4_REP = 1 + (int)((MK_DUP >> 4) & 1u);
__device__ __forceinline__ void tr_item(const float* W, int K, int N, const float* gain, bf16* WT, int k0, int n0, int dstrow, LAS float* scr, int lane, float f8s) {
    const int c4 = lane & 15, r0 = lane >> 4;
#pragma unroll 4
    for (int i = 0; i < 16; ++i) { const int kk = 4 * i + r0; f32x4 v = *(const GAS f32x4*)(W + (size_t)(k0 + kk) * N + n0 + 4 * c4); if (gain) v = v * gain[k0 + kk];
        *(LAS f32x4*)(scr + kk * 64 + 4 * (c4 ^ (2 * ((kk >> 3) & 7)))) = v; }
    LDS_WAIT(); asm volatile("" ::: "memory");
    const int c = lane & 7;
#pragma unroll
    for (int ps = 0; ps < 2; ++ps) { const int ng = (lane >> 3) + 8 * ps; f32x4 v[8];
#pragma unroll
        for (int j = 0; j < 8; ++j) v[j] = *(const LAS f32x4*)(scr + (8 * c + j) * 64 + 4 * (ng ^ (2 * c)));
#pragma unroll
        for (int i = 0; i < 4; ++i) {
            if (f8s != 0.f) { v2u o8; o8.x = pg8::pack4_fp8(v[0][i] * f8s, v[1][i] * f8s, v[2][i] * f8s, v[3][i] * f8s); o8.y = pg8::pack4_fp8(v[4][i] * f8s, v[5][i] * f8s, v[6][i] * f8s, v[7][i] * f8s);
                *(GAS v2u*)((GAS unsigned char*)WT + (size_t)(dstrow + 4 * ng + i) * K + k0 + 8 * c) = o8; continue; }
            v4u o; o.x = cvt_pk_bf16(v[0][i], v[1][i]); o.y = cvt_pk_bf16(v[2][i], v[3][i]); o.z = cvt_pk_bf16(v[4][i], v[5][i]); o.w = cvt_pk_bf16(v[6][i], v[7][i]);
            *(GAS v4u*)(WT + (size_t)(dstrow + 4 * ng + i) * K + k0 + 8 * c) = o; } }
    LDS_WAIT(); asm volatile("" ::: "memory");
}

struct In {
    const float *x, *p, *ffn1_norm, *ffn1_wg, *ffn1_wu, *ffn1_wd, *mix_norm, *w_in, *lam_re, *lam_im, *b_re, *b_im, *c_re, *c_im, *log_dt, *ssm_d, *w_glu, *b_glu, *q_norm, *k_norm,
        *on_ssm, *on_sb, *w_out, *ffn2_norm, *ffn2_wg, *ffn2_wu, *ffn2_wd, *ple_norm, *w_pg, *w_pp, *ple_post;
};

__device__ __forceinline__ void ssm_build(const In& in, unsigned char* ws, LAS unsigned char* lds, int g, int tid) {
    LAS float* PW = (LAS float*)lds;
    LAS float* CO = PW + 9 * 64 * 2;
    LAS float* CB = CO + 64 * 2;
    LAS float* KT = CB + 64 * 16 * 2;
    LAS float* CR = KT + 2048; LAS float* CI = CR + 1024;
    for (int i = tid; i < 1024; i += NTHREADS) { CR[i] = in.c_re[g * 1024 + i]; CI[i] = in.c_im[g * 1024 + i]; }
    if (tid < 64) {
        const int p = tid; const float dt = expf(in.log_dt[g]); const float lr = fminf(in.lam_re[g * 64 + p], -1e-4f), li = in.lam_im[g * 64 + p];
        const float a = lr * dt, th = li * dt; float s1, c1; sincosf(th, &s1, &c1); const float ea = expf(a);
        const float l1r = ea * c1, l1i = ea * s1;
        float pr = 1.f, pi = 0.f;
#pragma unroll
        for (int t = 0; t <= 8; ++t) { PW[(t * 64 + p) * 2] = pr; PW[(t * 64 + p) * 2 + 1] = pi; const float nr = pr * l1r - pi * l1i, ni = pr * l1i + pi * l1r; pr = nr; pi = ni; }
        float* l8 = (float*)(ws + WS_LAM8) + (g * 64 + p) * 2; l8[0] = PW[(8 * 64 + p) * 2]; l8[1] = PW[(8 * 64 + p) * 2 + 1];
        const float sh = sinf(0.5f * th); const float nr = expm1f(a) * c1 - 2.f * sh * sh, ni = l1i;
        const float den = 1.f / (lr * lr + li * li);
        CO[p * 2] = (nr * lr + ni * li) * den; CO[p * 2 + 1] = (ni * lr - nr * li) * den;
    }
    __syncthreads();
    for (int i = tid; i < 1024; i += NTHREADS) { const int p = i >> 4; const float br = in.b_re[g * 1024 + i], bi = in.b_im[g * 1024 + i], cr = CO[p * 2], ci = CO[p * 2 + 1];
        CB[i * 2] = cr * br - ci * bi; CB[i * 2 + 1] = cr * bi + ci * br; }
    __syncthreads();
    for (int i = tid; i < 2048; i += NTHREADS) { const int tau = i >> 8, h = (i >> 4) & 15, h2 = i & 15; float s = 0.f;
        for (int p = 0; p < 64; ++p) { const float cr = CR[h * 64 + p], ci = CI[h * 64 + p], pr = PW[(tau * 64 + p) * 2], pi = PW[(tau * 64 + p) * 2 + 1];
            const float wr = cr * pr - ci * pi, wi = cr * pi + ci * pr; s += wr * CB[(p * 16 + h2) * 2] - wi * CB[(p * 16 + h2) * 2 + 1]; }
        KT[i] = s; }
    __syncthreads();
    bf16* Ms = (bf16*)(ws + WS_SSMMAT) + (size_t)g * 3 * 16384; bf16* Mi = Ms + 16384; bf16* Mo = Mi + 16384;
    for (int i = tid; i < 16384; i += NTHREADS) { const int r = i >> 7, c = i & 127;
        { const int p = r & 63, s = c >> 4, h2 = c & 15; const float pr = PW[((7 - s) * 64 + p) * 2], pi = PW[((7 - s) * 64 + p) * 2 + 1], br = CB[(p * 16 + h2) * 2], bi = CB[(p * 16 + h2) * 2 + 1];
          const float v = (r < 64) ? (pr * br - pi * bi) : (pr * bi + pi * br); Ms[i] = (bf16)(cvt_pk_bf16(v, 0.f) & 0xffffu); }
        { const int t = r >> 4, h = r & 15, s = c >> 4, h2 = c & 15; float v = 0.f; if (s <= t) { v = KT[((t - s) * 16 + h) * 16 + h2]; if (r == c) v += in.ssm_d[g * 16 + h]; } Mi[i] = (bf16)(cvt_pk_bf16(v, 0.f) & 0xffffu); }
        { const int t = r >> 4, h = r & 15, p = c & 63; const float cr = CR[h * 64 + p], ci = CI[h * 64 + p], pr = PW[((t + 1) * 64 + p) * 2], pi = PW[((t + 1) * 64 + p) * 2 + 1];
          const float v = (c < 64) ? (cr * pr - ci * pi) : -(cr * pi + ci * pr); Mo[i] = (bf16)(cvt_pk_bf16(v, 0.f) & 0xffffu); }
    }
    __syncthreads();
}

__device__ __forceinline__ void p0_prologue(const In& in, float* out, unsigned char* ws, LAS unsigned char* lds, int tid, int lane, int wave) {
    const int G = gridDim.x, bx = blockIdx.x;
    if (bx == 0) { unsigned* bw = (unsigned*)(ws + WS_BAR); for (int i = tid; i < BAR_WORDS; i += NTHREADS) bw[i] = 0u; }
    for (int g = bx; g < NG; g += G) ssm_build(in, ws, lds, g, tid);
    { float* st = (float*)(ws + WS_STAT) + MROWS; for (int i = bx * NTHREADS + tid; i < (ST_N - 1) * MROWS; i += G * NTHREADS) st[i] = 0.f; }
    LAS float* scr = (LAS float*)(lds + wave * 16384);
    const int gw = bx * NWAVES + wave, NGW = G * NWAVES;
    constexpr int I_GU = (DM / 64) * (FF / 64), I_D = (FF / 64) * (DM / 64), I_IN = (DM / 64) * (NIN / 64), I_GLU = (SSMW / 64) * (SSMW / 64), I_SQ = (DM / 64) * (DM / 64), I_PP = (PLE / 64) * (DM / 64);
    constexpr int NITEMS = 4 * I_GU + 2 * I_D + I_IN + I_GLU + 2 * I_SQ + I_PP;
#define TR_ITEM(NI, Wp, Kd, Nd, gainp, dstoff, MODE, F8S) \
        if (r < (NI)) { const int nbk = (Nd) / 64, kb = r / nbk, nb = r % nbk, k0 = 64 * kb, n0 = 64 * nb; \
            const int dr = (MODE) == 0 ? n0 : (n0 / 128) * 256 + (n0 % 128) + ((MODE) == 2 ? 128 : 0); \
            tr_item((Wp), (Kd), (Nd), (gainp), (bf16*)(ws + (dstoff)), k0, n0, dr, scr, lane, (F8S)); continue; } r -= (NI);
    for (int it = gw; it < NITEMS * P0_REP; it += NGW) {
        int r = it % NITEMS;
        TR_ITEM(I_GU, in.ffn1_wg, DM, FF, in.ffn1_norm, WS_WGU1, 1, 0.f)
        TR_ITEM(I_GU, in.ffn1_wu, DM, FF, in.ffn1_norm, WS_WGU1, 2, 0.f)
        TR_ITEM(I_D, in.ffn1_wd, FF, DM, (const float*)nullptr, WS_WD1, 0, 0.f)
        TR_ITEM(I_IN, in.w_in, DM, NIN, in.mix_norm, WS_WIN, 0, 0.f)
        TR_ITEM(I_GLU, in.w_glu, SSMW, SSMW, (const float*)nullptr, WS_WGLU, 0, 0.f)
        TR_ITEM(I_SQ, in.w_out, DM, DM, (k0 < 1024 ? in.on_ssm : in.on_sb - 1024), WS_WOUT, 0, 0.f)
        TR_ITEM(I_GU, in.ffn2_wg, DM, FF, in.ffn2_norm, WS_WGU2, 1, pg8::F8_W_SCALE)
        TR_ITEM(I_GU, in.ffn2_wu, DM, FF, in.ffn2_norm, WS_WGU2, 2, pg8::F8_W_SCALE)
        TR_ITEM(I_D, in.ffn2_wd, FF, DM, (const float*)nullptr, WS_WD2, 0, 0.f)
        TR_ITEM(I_SQ, in.w_pg, DM, DM, in.ple_norm, WS_WPG, 0, 0.f)
        TR_ITEM(I_PP, in.w_pp, PLE, DM, (const float*)nullptr, WS_WPP, 0, 0.f)
    }
#undef TR_ITEM
    { bf16* XB = (bf16*)(ws + WS_XB); float* ss1 = (float*)(ws + WS_STAT) + ST_SS1 * MROWS;
      for (int mm = gw; mm < MROWS * P0_REP; mm += NGW) { const int m = mm % MROWS; const GAS f32x4* xr = (const GAS f32x4*)(in.x + (size_t)m * DM) + lane; GAS v2u* o = (GAS v2u*)(XB + (size_t)m * DM) + lane; float s = 0.f;
#pragma unroll
          for (int j = 0; j < 8; ++j) { const f32x4 v = xr[64 * j]; s += (v.x * v.x + v.y * v.y) + (v.z * v.z + v.w * v.w); v2u w; w.x = cvt_pk_bf16(v.x, v.y); w.y = cvt_pk_bf16(v.z, v.w); o[64 * j] = w; }
          s = wave_sum(s); if (lane == 0) ss1[m] = s; } }
    { const GAS f32x4* ps = (const GAS f32x4*)in.p; GAS v2u* o = (GAS v2u*)(ws + WS_PB);
      for (int i = bx * NTHREADS + tid; i < MROWS * PLE / 4; i += G * NTHREADS) { const f32x4 v = ps[i]; v2u w; w.x = cvt_pk_bf16(v.x, v.y); w.y = cvt_pk_bf16(v.z, v.w); o[i] = w; } }
}

constexpr int SSM_DROW = 132, SSM_SROW = 136;
constexpr int SSM_SUB = 64 * SSM_DROW * 4 + 64 * SSM_SROW * 2;
static_assert(2 * SSM_SUB <= RING_BYTES, "S5 LDS");
__device__ __forceinline__ void ssm_unit(unsigned char* ws, LAS unsigned char* lds, int b, int g0, int lane, int wave) {
    const int r16 = lane & 15, q4 = lane >> 4, sub = wave >> 2, w4 = wave & 3, g = g0 + sub;
    LAS float* DL = (LAS float*)(lds + sub * SSM_SUB); LAS bf16* S0 = (LAS bf16*)(lds + sub * SSM_SUB + 64 * SSM_DROW * 4);
    const bf16* Ms = (const bf16*)(ws + WS_SSMMAT) + (size_t)g * 3 * 16384; const bf16* Mi = Ms + 16384; const bf16* Mo = Mi + 16384;
    bf16x8 aS[2][4], aI[2][4];
#pragma unroll
    for (int ct = 0; ct < 2; ++ct)
#pragma unroll
        for (int ks = 0; ks < 4; ++ks) { const int o = (32 * w4 + 16 * ct + r16) * 128 + 32 * ks + 8 * q4; aS[ct][ks] = *(const bf16x8*)(Ms + o); aI[ct][ks] = *(const bf16x8*)(Mi + o); }
    const bf16* ug = (const bf16*)(ws + WS_UG) + (size_t)(b * 64 + g) * 4096 * 16;
    bf16* zb = (bf16*)(ws + WS_Z) + (size_t)b * 4096 * 1024 + g * 16;
    const float* l8 = (const float*)(ws + WS_LAM8) + (g * 64 + lane) * 2; const float l8r = l8[0], l8i = l8[1];
    float sre = 0.f, sim = 0.f;
    bf16x8 bu[4][4];
#define SSM_LOADU(SEG) do { _Pragma("unroll") for (int nt = 0; nt < 4; ++nt) { const int n = 64 * (SEG) + 16 * nt + r16; _Pragma("unroll") for (int ks = 0; ks < 4; ++ks) \
        bu[nt][ks] = *(const bf16x8*)(ug + (size_t)(n * 8 + 2 * ks + (q4 >> 1)) * 16 + 8 * (q4 & 1)); } } while (0)
    SSM_LOADU(0);
    for (int seg = 0; seg < 8; ++seg) {
        f32x4 ay[4][2];
#pragma unroll
        for (int nt = 0; nt < 4; ++nt)
#pragma unroll
            for (int ct = 0; ct < 2; ++ct) { f32x4 acc = {0.f, 0.f, 0.f, 0.f}, accy = {0.f, 0.f, 0.f, 0.f};
#pragma unroll
                for (int ks = 0; ks < 4; ++ks) { acc = mfma16(aS[ct][ks], bu[nt][ks], acc); accy = mfma16(aI[ct][ks], bu[nt][ks], accy); }
                *(LAS f32x4*)(DL + (16 * nt + r16) * SSM_DROW + 32 * w4 + 16 * ct + 4 * q4) = acc; ay[nt][ct] = accy; }
        if (seg < 7) SSM_LOADU(seg + 1);
        __syncthreads();
        if (w4 == 0) {
            for (int nb = 0; nb < 64; nb += 8) { float dr[8], di[8];
#pragma unroll
                for (int j = 0; j < 8; ++j) { dr[j] = DL[(nb + j) * SSM_DROW + lane]; di[j] = DL[(nb + j) * SSM_DROW + 64 + lane]; }
#pragma unroll
                for (int j = 0; j < 8; ++j) { S0[(nb + j) * SSM_SROW + lane] = (bf16)(cvt_pk_bf16(sre, 0.f) & 0xffffu); S0[(nb + j) * SSM_SROW + 64 + lane] = (bf16)(cvt_pk_bf16(sim, 0.f) & 0xffffu);
                    const float nr = l8r * sre - l8i * sim + dr[j], ni = l8r * sim + l8i * sre + di[j]; sre = nr; sim = ni; } }
        }
        bf16x8 aO[2][4];
#pragma unroll
        for (int ct = 0; ct < 2; ++ct)
#pragma unroll
            for (int ks = 0; ks < 4; ++ks) aO[ct][ks] = *(const bf16x8*)(Mo + (32 * w4 + 16 * ct + r16) * 128 + 32 * ks + 8 * q4);
        __syncthreads();
#pragma unroll
        for (int nt = 0; nt < 4; ++nt) { const int n = 64 * seg + 16 * nt + r16; bf16x8 bs[4];
#pragma unroll
            for (int ks = 0; ks < 4; ++ks) bs[ks] = *(const LAS bf16x8*)(S0 + (16 * nt + r16) * SSM_SROW + 32 * ks + 8 * q4);
#pragma unroll
            for (int ct = 0; ct < 2; ++ct) { f32x4 acc = ay[nt][ct];
#pragma unroll
                for (int ks = 0; ks < 4; ++ks) acc = mfma16(aO[ct][ks], bs[ks], acc);
                f32x4 z;
#pragma unroll
                for (int e = 0; e < 4; ++e) { const float y = acc[e]; const float t = 1.5957691216057308f * (y + 0.044715f * y * y * y); z[e] = y * __builtin_amdgcn_rcpf(1.0f + __builtin_amdgcn_exp2f(-1.4426950408889634f * t)); }
                v2u w; w.x = cvt_pk_bf16(z[0], z[1]); w.y = cvt_pk_bf16(z[2], z[3]);
                *(v2u*)(zb + (size_t)(n * 8 + 2 * w4 + ct) * 1024 + 4 * q4) = w; } }
    }
#undef SSM_LOADU
    __syncthreads();
}

constexpr int AT_KROW = 136, AT_VROW = 152, AT_SROW = 68, AT_PROW = 72;
constexpr int AT_KB = 64 * AT_KROW * 2, AT_VB = 64 * AT_VROW * 2, AT_BUF = AT_KB + AT_VB;
constexpr int AT_S_OFF = 2 * AT_BUF, AT_P_OFF = AT_S_OFF + 8 * 16 * AT_SROW * 4, AT_FLAG_OFF = AT_P_OFF + 8 * 16 * AT_PROW * 2;
static_assert(AT_FLAG_OFF + 64 <= RING_BYTES, "attention LDS");
constexpr float AT_THR = -152.0f;
typedef short s16x4 __attribute__((ext_vector_type(4)));
__device__ __forceinline__ s16x4 lds_tr(const LAS bf16* p) { return __builtin_bit_cast(s16x4, __builtin_amdgcn_ds_read_tr16_b64_v4i16((LAS s16x4*)p)); }
__device__ __forceinline__ void attn_unit(unsigned char* ws, LAS unsigned char* lds, int b, int h, int qb, int tid, int lane, int wave, bool do_ss) {
    const int r16 = lane & 15, q4 = lane >> 4;
    LAS float* Sw = (LAS float*)(lds + AT_S_OFF) + wave * 16 * AT_SROW; LAS bf16* Pw = (LAS bf16*)(lds + AT_P_OFF) + wave * 16 * AT_PROW;
    volatile LAS unsigned* flag = (volatile LAS unsigned*)(lds + AT_FLAG_OFF);
    const bf16* Qg = (const bf16*)(ws + WS_Q) + (size_t)b * SEQ * 1024 + h * 128;
    const bf16* Kg = (const bf16*)(ws + WS_K) + (size_t)b * SEQ * 1024 + h * 128;
    const bf16* Vg = (const bf16*)(ws + WS_V) + (size_t)b * SEQ * 1024 + h * 128;
    const int qw0 = 128 * qb + 16 * wave, qrow = qw0 + r16;
    bf16x8 qf[4];
#pragma unroll
    for (int ks = 0; ks < 4; ++ks) qf[ks] = *(const bf16x8*)(Qg + (size_t)qrow * 1024 + 32 * ks + 8 * q4);
    f32x4 o[8];
#pragma unroll
    for (int i = 0; i < 8; ++i) o[i] = (f32x4){0.f, 0.f, 0.f, 0.f};
    float carry = 0.f; bool done = false;
    const int pr0 = tid >> 4, pc = tid & 15;
    v4u kr[2], vr[2];
    int kt = 2 * qb + 1, buf = 0, it = 0;
#define AT_LOAD(KT) do { _Pragma("unroll") for (int i = 0; i < 2; ++i) { const size_t go = (size_t)(64 * (KT) + pr0 + 32 * i) * 1024 + 8 * pc; kr[i] = *(const v4u*)(Kg + go); vr[i] = *(const v4u*)(Vg + go); } } while (0)
#define AT_STAGE(B) do { _Pragma("unroll") for (int i = 0; i < 2; ++i) { const int row = pr0 + 32 * i; *(LAS v4u*)((LAS bf16*)(lds + (B) * AT_BUF) + row * AT_KROW + 8 * pc) = kr[i]; \
        *(LAS v4u*)((LAS bf16*)(lds + (B) * AT_BUF + AT_KB) + row * AT_VROW + 8 * pc) = vr[i]; } } while (0)
    AT_LOAD(kt); AT_STAGE(0);
    if (kt > 0) AT_LOAD(kt - 1);
    __syncthreads();
    for (;;) {
        const LAS bf16* Ks = (const LAS bf16*)(lds + buf * AT_BUF); const LAS bf16* Vs = (const LAS bf16*)(lds + buf * AT_BUF + AT_KB);
        const int j0 = 64 * kt;
        if (!done && j0 < qw0 + 15) {
            {
                bf16x8 ak[2][4];
#pragma unroll
                for (int ks = 0; ks < 4; ++ks) ak[0][ks] = *(const LAS bf16x8*)(Ks + r16 * AT_KROW + 32 * ks + 8 * q4);
#pragma unroll
                for (int t4 = 0; t4 < 4; ++t4) {
                    if (t4 < 3) {
#pragma unroll
                        for (int ks = 0; ks < 4; ++ks) ak[(t4 + 1) & 1][ks] = *(const LAS bf16x8*)(Ks + (16 * (t4 + 1) + r16) * AT_KROW + 32 * ks + 8 * q4); }
                    __builtin_amdgcn_sched_barrier(0);
                    f32x4 acc = {0.f, 0.f, 0.f, 0.f};
#pragma unroll
                    for (int ks = 0; ks < 4; ++ks) acc = mfma16(ak[t4 & 1][ks], qf[ks], acc);
                    *(LAS f32x4*)(Sw + r16 * AT_SROW + 16 * t4 + 4 * q4) = acc;
                    __builtin_amdgcn_sched_barrier(0); } }
            LDS_WAIT(); __builtin_amdgcn_wave_barrier();
            float lk[16], ls[16];
#pragma unroll
            for (int c = 0; c < 4; ++c) { const f32x4 sv = *(const LAS f32x4*)(Sw + r16 * AT_SROW + 16 * q4 + 4 * c);
#pragma unroll
                for (int e = 0; e < 4; ++e) { const float z2 = sv[e]; const float az = __builtin_fabsf(z2); const float ex = __builtin_amdgcn_exp2f(-az); const float sp = fmaxf(z2, 0.f) + __builtin_amdgcn_logf(1.0f + ex);
                    const bool valid = (j0 + 16 * q4 + 4 * c + e) < qrow; lk[4 * c + e] = valid ? -sp : 0.f; ls[4 * c + e] = valid ? (z2 - sp) : -1.0e30f; } }
            float run = 0.f, ps[16];
#pragma unroll
            for (int i = 15; i >= 0; --i) { ps[i] = run; run += lk[i]; }
            const float t0 = __shfl(run, r16), t1 = __shfl(run, r16 + 16), t2 = __shfl(run, r16 + 32), t3 = __shfl(run, r16 + 48);
            const float offs = (q4 < 1 ? t1 : 0.f) + (q4 < 2 ? t2 : 0.f) + (q4 < 3 ? t3 : 0.f);
            const float base = carry + offs;
            float wv[16];
#pragma unroll
            for (int i = 0; i < 16; ++i) wv[i] = __builtin_amdgcn_exp2f(ls[i] + ps[i] + base);
            carry += (t0 + t1) + (t2 + t3);
            v4u p0, p1;
            p0.x = cvt_pk_bf16(wv[0], wv[1]); p0.y = cvt_pk_bf16(wv[2], wv[3]); p0.z = cvt_pk_bf16(wv[4], wv[5]); p0.w = cvt_pk_bf16(wv[6], wv[7]);
            p1.x = cvt_pk_bf16(wv[8], wv[9]); p1.y = cvt_pk_bf16(wv[10], wv[11]); p1.z = cvt_pk_bf16(wv[12], wv[13]); p1.w = cvt_pk_bf16(wv[14], wv[15]);
            *(LAS v4u*)(Pw + r16 * AT_PROW + 16 * q4) = p0; *(LAS v4u*)(Pw + r16 * AT_PROW + 16 * q4 + 8) = p1;
            LDS_WAIT(); __builtin_amdgcn_wave_barrier();
            bf16x8 bp[2];
#pragma unroll
            for (int ks = 0; ks < 2; ++ks) bp[ks] = *(const LAS bf16x8*)(Pw + r16 * AT_PROW + 32 * ks + 8 * q4);
            const LAS bf16* vb = Vs + (8 * q4 + (r16 >> 2)) * AT_VROW + 4 * (r16 & 3);
            {
                s16x4 vlo[2][2], vhi[2][2];
#pragma unroll
                for (int ks = 0; ks < 2; ++ks) { vlo[0][ks] = lds_tr(vb + 32 * ks * AT_VROW); vhi[0][ks] = lds_tr(vb + (32 * ks + 4) * AT_VROW); }
#pragma unroll
                for (int dt = 0; dt < 8; ++dt) {
                    if (dt < 7) {
#pragma unroll
                        for (int ks = 0; ks < 2; ++ks) { vlo[(dt + 1) & 1][ks] = lds_tr(vb + 32 * ks * AT_VROW + 16 * (dt + 1)); vhi[(dt + 1) & 1][ks] = lds_tr(vb + (32 * ks + 4) * AT_VROW + 16 * (dt + 1)); } }
                    __builtin_amdgcn_sched_barrier(0);
#pragma unroll
                    for (int ks = 0; ks < 2; ++ks) { const bf16x8 av = __builtin_shufflevector(vlo[dt & 1][ks], vhi[dt & 1][ks], 0, 1, 2, 3, 4, 5, 6, 7); o[dt] = mfma16(av, bp[ks], o[dt]); }
                    __builtin_amdgcn_sched_barrier(0); } }
            done = __all(carry < AT_THR);
        }
        if (kt > 0) { AT_STAGE(buf ^ 1); if (kt > 1) AT_LOAD(kt - 2); }
        if (lane == 0) flag[(it & 1) * 8 + wave] = (!done && kt > 0) ? 1u : 0u;
        __syncthreads();
        unsigned any = 0;
#pragma unroll
        for (int i = 0; i < 8; ++i) any |= flag[(it & 1) * 8 + i];
        if (!any) break;
        --kt; buf ^= 1; ++it;
    }
#undef AT_LOAD
#undef AT_STAGE
    bf16* Y = (bf16*)(ws + WS_YMIX) + (size_t)(b * SEQ + qrow) * 2048 + 1024 + h * 128 + 4 * q4;
    float q = 0.f;
#pragma unroll
    for (int dt = 0; dt < 8; ++dt) { v2u w; w.x = cvt_pk_bf16(o[dt][0], o[dt][1]); w.y = cvt_pk_bf16(o[dt][2], o[dt][3]); *(v2u*)(Y + 16 * dt) = w; q += (o[dt][0] * o[dt][0] + o[dt][1] * o[dt][1]) + (o[dt][2] * o[dt][2] + o[dt][3] * o[dt][3]); }
    q += __shfl_xor(q, 16); q += __shfl_xor(q, 32);
    if (q4 == 0 && do_ss) atomicAdd((float*)(ws + WS_STAT) + ST_SB * MROWS + b * SEQ + qrow, q);
    __syncthreads();
}

#define XB_TMO      128
#define XB_XCNT(j)  (256  + 64 * (j))
#define XB_XSUB(j)  (1280 + 64 * (j))
#define XB_XGEN(j)  (2304 + 64 * (j))
#define XB_TOP      3328
#define XB_TOPGEN   3392
#define XCD_BAR_WORDS 3456
#define XB_SPIN_CAP (1u << 18)

__device__ __forceinline__ unsigned xb_ld(unsigned* p)              { return __hip_atomic_load(p, __ATOMIC_RELAXED, __HIP_MEMORY_SCOPE_AGENT); }
__device__ __forceinline__ unsigned xb_add(unsigned* p, unsigned v) { return __hip_atomic_fetch_add(p, v, __ATOMIC_RELAXED, __HIP_MEMORY_SCOPE_AGENT); }
__device__ __forceinline__ unsigned xb_xcc_id() { return (unsigned)__builtin_amdgcn_s_getreg((3 << 11) | 20) & 0xFu; }
#define XB_SPIN(cond, bar) do { unsigned _sp = 0; while (cond) { __builtin_amdgcn_s_sleep(1); \
    if ((++_sp & 255u) == 0u) { if (xb_ld(&(bar)[XB_TMO])) break; if (_sp > XB_SPIN_CAP) { atomicAdd(&(bar)[XB_TMO], 1u); break; } } } } while (0)

struct XcdBarrier {
    unsigned* bar; unsigned x;
    volatile LAS unsigned* st;
};

__device__ __forceinline__ XcdBarrier xcd_barrier_post(unsigned* bar, volatile LAS unsigned* st) {
    XcdBarrier b; b.bar = bar; b.x = xb_xcc_id(); b.st = st;
    if (threadIdx.x == 0) (void)xb_add(&bar[XB_XCNT(b.x)], 1u);
    return b;
}
__device__ __forceinline__ void xcd_barrier_complete(unsigned* bar, unsigned x, unsigned& nloc, unsigned& nx) {
    const unsigned G = gridDim.x * gridDim.y * gridDim.z;
    unsigned sum, cnt, mine, sp = 0u;
    for (;;) {
        sum = 0u; cnt = 0u; mine = 0u;
#pragma unroll
        for (unsigned j = 0; j < 16; ++j) { const unsigned c = xb_ld(&bar[XB_XCNT(j)]); sum += c; cnt += (c > 0u) ? 1u : 0u; mine = (j == x) ? c : mine; }
        if (sum == G) break;
        __builtin_amdgcn_s_sleep(1);
        if ((++sp & 255u) == 0u) { if (xb_ld(&bar[XB_TMO])) break; if (sp > XB_SPIN_CAP) { atomicAdd(&bar[XB_TMO], 1u); break; } }
    }
    nloc = mine > 0u ? mine : 1u; nx = cnt > 0u ? cnt : 1u;
}

__device__ __forceinline__ void xcd_barrier(const XcdBarrier& b) {
    asm volatile("s_waitcnt vmcnt(0)" ::: "memory");
    __syncthreads();
    if (threadIdx.x == 0) {
        unsigned* bar = b.bar;
        __builtin_amdgcn_s_waitcnt(0);
        unsigned nloc = b.st[0], nx = b.st[1];
        if (nloc == 0u) { xcd_barrier_complete(bar, b.x, nloc, nx); b.st[0] = nloc; b.st[1] = nx; }
        const unsigned old = xb_add(&bar[XB_XSUB(b.x)], 1u);
        const unsigned gen = old / nloc;
        if (old + 1u == (gen + 1u) * nloc) {
            __builtin_amdgcn_fence(__ATOMIC_RELEASE, "agent");
            asm volatile("s_waitcnt vmcnt(0)" ::: "memory");
            const unsigned og = xb_add(&bar[XB_TOP], 1u);
            const unsigned tg = og / nx;
            if (og + 1u == (tg + 1u) * nx) xb_add(&bar[XB_TOPGEN], 1u);
            else XB_SPIN(xb_ld(&bar[XB_TOPGEN]) == tg, bar);
            __builtin_amdgcn_fence(__ATOMIC_ACQUIRE, "agent");
            xb_add(&bar[XB_XGEN(b.x)], 1u);
            asm volatile("s_waitcnt vmcnt(0)" ::: "memory");
        } else {
            XB_SPIN(xb_ld(&bar[XB_XGEN(b.x)]) == gen, bar);
            __builtin_amdgcn_fence(__ATOMIC_ACQUIRE, "agent");
            asm volatile("s_waitcnt vmcnt(0)" ::: "memory");
        }
    }
    __syncthreads();
}

static_assert(BAR_WORDS == XCD_BAR_WORDS, "barrier words");
struct Args { const float* in[31]; float* out; unsigned char* ws; };
#ifndef MK_PHASE_MASK
#define MK_PHASE_MASK 0xFFFFFFFFu
#endif
__global__ void __launch_bounds__(NTHREADS, 2) mk_fwd(Args args) {
    extern __shared__ __attribute__((aligned(16))) unsigned char lds_raw[];
    LAS unsigned char* lds = (LAS unsigned char*)lds_raw;
    cg::grid_group grid = cg::this_grid();
    volatile LAS unsigned* bar_st = (volatile LAS unsigned*)(lds + XCH_OFF + 12288);
    if (threadIdx.x < 2) bar_st[threadIdx.x] = 0u;
    __syncthreads();
    const int wave_s = __builtin_amdgcn_readfirstlane(threadIdx.x >> 6);
#define FRESH_IDS unsigned ones_ = ~0u; asm volatile("" : "+s"(ones_)); const int lane = (int)__builtin_amdgcn_mbcnt_hi(ones_, __builtin_amdgcn_mbcnt_lo(ones_, 0u)), wave = wave_s, tid = wave * 64 + lane; (void)tid; (void)lane; (void)wave;
    const int G = gridDim.x, bx = blockIdx.x;
    unsigned char* ws = args.ws; float* out = args.out;
    In in;
    in.x = args.in[0]; in.p = args.in[1]; in.ffn1_norm = args.in[2]; in.ffn1_wg = args.in[3]; in.ffn1_wu = args.in[4]; in.ffn1_wd = args.in[5]; in.mix_norm = args.in[6]; in.w_in = args.in[7];
    in.lam_re = args.in[8]; in.lam_im = args.in[9]; in.b_re = args.in[10]; in.b_im = args.in[11]; in.c_re = args.in[12]; in.c_im = args.in[13]; in.log_dt = args.in[14]; in.ssm_d = args.in[15];
    in.w_glu = args.in[16]; in.b_glu = args.in[17]; in.q_norm = args.in[18]; in.k_norm = args.in[19]; in.on_ssm = args.in[20]; in.on_sb = args.in[21]; in.w_out = args.in[22];
    in.ffn2_norm = args.in[23]; in.ffn2_wg = args.in[24]; in.ffn2_wu = args.in[25]; in.ffn2_wd = args.in[26]; in.ple_norm = args.in[27]; in.w_pg = args.in[28]; in.w_pp = args.in[29]; in.ple_post = args.in[30];
    float* stat = (float*)(ws + WS_STAT);
    bf16* XB = (bf16*)(ws + WS_XB); bf16* ACT = (bf16*)(ws + WS_ACT); bf16* YMIX = (bf16*)(ws + WS_YMIX);
#define PH(k) ((MK_PHASE_MASK >> (k)) & 1u)
#ifndef MK_DUP
#define MK_DUP 0u
#endif
#define NREP(k) (1 + (int)((MK_DUP >> (k)) & 1u))

    { FRESH_IDS p0_prologue(in, out, ws, lds, tid, lane, wave); }
    grid.sync();
    const XcdBarrier xbar = xcd_barrier_post((unsigned*)(ws + WS_BAR), bar_st);
    for (int rep_ = 0; rep_ < NREP(1); ++rep_) { pg8::Gemm g{XB, (const bf16*)(ws + WS_WGU1), MROWS, 2 * FF, DM, DM}; pg8::StaticOrder S; S.init(MROWS, 2 * FF, G, bx);
        pg8::EpiSwiGLU<false> E{ACT, stat + ST_SS1 * MROWS, FF, (LAS float*)(lds + XCH_OFF), 1.0f}; pg8::gemm_phase<pg8::EpiSwiGLU<false>, pg8::StaticOrder, true, true>(lds, g, S, E, wave_s); }
    xcd_barrier(xbar);
    for (int rep_ = 0; rep_ < NREP(2); ++rep_) { pg8::Gemm g{ACT, (const bf16*)(ws + WS_WD1), MROWS, DM, FF, FF}; pg8::StaticOrder S; S.init(MROWS, DM, G, bx);
        pg8::EpiResid<0, false> E{nullptr, XB, (rep_ + 1 < NREP(2)) ? nullptr : stat + ST_SS2 * MROWS, nullptr, nullptr, nullptr, 0.5f}; pg8::gemm_phase<pg8::EpiResid<0, false>, pg8::StaticOrder, true, true, true>(lds, g, S, E, wave_s); }
    xcd_barrier(xbar);
    for (int rep_ = 0; rep_ < NREP(3); ++rep_) { pg8::Gemm g{XB, (const bf16*)(ws + WS_WIN), MROWS, NIN, DM, DM}; pg8::StaticOrder S; S.init(MROWS, NIN, G, bx);
        pg8::EpiWin E{stat + ST_SS2 * MROWS, (bf16*)(ws + WS_UG), (bf16*)(ws + WS_Q), (bf16*)(ws + WS_K), (bf16*)(ws + WS_V), in.q_norm, in.k_norm, (LAS float*)(lds + XCH_OFF)};
        pg8::gemm_phase<pg8::EpiWin, pg8::StaticOrder, true, true>(lds, g, S, E, wave_s); }
    xcd_barrier(xbar);
    { FRESH_IDS
        for (int itt = bx; itt < (256 + 2048) * P4_REP; itt += G) { const int it = itt % (256 + 2048);
            unsigned o2_ = ~0u; asm volatile("" : "+s"(o2_)); const int lane2 = (int)__builtin_amdgcn_mbcnt_hi(o2_, __builtin_amdgcn_mbcnt_lo(o2_, 0u)), tid2 = wave * 64 + lane2;
            if (it < 256) ssm_unit(ws, lds, it >> 5, 2 * (it & 31), lane2, wave);
            else { const int a = it - 256; attn_unit(ws, lds, a >> 8, (a >> 5) & 7, a & 31, tid2, lane2, wave, itt >= (256 + 2048) * (P4_REP - 1)); }
        }
    }
    xcd_barrier(xbar);
    if (PH(5)) { pg8::Gemm g{(const bf16*)(ws + WS_Z), (const bf16*)(ws + WS_WGLU), MROWS, SSMW, SSMW, SSMW}; pg8::StaticOrder S; S.init(MROWS, SSMW, G, bx);
        pg8::EpiGlu E{(const bf16*)(ws + WS_Z), in.b_glu, YMIX, stat + ST_SSM * MROWS}; pg8::gemm_phase<pg8::EpiGlu, pg8::StaticOrder, true, true>(lds, g, S, E, wave_s); }
    xcd_barrier(xbar);
    if (PH(6)) { pg8::Gemm g{YMIX, (const bf16*)(ws + WS_WOUT), MROWS, DM, DM, DM / 2}; pg8::SplitOrder S; S.base.init(MROWS, DM, G, bx);
        pg8::EpiResid<1, false, false, true> E{nullptr, XB, stat + ST_SS3 * MROWS, stat + ST_SSM * MROWS, stat + ST_SB * MROWS, ws + WS_XB8, 0.f}; pg8::gemm_phase<pg8::EpiResid<1, false, false, true>, pg8::SplitOrder, true, true>(lds, g, S, E, wave_s); }
    xcd_barrier(xbar);
    if (PH(7)) { pg8::Gemm g{(const bf16*)(ws + WS_XB8), (const bf16*)(ws + WS_WGU2), MROWS, 2 * FF, DM / 2, DM / 2}; pg8::StaticOrder S; S.init(MROWS, 2 * FF, G, bx);
        pg8::EpiSwiGLU<false, true> E{ACT, stat + ST_SS3 * MROWS, FF, (LAS float*)(lds + XCH_OFF), 1.0f / (pg8::F8_X_SCALE * pg8::F8_W_SCALE)}; pg8::gemm_phase<pg8::EpiSwiGLU<false, true>, pg8::StaticOrder, true, true, false, true>(lds, g, S, E, wave_s); }
    xcd_barrier(xbar);
    if (PH(8)) { pg8::Gemm g{ACT, (const bf16*)(ws + WS_WD2), MROWS, DM, FF, FF}; pg8::StaticOrder S; S.init(MROWS, DM, G, bx);
        pg8::EpiResid<0, false> E{nullptr, XB, stat + ST_SS4 * MROWS, nullptr, nullptr, nullptr, 0.5f}; pg8::gemm_phase<pg8::EpiResid<0, false>, pg8::StaticOrder, true, true, true>(lds, g, S, E, wave_s); }
    xcd_barrier(xbar);
    if (PH(9)) { pg8::Gemm g{(const bf16*)(ws + WS_PB), (const bf16*)(ws + WS_WPP), MROWS, DM, PLE, PLE}; pg8::StaticOrder S; S.init(MROWS, DM, G, bx);
        pg8::EpiPlain E{YMIX, DM}; pg8::gemm_phase<pg8::EpiPlain, pg8::StaticOrder, true, true>(lds, g, S, E, wave_s); }
    asm volatile("s_waitcnt vmcnt(0)" ::: "memory"); __syncthreads();
    if (PH(10)) { pg8::Gemm g{XB, (const bf16*)(ws + WS_WPG), MROWS, DM, DM, DM}; pg8::StaticOrder S; S.init(MROWS, DM, G, bx);
        pg8::EpiPle E{YMIX, stat + ST_SS4 * MROWS, (bf16*)(ws + WS_E), stat + ST_SSE * MROWS}; pg8::gemm_phase<pg8::EpiPle, pg8::StaticOrder, true, true>(lds, g, S, E, wave_s); }
    xcd_barrier(xbar);
    if (PH(11)) { FRESH_IDS const bf16* E = (const bf16*)(ws + WS_E); const float* sse = stat + ST_SSE * MROWS; const int gw = bx * NWAVES + wave, NGW = G * NWAVES;
        for (int m = gw; m < MROWS; m += NGW) { const float r = pg8::rstd_of(sse[m], 1.0f / 2048.0f); GAS f32x4* xr = (GAS f32x4*)(out + (size_t)m * DM) + lane; const GAS v2u* xbr = (const GAS v2u*)(XB + (size_t)m * DM) + lane; const GAS v2u* er = (const GAS v2u*)(E + (size_t)m * DM) + lane;
            const GAS f32x4* gp = (const GAS f32x4*)in.ple_post + lane;
#pragma unroll
            for (int j = 0; j < 8; ++j) { const v2u xw = xbr[64 * j]; const v2u w = er[64 * j]; const f32x4 gg = gp[64 * j]; f32x4 v;
                v.x = pg8::bf_lo(xw.x) + pg8::bf_lo(w.x) * r * gg.x; v.y = pg8::bf_hi(xw.x) + pg8::bf_hi(w.x) * r * gg.y; v.z = pg8::bf_lo(xw.y) + pg8::bf_lo(w.y) * r * gg.z; v.w = pg8::bf_hi(xw.y) + pg8::bf_hi(w.y) * r * gg.w; xr[64 * j] = v; } } }
#undef PH
}

extern "C" void kernel_launch(void* const* d_in, const int* in_sizes, int n_in, void* d_out, int out_size, void* d_ws, size_t ws_size, hipStream_t stream) {
    static int grid = 0;
    if (grid == 0) {
        if (n_in != 31 || out_size != MROWS * DM || ws_size < WS_END) { fprintf(stderr, "kernel_launch: unexpected shapes (n_in %d, out %d, ws %zu)\n", n_in, out_size, ws_size); grid = -1; return; }
        int dev = 0, cus = 0, per_cu = 0;
        hipGetDevice(&dev); hipDeviceGetAttribute(&cus, hipDeviceAttributeMultiprocessorCount, dev);
        if (hipFuncSetAttribute((const void*)mk_fwd, hipFuncAttributeMaxDynamicSharedMemorySize, LDS_BYTES) != hipSuccess) { fprintf(stderr, "kernel_launch: hipFuncSetAttribute failed\n"); grid = -1; return; }
        if (hipOccupancyMaxActiveBlocksPerMultiprocessor(&per_cu, (const void*)mk_fwd, NTHREADS, LDS_BYTES) != hipSuccess || per_cu < 1) { fprintf(stderr, "kernel_launch: occupancy query gives %d\n", per_cu); per_cu = 1; }
        (void)hipGetLastError();
        grid = cus * 1;
    }
    if (grid < 0) return;
    Args a{};
    for (int i = 0; i < 31; ++i) a.in[i] = (const float*)d_in[i];
    a.out = (float*)d_out; a.ws = (unsigned char*)d_ws;
    void* kargs[] = {&a};
    hipError_t e = hipLaunchCooperativeKernel((const void*)mk_fwd, dim3(grid), dim3(NTHREADS), kargs, LDS_BYTES, stream);
    if (e != hipSuccess) fprintf(stderr, "kernel_launch: cooperative launch failed: %s (grid %d)\n", hipGetErrorString(e), grid);
}
```

```cpp
#include <hip/hip_runtime.h>
#include <hip/hip_cooperative_groups.h>
#include <cstdio>
#include <cstdint>
namespace cg = cooperative_groups;
namespace pg8 {
#define PG8_LAS __attribute__((address_space(3)))
typedef unsigned short bf16_t;
typedef short bf16x8 __attribute__((ext_vector_type(8)));
typedef float f32x4 __attribute__((ext_vector_type(4)));
typedef unsigned u32x4 __attribute__((ext_vector_type(4)));
constexpr int BM = 256, BK = 64, HALF = 128, HTB = HALF * BK * 2  , STAGE_BYTES = 8 * HTB, NXCD = 8, WGM = 8;

__host__ __device__ __forceinline__ int lds_byte(int r, int c) { const int st = (r >> 4) * 2 + (c >> 5), rr = r & 15, cc = c & 31, ob = rr * 64 + cc * 2; return st * 1024 + (ob ^ (((ob >> 9) & 1) << 5)); }
__host__ __device__ __forceinline__ void stage_rc(int b, int& R, int& C) { const int st = b / 1024, sb = b % 1024, swz = sb ^ (((sb >> 9) & 1) << 5); R = (st >> 1) * 16 + swz / 64; C = (st & 1) * 32 + (swz % 64) / 2; }
__host__ __device__ __forceinline__ int perm32(int rho) { const int n = rho >> 4, i = rho & 15; return 8 * (i >> 2) + 4 * n + (i & 3); }

struct Unit { int pm, pn, kh, par; };
struct Gemm { const bf16_t* A; const bf16_t* Bt; int M, N, K, KU; };

struct StaticOrder {
    int nM, nN, nwg, G, c;
    __host__ __device__ void init(int M, int N, int G_, int c_) { nM = M / BM; nN = N / BM; nwg = nM * nN; G = G_; c = c_; }
    __host__ __device__ bool next(int i, Unit& u) const {
        const long L = (long)i * G + c; if (L >= nwg) return false;
        int wgid = (int)L; { const int q = nwg / NXCD, r = nwg % NXCD, xcd = wgid % NXCD, off = wgid / NXCD; wgid = (xcd < r ? xcd * (q + 1) : r * (q + 1) + (xcd - r) * q) + off; }
        const int nig = WGM * nN, gid = wgid / nig, fm = gid * WGM, gsz = (nM - fm) < WGM ? (nM - fm) : WGM;
        u.pm = fm + ((wgid % nig) % gsz); u.pn = (wgid % nig) / gsz; u.kh = 0; return true;
    }
    __device__ __forceinline__ void a_ready(const Unit&) const {}
    __device__ __forceinline__ void done(const Unit&) const {}
};

__device__ __forceinline__ unsigned cvt_pk_bf16(float lo, float hi) { unsigned r; asm volatile("v_cvt_pk_bf16_f32 %0, %1, %2" : "=v"(r) : "v"(lo), "v"(hi)); return r; }
typedef int i32x4 __attribute__((ext_vector_type(4)));
typedef int i32x8 __attribute__((ext_vector_type(8)));
__device__ __forceinline__ i32x8 cat8(bf16x8 a, bf16x8 b) { return __builtin_shufflevector(__builtin_bit_cast(i32x4, a), __builtin_bit_cast(i32x4, b), 0, 1, 2, 3, 4, 5, 6, 7); }
__device__ __forceinline__ unsigned pack4_fp8(float a, float b, float c, float d) {
    a = __builtin_fminf(__builtin_fmaxf(a, -448.f), 448.f); b = __builtin_fminf(__builtin_fmaxf(b, -448.f), 448.f); c = __builtin_fminf(__builtin_fmaxf(c, -448.f), 448.f); d = __builtin_fminf(__builtin_fmaxf(d, -448.f), 448.f);
    int w = __builtin_amdgcn_cvt_pk_fp8_f32(a, b, 0, false); w = __builtin_amdgcn_cvt_pk_fp8_f32(c, d, w, true); return (unsigned)w; }
constexpr float F8_ACT_SCALE = 8.0f, F8_W_SCALE = 64.0f, F8_X_SCALE = 16.0f;
struct SplitOrder {
    StaticOrder base;
    __device__ bool next(int i, Unit& u) const { const bool r = base.next(i >> 1, u); u.kh = i & 1; return r; }
    __device__ __forceinline__ void a_ready(const Unit&) const {}
    __device__ __forceinline__ void done(const Unit&) const {}
};
typedef float f32x2 __attribute__((ext_vector_type(2)));
__device__ __forceinline__ float rstd_of(float ss, float inv_n) { return __builtin_amdgcn_rsqf(ss * inv_n + 1e-6f); }
__device__ __forceinline__ float sigmoid_f(float v) { return __builtin_amdgcn_rcpf(1.0f + __builtin_amdgcn_exp2f(-1.4426950408889634f * v)); }
__device__ __forceinline__ float bf_lo(unsigned w) { return __uint_as_float(w << 16); }
__device__ __forceinline__ float bf_hi(unsigned w) { return __uint_as_float(w & 0xffff0000u); }
__device__ __forceinline__ u32x4 pack8(const f32x4 a, const f32x4 b) { u32x4 w; w.x = cvt_pk_bf16(a[0], a[1]); w.y = cvt_pk_bf16(a[2], a[3]); w.z = cvt_pk_bf16(b[0], b[1]); w.w = cvt_pk_bf16(b[2], b[3]); return w; }
__device__ __forceinline__ float sumsq4(const f32x4 a) { return (a[0] * a[0] + a[1] * a[1]) + (a[2] * a[2] + a[3] * a[3]); }

template <bool F8OUT, bool OPQ = false> struct EpiSwiGLU {
    static constexpr bool PERM = true, AFTER_DRAIN = false, MID = false, PREF = true;
    bf16_t* O; const float* ss; int ldo; PG8_LAS float* sl; float ascale;
    __device__ __forceinline__ void prefetch(const Unit& u, int wid, int lane) const {
        if (wid < 4) __builtin_amdgcn_global_load_lds((const unsigned*)(ss + u.pm * BM + 64 * wid + lane), (PG8_LAS unsigned*)(sl + u.par * 256 + 64 * wid), 4, 0, 0);
    }
    __device__ __forceinline__ void operator()(f32x4 (&acc)[2][2][4][2], const Unit& u_, int wr, int wc, int fr, int fq) const {
        Unit u = u_; if constexpr (OPQ) { unsigned o1_ = ~0u; asm volatile("" : "+s"(u.pm), "+s"(u.pn), "+s"(o1_)); const int l_ = (int)__builtin_amdgcn_mbcnt_hi(o1_, __builtin_amdgcn_mbcnt_lo(o1_, 0u)); fr = l_ & 15; fq = l_ >> 4; }
        const int row0 = u.pm * BM + wr * 64 + fr, col0 = u.pn * HALF + wc * 32 + 8 * fq;
#pragma unroll
        for (int ai = 0; ai < 2; ++ai)
#pragma unroll
            for (int m = 0; m < 4; ++m) {
                const int row = row0 + ai * HALF + m * 16; const float r = rstd_of(sl[u.par * 256 + ai * HALF + wr * 64 + m * 16 + fr], 1.0f / 2048.0f) * ascale;
                f32x4 o[2];
#pragma unroll
                for (int n = 0; n < 2; ++n) { const f32x4 g = acc[ai][0][m][n] * r, uu = acc[ai][1][m][n] * r;
#pragma unroll
                    for (int e = 0; e < 4; ++e) o[n][e] = g[e] * uu[e] * sigmoid_f(g[e]); }
                if constexpr (F8OUT) {
                    typedef unsigned u32x2 __attribute__((ext_vector_type(2))); u32x2 w8; w8.x = pack4_fp8(o[0][0] * F8_ACT_SCALE, o[0][1] * F8_ACT_SCALE, o[0][2] * F8_ACT_SCALE, o[0][3] * F8_ACT_SCALE);
                    w8.y = pack4_fp8(o[1][0] * F8_ACT_SCALE, o[1][1] * F8_ACT_SCALE, o[1][2] * F8_ACT_SCALE, o[1][3] * F8_ACT_SCALE);
                    *(u32x2*)((unsigned char*)O + (((size_t)u.pm * (ldo / 128) + (col0 >> 7)) * BM + (ai * HALF + wr * 64 + m * 16 + fr)) * 128 + (col0 & 127)) = w8;
                } else
                *(u32x4*)(O + (((size_t)u.pm * (ldo / 64) + (col0 >> 6)) * BM + (ai * HALF + wr * 64 + m * 16 + fr)) * 64 + (col0 & 63)) = pack8(o[0], o[1]);
            }
    }
    __device__ __forceinline__ void mid(f32x4 (&)[2][2][4][2], const Unit&, int, int) const {}
};

template <int MODE, bool XF32, bool BATCH = true, bool OPQ = false> struct EpiResid {
    static constexpr bool PERM = true, AFTER_DRAIN = false, MID = (MODE == 1), PREF = false;
    const float* xin; bf16_t* xb; float* ssout; const float* ssa; const float* ssb; unsigned char* x8; float alpha;
    __device__ __forceinline__ void mid(f32x4 (&acc)[2][2][4][2], const Unit& u, int wr, int fr) const {
        {
            const int row0 = u.pm * BM + wr * 64 + fr;
#pragma unroll
            for (int ai = 0; ai < 2; ++ai)
#pragma unroll
                for (int m = 0; m < 4; ++m) { const int row = row0 + ai * HALF + m * 16;
                    const float ra = rstd_of(ssa[row], 1.0f / 1024.0f), rb = rstd_of(ssb[row], 1.0f / 1024.0f), ratio = ra * __builtin_amdgcn_rcpf(rb);
#pragma unroll
                    for (int bj = 0; bj < 2; ++bj)
#pragma unroll
                        for (int n = 0; n < 2; ++n) acc[ai][bj][m][n] = acc[ai][bj][m][n] * ratio;
                    asm volatile("" ::: "memory"); }
        }
    }
    __device__ __forceinline__ void operator()(f32x4 (&acc)[2][2][4][2], const Unit& u_, int wr, int wc, int fr, int fq) const {
        Unit u = u_; if constexpr (OPQ) { unsigned o1_ = ~0u; asm volatile("" : "+s"(u.pm), "+s"(u.pn), "+s"(o1_)); const int l_ = (int)__builtin_amdgcn_mbcnt_hi(o1_, __builtin_amdgcn_mbcnt_lo(o1_, 0u)); fr = l_ & 15; fq = l_ >> 4; }
        if (MODE == 1 && u.kh == 0) { mid(acc, u, wr, fr); return; }
        const int row0 = u.pm * BM + wr * 64 + fr, col0 = u.pn * BM + wc * 32 + 8 * fq;
        u32x4 xw[2][4][2]; f32x4 xf[XF32 ? 16 : 1][2];
#pragma unroll
        for (int ai = 0; ai < 2; ++ai)
#pragma unroll
            for (int m = 0; m < 4; ++m)
#pragma unroll
                for (int bj = 0; bj < 2; ++bj) { const size_t off = (size_t)(row0 + ai * HALF + m * 16) * 2048 + col0 + bj * HALF;
                    if constexpr (XF32) { xf[(ai * 4 + m) * 2 + bj][0] = *(const f32x4*)(xin + off); xf[(ai * 4 + m) * 2 + bj][1] = *(const f32x4*)(xin + off + 4); }
                    else if constexpr (BATCH) xw[ai][m][bj] = *(const u32x4*)(xb + off); }
#pragma unroll
        for (int ai = 0; ai < 2; ++ai)
#pragma unroll
            for (int m = 0; m < 4; ++m) {
                const int row = row0 + ai * HALF + m * 16; const size_t off = (size_t)row * 2048 + col0;
                float sc = alpha; if constexpr (MODE == 1) sc = rstd_of(ssb[row], 1.0f / 1024.0f);
                float q = 0.f;
#pragma unroll
                for (int bj = 0; bj < 2; ++bj) {
                    f32x4 x0, x1;
                    if constexpr (XF32) { x0 = xf[(ai * 4 + m) * 2 + bj][0]; x1 = xf[(ai * 4 + m) * 2 + bj][1]; }
                    else { const u32x4 w = BATCH ? xw[ai][m][bj] : *(const u32x4*)(xb + off + bj * HALF); x0 = (f32x4){bf_lo(w.x), bf_hi(w.x), bf_lo(w.y), bf_hi(w.y)}; x1 = (f32x4){bf_lo(w.z), bf_hi(w.z), bf_lo(w.w), bf_hi(w.w)}; }
                    const f32x4 v0 = x0 + acc[ai][bj][m][0] * sc, v1 = x1 + acc[ai][bj][m][1] * sc;
                    *(u32x4*)(xb + off + bj * HALF) = pack8(v0, v1);
                    if (x8) { typedef unsigned u32x2 __attribute__((ext_vector_type(2))); u32x2 w8; w8.x = pack4_fp8(v0[0] * F8_X_SCALE, v0[1] * F8_X_SCALE, v0[2] * F8_X_SCALE, v0[3] * F8_X_SCALE);
                        w8.y = pack4_fp8(v1[0] * F8_X_SCALE, v1[1] * F8_X_SCALE, v1[2] * F8_X_SCALE, v1[3] * F8_X_SCALE); *(u32x2*)(x8 + off + bj * HALF) = w8; }
                    q += sumsq4(v0) + sumsq4(v1);
                }
                q += __shfl_xor(q, 16); q += __shfl_xor(q, 32);
                if (fq == 0 && ssout) atomicAdd(ssout + row, q);
                if constexpr (!BATCH) { if (m == 3) asm volatile("" ::: "memory"); }
            }
    }
};

struct EpiWin {
    static constexpr bool PERM = true, AFTER_DRAIN = false, MID = false, PREF = false;
    const float* ss; bf16_t *UG, *Q, *K, *V; const float *gq, *gk; PG8_LAS float* xch;
    __device__ __forceinline__ void mid(f32x4 (&)[2][2][4][2], const Unit&, int, int) const {}
    __device__ __forceinline__ void operator()(f32x4 (&acc)[2][2][4][2], const Unit& u, int wr, int wc, int fr, int fq) const {
        const int row0 = u.pm * BM + wr * 64 + fr, seg = u.pn >> 2, lc0 = (u.pn & 3) * BM + wc * 32 + 8 * fq; const float* ssr = ss + row0;
        if (seg == 0) {
#pragma unroll
            for (int ai = 0; ai < 2; ++ai)
#pragma unroll
                for (int m = 0; m < 4; ++m) { const float r = rstd_of(ssr[ai * HALF + m * 16], 1.0f / 2048.0f); const int row = row0 + ai * HALF + m * 16, b = row >> 12, t = row & 4095;
#pragma unroll
                    for (int bj = 0; bj < 2; ++bj) { const int col = lc0 + bj * HALF, g = col >> 4, half = (col >> 3) & 1;
                        *(u32x4*)(UG + ((size_t)((b * 64 + g) * 4096 + t) * 16 + 8 * half)) = pack8(acc[ai][bj][m][0] * r, acc[ai][bj][m][1] * r); } }
        } else if (seg == 3) {
#pragma unroll
            for (int ai = 0; ai < 2; ++ai)
#pragma unroll
                for (int m = 0; m < 4; ++m) { const float r = rstd_of(ssr[ai * HALF + m * 16], 1.0f / 2048.0f); const int row = row0 + ai * HALF + m * 16;
#pragma unroll
                    for (int bj = 0; bj < 2; ++bj) *(u32x4*)(V + (size_t)row * 1024 + lc0 + bj * HALF) = pack8(acc[ai][bj][m][0] * r, acc[ai][bj][m][1] * r); }
        } else {
#pragma unroll
            for (int ai = 0; ai < 2; ++ai)
#pragma unroll
                for (int m = 0; m < 4; ++m) { const int rl = ai * HALF + wr * 64 + m * 16 + fr;
#pragma unroll
                    for (int bj = 0; bj < 2; ++bj) { float q = sumsq4(acc[ai][bj][m][0]) + sumsq4(acc[ai][bj][m][1]); q += __shfl_xor(q, 16); q += __shfl_xor(q, 32);
                        if (fq == 0) xch[rl * 8 + bj * 4 + wc] = q; } }
            asm volatile("s_waitcnt lgkmcnt(0)" ::: "memory"); __builtin_amdgcn_s_barrier(); asm volatile("" ::: "memory");
            const float* gain = (seg == 1) ? gq : gk; bf16_t* dst = (seg == 1) ? Q : K;
            const float osc = (seg == 1) ? (0.08838834764831845f * 1.4426950408889634f) : 1.0f;
            const int d0 = wc * 32 + 8 * fq;
            const f32x4 g0 = *(const f32x4*)(gain + d0) * osc, g1 = *(const f32x4*)(gain + d0 + 4) * osc;
#pragma unroll
            for (int ai = 0; ai < 2; ++ai)
#pragma unroll
                for (int m = 0; m < 4; ++m) { const int rl = ai * HALF + wr * 64 + m * 16 + fr, row = u.pm * BM + rl;
                    const float epr = 1e-6f * (ssr[ai * HALF + m * 16] * (1.0f / 2048.0f) + 1e-6f);
#pragma unroll
                    for (int bj = 0; bj < 2; ++bj) { const f32x4 p = *(const PG8_LAS f32x4*)(xch + rl * 8 + bj * 4);
                        const float rq = __builtin_amdgcn_rsqf(((p[0] + p[1]) + (p[2] + p[3])) * (1.0f / 128.0f) + epr);
                        *(u32x4*)(dst + (size_t)row * 1024 + lc0 + bj * HALF) = pack8(acc[ai][bj][m][0] * g0 * rq, acc[ai][bj][m][1] * g1 * rq); } }
        }
    }
};

struct EpiGlu {
    static constexpr bool PERM = true, AFTER_DRAIN = false, MID = false, PREF = false;
    const bf16_t* Z; const float* bias; bf16_t* Y; float* ssout;
    __device__ __forceinline__ void mid(f32x4 (&)[2][2][4][2], const Unit&, int, int) const {}
    __device__ __forceinline__ void operator()(f32x4 (&acc)[2][2][4][2], const Unit& u, int wr, int wc, int fr, int fq) const {
        const int row0 = u.pm * BM + wr * 64 + fr, col0 = u.pn * BM + wc * 32 + 8 * fq;
        f32x4 bv[2][2];
#pragma unroll
        for (int bj = 0; bj < 2; ++bj)
#pragma unroll
            for (int n = 0; n < 2; ++n) bv[bj][n] = *(const f32x4*)(bias + col0 + bj * HALF + 4 * n);
        u32x4 zw[2][4][2];
#pragma unroll
        for (int ai = 0; ai < 2; ++ai)
#pragma unroll
            for (int m = 0; m < 4; ++m)
#pragma unroll
                for (int bj = 0; bj < 2; ++bj) zw[ai][m][bj] = *(const u32x4*)(Z + (size_t)(row0 + ai * HALF + m * 16) * 1024 + col0 + bj * HALF);
#pragma unroll
        for (int ai = 0; ai < 2; ++ai)
#pragma unroll
            for (int m = 0; m < 4; ++m) { const int row = row0 + ai * HALF + m * 16; float q = 0.f;
#pragma unroll
                for (int bj = 0; bj < 2; ++bj) { const u32x4 zb = zw[ai][m][bj];
                    const f32x4 z0 = {bf_lo(zb.x), bf_hi(zb.x), bf_lo(zb.y), bf_hi(zb.y)}, z1 = {bf_lo(zb.z), bf_hi(zb.z), bf_lo(zb.w), bf_hi(zb.w)};
                    const f32x4 a0 = acc[ai][bj][m][0] + bv[bj][0], a1 = acc[ai][bj][m][1] + bv[bj][1]; f32x4 y0, y1;
#pragma unroll
                    for (int e = 0; e < 4; ++e) { y0[e] = z0[e] * sigmoid_f(a0[e]); y1[e] = z1[e] * sigmoid_f(a1[e]); }
                    *(u32x4*)(Y + (size_t)row * 2048 + col0 + bj * HALF) = pack8(y0, y1); q += sumsq4(y0) + sumsq4(y1); }
                q += __shfl_xor(q, 16); q += __shfl_xor(q, 32);
                if (fq == 0) atomicAdd(ssout + row, q); }
    }
};

struct EpiPle {
    static constexpr bool PERM = true, AFTER_DRAIN = false, MID = false, PREF = false;
    const bf16_t* PP; const float* ss; bf16_t* E; float* ssout;
    __device__ __forceinline__ void mid(f32x4 (&)[2][2][4][2], const Unit&, int, int) const {}
    __device__ __forceinline__ void operator()(f32x4 (&acc)[2][2][4][2], const Unit& u, int wr, int wc, int fr, int fq) const {
        const int row0 = u.pm * BM + wr * 64 + fr, col0 = u.pn * BM + wc * 32 + 8 * fq;
        u32x4 pw[2][4][2];
#pragma unroll
        for (int ai = 0; ai < 2; ++ai)
#pragma unroll
            for (int m = 0; m < 4; ++m)
#pragma unroll
                for (int bj = 0; bj < 2; ++bj) pw[ai][m][bj] = *(const u32x4*)(PP + (size_t)(row0 + ai * HALF + m * 16) * 2048 + col0 + bj * HALF);
#pragma unroll
        for (int ai = 0; ai < 2; ++ai)
#pragma unroll
            for (int m = 0; m < 4; ++m) { const int row = row0 + ai * HALF + m * 16; const float r = rstd_of(ss[row], 1.0f / 2048.0f); float q = 0.f;
#pragma unroll
                for (int bj = 0; bj < 2; ++bj) { const u32x4 pb = pw[ai][m][bj];
                    const f32x4 p0 = {bf_lo(pb.x), bf_hi(pb.x), bf_lo(pb.y), bf_hi(pb.y)}, p1 = {bf_lo(pb.z), bf_hi(pb.z), bf_lo(pb.w), bf_hi(pb.w)};
                    const f32x4 a0 = acc[ai][bj][m][0] * r, a1 = acc[ai][bj][m][1] * r; f32x4 y0, y1;
#pragma unroll
                    for (int e = 0; e < 4; ++e) { y0[e] = p0[e] * sigmoid_f(a0[e]); y1[e] = p1[e] * sigmoid_f(a1[e]); }
                    *(u32x4*)(E + (size_t)row * 2048 + col0 + bj * HALF) = pack8(y0, y1); q += sumsq4(y0) + sumsq4(y1); }
                q += __shfl_xor(q, 16); q += __shfl_xor(q, 32);
                if (fq == 0) atomicAdd(ssout + row, q); }
    }
};

struct EpiPlain {
    static constexpr bool PERM = true, AFTER_DRAIN = false, MID = false, PREF = false;
    bf16_t* O; int ldo;
    __device__ __forceinline__ void mid(f32x4 (&)[2][2][4][2], const Unit&, int, int) const {}
    __device__ __forceinline__ void operator()(f32x4 (&acc)[2][2][4][2], const Unit& u, int wr, int wc, int fr, int fq) const {
        const int row0 = u.pm * BM + wr * 64 + fr, col0 = u.pn * BM + wc * 32 + 8 * fq;
#pragma unroll
        for (int ai = 0; ai < 2; ++ai)
#pragma unroll
            for (int m = 0; m < 4; ++m) { const int row = row0 + ai * HALF + m * 16;
#pragma unroll
                for (int bj = 0; bj < 2; ++bj) *(u32x4*)(O + (size_t)row * ldo + col0 + bj * HALF) = pack8(acc[ai][bj][m][0], acc[ai][bj][m][1]); }
    }
};
template <class Epi, class Sched, bool ALIGN_EPI = false, bool SP2 = false, bool ABLK = false, bool F8 = false>
__device__ __forceinline__ void gemm_phase(PG8_LAS unsigned char* lds, const Gemm g, const Sched& S, const Epi& E, const int wave_s) {
    unsigned ones_ = ~0u; asm volatile("" : "+s"(ones_));
    const int lane = (int)__builtin_amdgcn_mbcnt_hi(ones_, __builtin_amdgcn_mbcnt_lo(ones_, 0u)), wid = wave_s, tid = wid * 64 + lane, wr = wid >> 2, wc = wid & 3, fr = lane & 15, fq = lane >> 4;
    const int K = g.K, nt = g.KU / BK;
    unsigned voffA[2], voffB[2];
#pragma unroll
    for (int i = 0; i < 2; ++i) { int R, C; stage_rc(tid * 16 + i * 8192, R, C); const int Rb = Epi::PERM ? ((R & ~31) + perm32(R & 31)) : R;
        voffA[i] = ABLK ? (unsigned)(R * BK + C) * 2u : (unsigned)(R * K + C) * 2u; voffB[i] = (unsigned)(Rb * K + C) * 2u; }
    const size_t kstep = (size_t)(BK * 2);
    const size_t hstep = (size_t)HALF * K * 2;
    const size_t tstep = 2 * hstep;
    const size_t kstepA = ABLK ? (size_t)(BM * BK * 2) : kstep, hstepA = ABLK ? (size_t)(HALF * BK * 2) : hstep;
    const unsigned ldsw = (unsigned)wid * 1024u;
    const int aoff = lds_byte(wr * 64 + fr, fq * 8), boff = lds_byte(wc * 32 + fr, fq * 8);
#define PG8_SA(b, h) (((b) * 2 + (h)) * HTB)
#define PG8_SB(b, h) ((4 + (b) * 2 + (h)) * HTB)
#define PG8_STAGE(bufoff, gbase, voff) do { _Pragma("unroll") for (int _i = 0; _i < 2; ++_i) \
        { unsigned _vo = (voff)[_i]; asm volatile("" : "+v"(_vo));     \
        __builtin_amdgcn_global_load_lds((const unsigned*)((const char*)(gbase) + _vo), (PG8_LAS unsigned*)(lds + (bufoff) + ldsw + _i * 8192), 16, 0, 0); } } while (0)
#define PG8_LDA(dst, b, h) do { _Pragma("unroll") for (int m = 0; m < 4; ++m) _Pragma("unroll") for (int k = 0; k < 2; ++k) dst[m][k] = *(const PG8_LAS bf16x8*)(lds + PG8_SA(b, h) + aoff + m * 2048 + k * 1024); } while (0)
#define PG8_LDB(dst, b, h) do { _Pragma("unroll") for (int n = 0; n < 2; ++n) _Pragma("unroll") for (int k = 0; k < 2; ++k) dst[n][k] = *(const PG8_LAS bf16x8*)(lds + PG8_SB(b, h) + boff + n * 2048 + k * 1024); } while (0)
#define PG8_MMA(ai, bj, At, Bt) do { __builtin_amdgcn_s_setprio(1); if constexpr (F8) { _Pragma("unroll") for (int m = 0; m < 4; ++m) _Pragma("unroll") for (int n = 0; n < 2; ++n) \
        acc[ai][bj][m][n] = __builtin_amdgcn_mfma_scale_f32_16x16x128_f8f6f4(cat8(Bt[n][0], Bt[n][1]), cat8(At[m][0], At[m][1]), acc[ai][bj][m][n], 0, 0, 0, 0x7F7F7F7F, 0, 0x7F7F7F7F); } \
    else { _Pragma("unroll") for (int m = 0; m < 4; ++m) _Pragma("unroll") for (int n = 0; n < 2; ++n) _Pragma("unroll") for (int k = 0; k < 2; ++k) \
        acc[ai][bj][m][n] = __builtin_amdgcn_mfma_f32_16x16x32_bf16(Bt[n][k], At[m][k], acc[ai][bj][m][n], 0, 0, 0); } __builtin_amdgcn_s_setprio(0); } while (0)
#define PG8_WAIT_V(n) asm volatile("s_waitcnt vmcnt(" #n ")" ::: "memory")
#define PG8_WAIT_L(n) asm volatile("s_waitcnt lgkmcnt(" #n ")" ::: "memory")
#define PG8_BAR __builtin_amdgcn_s_barrier()
#define PG8_SCHED __builtin_amdgcn_sched_barrier(0)
    Unit cur, nxt; int ui = 0;
    if (!S.next(0, cur)) return;
    cur.par = 0;
    if constexpr (Epi::PREF) E.prefetch(cur, wid, lane);
    f32x4 acc[2][2][4][2];
#pragma unroll
    for (int a = 0; a < 2; ++a)
#pragma unroll
        for (int b = 0; b < 2; ++b)
#pragma unroll
            for (int m = 0; m < 4; ++m)
#pragma unroll
                for (int n = 0; n < 2; ++n) acc[a][b][m][n] = (f32x4){0.f, 0.f, 0.f, 0.f};
    bf16x8 At[4][2], B0[2][2], B1[2][2];
    const size_t khb = (size_t)g.KU * 2, khbA = ABLK ? (size_t)(g.KU / BK) * kstepA : khb; const char* cA = (const char*)g.A + (size_t)cur.pm * tstep + cur.kh * khbA; const char* cB = (const char*)g.Bt + (size_t)cur.pn * tstep + cur.kh * khb;
    S.a_ready(cur);
    if constexpr (SP2) {
        PG8_STAGE(PG8_SB(0, 0), cB, voffB); PG8_STAGE(PG8_SB(0, 1), cB + hstep, voffB); PG8_STAGE(PG8_SA(0, 0), cA, voffA); PG8_STAGE(PG8_SA(0, 1), cA + hstepA, voffA);
        if (wr == 1) PG8_BAR;
        PG8_WAIT_V(2); PG8_BAR;
        PG8_STAGE(PG8_SB(1, 0), cB + kstep, voffB); PG8_STAGE(PG8_SA(1, 0), cA + kstepA, voffA); PG8_STAGE(PG8_SB(1, 1), cB + hstep + kstep, voffB);
        PG8_WAIT_V(6); PG8_BAR;
    } else {
        PG8_STAGE(PG8_SB(0, 0), cB, voffB); PG8_STAGE(PG8_SA(0, 0), cA, voffA); PG8_STAGE(PG8_SB(0, 1), cB + hstep, voffB); PG8_STAGE(PG8_SA(0, 1), cA + hstepA, voffA);
        if (wr == 1) PG8_BAR;
        PG8_WAIT_V(4); PG8_BAR;
        PG8_STAGE(PG8_SB(1, 0), cB + kstep, voffB); PG8_STAGE(PG8_SA(1, 0), cA + kstepA, voffA); PG8_STAGE(PG8_SB(1, 1), cB + hstep + kstep, voffB);
        PG8_WAIT_V(6); PG8_BAR;
    }
    for (;;) {
        const bool has_next = S.next(ui + 1, nxt); nxt.par = (ui + 1) & 1;
        const char* nA = has_next ? (const char*)g.A + (size_t)nxt.pm * tstep + nxt.kh * khbA : cA; const char* nB = has_next ? (const char*)g.Bt + (size_t)nxt.pn * tstep + nxt.kh * khb : cB;
        for (int t = 0; t < nt; t += 2) {
            const bool last = (t == nt - 2);
            const char* a1 = cA + (size_t)(t + 1) * kstepA;
            const char* a2 = last ? nA : cA + (size_t)(t + 2) * kstepA; const char* b2 = last ? nB : cB + (size_t)(t + 2) * kstep;
            const char* a3 = a2 + kstepA; const char* b3 = b2 + kstep;
            if (last && has_next) { S.a_ready(nxt); if constexpr (Epi::PREF) E.prefetch(nxt, wid, lane); }
            if constexpr (SP2) {
            PG8_LDB(B0, 0, 0); PG8_LDB(B1, 0, 1); PG8_SCHED; PG8_LDA(At, 0, 0); PG8_STAGE(PG8_SA(1, 1), a1 + hstepA, voffA);
            PG8_WAIT_V(8); PG8_WAIT_L(0); PG8_BAR; PG8_MMA(0, 0, At, B0); PG8_MMA(0, 1, At, B1); PG8_BAR; PG8_SCHED;
            PG8_LDA(At, 0, 1); PG8_STAGE(PG8_SB(0, 0), b2, voffB); PG8_STAGE(PG8_SB(0, 1), b2 + hstep, voffB); PG8_STAGE(PG8_SA(0, 0), a2, voffA);
            PG8_WAIT_V(8); PG8_WAIT_L(0); PG8_BAR; PG8_MMA(1, 0, At, B0); PG8_MMA(1, 1, At, B1); PG8_BAR; PG8_SCHED;
            PG8_LDB(B0, 1, 0); PG8_LDB(B1, 1, 1); PG8_SCHED; PG8_LDA(At, 1, 0); PG8_STAGE(PG8_SA(0, 1), a2 + hstepA, voffA);
            PG8_WAIT_V(8); PG8_WAIT_L(0); PG8_BAR; PG8_MMA(0, 0, At, B0); PG8_MMA(0, 1, At, B1); PG8_BAR; PG8_SCHED;
            PG8_LDA(At, 1, 1); PG8_STAGE(PG8_SB(1, 0), b3, voffB); PG8_STAGE(PG8_SB(1, 1), b3 + hstep, voffB); PG8_STAGE(PG8_SA(1, 0), a3, voffA);
            PG8_WAIT_V(8); PG8_WAIT_L(0); PG8_BAR; PG8_MMA(1, 0, At, B0); PG8_MMA(1, 1, At, B1); PG8_BAR; PG8_SCHED;
            } else {
            PG8_LDB(B0, 0, 0); PG8_SCHED; PG8_LDA(At, 0, 0); PG8_STAGE(PG8_SA(1, 1), a1 + hstepA, voffA);
            PG8_WAIT_L(8); PG8_BAR; PG8_WAIT_L(0); PG8_MMA(0, 0, At, B0); PG8_BAR; PG8_SCHED;
            PG8_LDB(B1, 0, 1); PG8_STAGE(PG8_SB(0, 0), b2, voffB);
            PG8_BAR; PG8_WAIT_L(0); PG8_MMA(0, 1, At, B1); PG8_BAR;
            PG8_LDA(At, 0, 1); PG8_STAGE(PG8_SA(0, 0), a2, voffA);
            PG8_BAR; PG8_WAIT_L(0); PG8_MMA(1, 0, At, B0); PG8_BAR; PG8_SCHED;
            PG8_STAGE(PG8_SB(0, 1), b2 + hstep, voffB);
            PG8_WAIT_V(6); PG8_BAR; PG8_MMA(1, 1, At, B1); PG8_BAR;
            PG8_LDB(B0, 1, 0); PG8_SCHED; PG8_LDA(At, 1, 0); PG8_STAGE(PG8_SA(0, 1), a2 + hstepA, voffA);
            PG8_WAIT_L(8); PG8_BAR; PG8_WAIT_L(0); PG8_MMA(0, 0, At, B0); PG8_BAR; PG8_SCHED;
            PG8_LDB(B1, 1, 1); PG8_STAGE(PG8_SB(1, 0), b3, voffB);
            PG8_BAR; PG8_WAIT_L(0); PG8_MMA(0, 1, At, B1); PG8_BAR;
            PG8_LDA(At, 1, 1); PG8_STAGE(PG8_SA(1, 0), a3, voffA);
            PG8_BAR; PG8_WAIT_L(0); PG8_MMA(1, 0, At, B0); PG8_BAR; PG8_SCHED;
            PG8_STAGE(PG8_SB(1, 1), b3 + hstep, voffB);
            PG8_WAIT_V(6); PG8_BAR; PG8_MMA(1, 1, At, B1); PG8_BAR;
            }
        }
        if constexpr (ALIGN_EPI) { if (wr == 0) PG8_BAR; }
        if constexpr (!Epi::AFTER_DRAIN) { E(acc, cur, wr, wc, fr, fq); S.done(cur); }
        if (!has_next) break;
        if (!(Epi::MID && cur.kh == 0))
#pragma unroll
        for (int a = 0; a < 2; ++a)
#pragma unroll
            for (int b = 0; b < 2; ++b)
#pragma unroll
                for (int m = 0; m < 4; ++m)
#pragma unroll
                    for (int n = 0; n < 2; ++n) acc[a][b][m][n] = (f32x4){0.f, 0.f, 0.f, 0.f};
        cur = nxt; cA = nA; cB = nB; ++ui;
        if constexpr (ALIGN_EPI) { if (wr == 1) PG8_BAR; }
    }
    PG8_WAIT_V(0);
    if constexpr (!ALIGN_EPI) { if (wr == 0) PG8_BAR; }
    PG8_BAR;
    if constexpr (Epi::AFTER_DRAIN) { E.fused(acc, cur, wr, wc, fr, fq, lds, wid, lane); S.done(cur); }
#undef PG8_SA
#undef PG8_SB
#undef PG8_STAGE
#undef PG8_LDA
#undef PG8_LDB
#undef PG8_MMA
#undef PG8_WAIT_V
#undef PG8_WAIT_L
#undef PG8_BAR
#undef PG8_SCHED
}
}
constexpr int NWAVES = 8, NTHREADS = 512;
constexpr int DM = 2048, NB = 8, SEQ = 4096, MROWS = NB * SEQ, FF = 5632, PLE = 256;
constexpr int SSMW = 1024, NG = 64, GH = 16, NP = 64, SBW = 1024, NHEAD = 8, HD = 128, NIN = 4096;
constexpr size_t MiB = 1u << 20;
constexpr size_t WS_STAT = 0;
constexpr size_t WS_BAR = 960 * 1024;
constexpr int BAR_WORDS = 3456;
constexpr size_t WS_LAM8 = 1 * MiB;
constexpr size_t WS_SSMMAT = 2 * MiB;
constexpr size_t WS_WGU1 = 8 * MiB, WS_WD1 = 52 * MiB, WS_WIN = 74 * MiB, WS_WGLU = 90 * MiB, WS_WOUT = 92 * MiB, WS_WGU2 = 100 * MiB, WS_WD2 = 144 * MiB, WS_WPG = 166 * MiB, WS_WPP = 174 * MiB;
constexpr size_t WS_PB = 176 * MiB;
constexpr size_t WS_XB = 192 * MiB;
constexpr size_t WS_YMIX = 320 * MiB;
constexpr size_t WS_ACT = 448 * MiB;
constexpr size_t WS_UG = WS_ACT, WS_Q = WS_ACT + 64 * MiB, WS_K = WS_ACT + 128 * MiB, WS_V = WS_ACT + 192 * MiB, WS_Z = WS_ACT + 256 * MiB, WS_E = WS_ACT;
constexpr size_t WS_XB8 = 832 * MiB;
constexpr size_t WS_END = 896 * MiB;
enum { ST_SS1 = 0, ST_SS2, ST_SSM, ST_SB, ST_SS3, ST_SS4, ST_SSE, ST_N };
constexpr int RING_BYTES = 131072, XCH_OFF = RING_BYTES, LDS_BYTES = 147456;

#define GAS __attribute__((address_space(1)))
#define LAS __attribute__((address_space(3)))
typedef unsigned short bf16;
typedef unsigned v4u __attribute__((ext_vector_type(4)));
typedef unsigned v2u __attribute__((ext_vector_type(2)));
typedef float f32x4 __attribute__((ext_vector_type(4)));
typedef short bf16x8 __attribute__((ext_vector_type(8)));
#define LDS_WAIT() asm volatile("s_waitcnt lgkmcnt(0)" ::: "memory")
using pg8::cvt_pk_bf16;
__device__ __forceinline__ float wave_sum(float v) {
#pragma unroll
    for (int o = 1; o < 64; o <<= 1) v += __shfl_xor(v, o);
    return v;
}
__device__ __forceinline__ f32x4 mfma16(bf16x8 a, bf16x8 b, f32x4 c) { return __builtin_amdgcn_mfma_f32_16x16x32_bf16(a, b, c, 0, 0, 0); }

#ifndef MK_DUP
#define MK_DUP 0u
#endif
constexpr int P0_REP = 1 + (int)(MK_DUP & 1u), P4_REP = 1 + (int)((MK_DUP >> 4) & 1u);
__device__ __forceinline__ void tr_item(const float* W, int K, int N, const float* gain, bf16* WT, int k0, int n0, int dstrow, LAS float* scr, int lane, float f8s) {
    const int c4 = lane & 15, r0 = lane >> 4;
#pragma unroll 4
    for (int i = 0; i < 16; ++i) { const int kk = 4 * i + r0; f32x4 v = *(const GAS f32x4*)(W + (size_t)(k0 + kk) * N + n0 + 4 * c4); if (gain) v = v * gain[k0 + kk];
        *(LAS f32x4*)(scr + kk * 64 + 4 * (c4 ^ (2 * ((kk >> 3) & 7)))) = v; }
    LDS_WAIT(); asm volatile("" ::: "memory");
    const int c = lane & 7;
#pragma unroll
    for (int ps = 0; ps < 2; ++ps) { const int ng = (lane >> 3) + 8 * ps; f32x4 v[8];
#pragma unroll
        for (int j = 0; j < 8; ++j) v[j] = *(const LAS f32x4*)(scr + (8 * c + j) * 64 + 4 * (ng ^ (2 * c)));
#pragma unroll
        for (int i = 0; i < 4; ++i) {
            if (f8s != 0.f) { v2u o8; o8.x = pg8::pack4_fp8(v[0][i] * f8s, v[1][i] * f8s, v[2][i] * f8s, v[3][i] * f8s); o8.y = pg8::pack4_fp8(v[4][i] * f8s, v[5][i] * f8s, v[6][i] * f8s, v[7][i] * f8s);
                *(GAS v2u*)((GAS unsigned char*)WT + (size_t)(dstrow + 4 * ng + i) * K + k0 + 8 * c) = o8; continue; }
            v4u o; o.x = cvt_pk_bf16(v[0][i], v[1][i]); o.y = cvt_pk_bf16(v[2][i], v[3][i]); o.z = cvt_pk_bf16(v[4][i], v[5][i]); o.w = cvt_pk_bf16(v[6][i], v[7][i]);
            *(GAS v4u*)(WT + (size_t)(dstrow + 4 * ng + i) * K + k0 + 8 * c) = o; } }
    LDS_WAIT(); asm volatile("" ::: "memory");
}

struct In {
    const float *x, *p, *ffn1_norm, *ffn1_wg, *ffn1_wu, *ffn1_wd, *mix_norm, *w_in, *lam_re, *lam_im, *b_re, *b_im, *c_re, *c_im, *log_dt, *ssm_d, *w_glu, *b_glu, *q_norm, *k_norm,
        *on_ssm, *on_sb, *w_out, *ffn2_norm, *ffn2_wg, *ffn2_wu, *ffn2_wd, *ple_norm, *w_pg, *w_pp, *ple_post;
};

__device__ __forceinline__ void ssm_build(const In& in, unsigned char* ws, LAS unsigned char* lds, int g, int tid) {
    LAS float* PW = (LAS float*)lds;
    LAS float* CO = PW + 9 * 64 * 2;
    LAS float* CB = CO + 64 * 2;
    LAS float* KT = CB + 64 * 16 * 2;
    LAS float* CR = KT + 2048; LAS float* CI = CR + 1024;
    for (int i = tid; i < 1024; i += NTHREADS) { CR[i] = in.c_re[g * 1024 + i]; CI[i] = in.c_im[g * 1024 + i]; }
    if (tid < 64) {
        const int p = tid; const float dt = expf(in.log_dt[g]); const float lr = fminf(in.lam_re[g * 64 + p], -1e-4f), li = in.lam_im[g * 64 + p];
        const float a = lr * dt, th = li * dt; float s1, c1; sincosf(th, &s1, &c1); const float ea = expf(a);
        const float l1r = ea * c1, l1i = ea * s1;
        float pr = 1.f, pi = 0.f;
#pragma unroll
        for (int t = 0; t <= 8; ++t) { PW[(t * 64 + p) * 2] = pr; PW[(t * 64 + p) * 2 + 1] = pi; const float nr = pr * l1r - pi * l1i, ni = pr * l1i + pi * l1r; pr = nr; pi = ni; }
        float* l8 = (float*)(ws + WS_LAM8) + (g * 64 + p) * 2; l8[0] = PW[(8 * 64 + p) * 2]; l8[1] = PW[(8 * 64 + p) * 2 + 1];
        const float sh = sinf(0.5f * th); const float nr = expm1f(a) * c1 - 2.f * sh * sh, ni = l1i;
        const float den = 1.f / (lr * lr + li * li);
        CO[p * 2] = (nr * lr + ni * li) * den; CO[p * 2 + 1] = (ni * lr - nr * li) * den;
    }
    __syncthreads();
    for (int i = tid; i < 1024; i += NTHREADS) { const int p = i >> 4; const float br = in.b_re[g * 1024 + i], bi = in.b_im[g * 1024 + i], cr = CO[p * 2], ci = CO[p * 2 + 1];
        CB[i * 2] = cr * br - ci * bi; CB[i * 2 + 1] = cr * bi + ci * br; }
    __syncthreads();
    for (int i = tid; i < 2048; i += NTHREADS) { const int tau = i >> 8, h = (i >> 4) & 15, h2 = i & 15; float s = 0.f;
        for (int p = 0; p < 64; ++p) { const float cr = CR[h * 64 + p], ci = CI[h * 64 + p], pr = PW[(tau * 64 + p) * 2], pi = PW[(tau * 64 + p) * 2 + 1];
            const float wr = cr * pr - ci * pi, wi = cr * pi + ci * pr; s += wr * CB[(p * 16 + h2) * 2] - wi * CB[(p * 16 + h2) * 2 + 1]; }
        KT[i] = s; }
    __syncthreads();
    bf16* Ms = (bf16*)(ws + WS_SSMMAT) + (size_t)g * 3 * 16384; bf16* Mi = Ms + 16384; bf16* Mo = Mi + 16384;
    for (int i = tid; i < 16384; i += NTHREADS) { const int r = i >> 7, c = i & 127;
        { const int p = r & 63, s = c >> 4, h2 = c & 15; const float pr = PW[((7 - s) * 64 + p) * 2], pi = PW[((7 - s) * 64 + p) * 2 + 1], br = CB[(p * 16 + h2) * 2], bi = CB[(p * 16 + h2) * 2 + 1];
          const float v = (r < 64) ? (pr * br - pi * bi) : (pr * bi + pi * br); Ms[i] = (bf16)(cvt_pk_bf16(v, 0.f) & 0xffffu); }
        { const int t = r >> 4, h = r & 15, s = c >> 4, h2 = c & 15; float v = 0.f; if (s <= t) { v = KT[((t - s) * 16 + h) * 16 + h2]; if (r == c) v += in.ssm_d[g * 16 + h]; } Mi[i] = (bf16)(cvt_pk_bf16(v, 0.f) & 0xffffu); }
        { const int t = r >> 4, h = r & 15, p = c & 63; const float cr = CR[h * 64 + p], ci = CI[h * 64 + p], pr = PW[((t + 1) * 64 + p) * 2], pi = PW[((t + 1) * 64 + p) * 2 + 1];
          const float v = (c < 64) ? (cr * pr - ci * pi) : -(cr * pi + ci * pr); Mo[i] = (bf16)(cvt_pk_bf16(v, 0.f) & 0xffffu); }
    }
    __syncthreads();
}

__device__ __forceinline__ void p0_prologue(const In& in, float* out, unsigned char* ws, LAS unsigned char* lds, int tid, int lane, int wave) {
    const int G = gridDim.x, bx = blockIdx.x;
    if (bx == 0) { unsigned* bw = (unsigned*)(ws + WS_BAR); for (int i = tid; i < BAR_WORDS; i += NTHREADS) bw[i] = 0u; }
    for (int g = bx; g < NG; g += G) ssm_build(in, ws, lds, g, tid);
    { float* st = (float*)(ws + WS_STAT) + MROWS; for (int i = bx * NTHREADS + tid; i < (ST_N - 1) * MROWS; i += G * NTHREADS) st[i] = 0.f; }
    LAS float* scr = (LAS float*)(lds + wave * 16384);
    const int gw = bx * NWAVES + wave, NGW = G * NWAVES;
    constexpr int I_GU = (DM / 64) * (FF / 64), I_D = (FF / 64) * (DM / 64), I_IN = (DM / 64) * (NIN / 64), I_GLU = (SSMW / 64) * (SSMW / 64), I_SQ = (DM / 64) * (DM / 64), I_PP = (PLE / 64) * (DM / 64);
    constexpr int NITEMS = 4 * I_GU + 2 * I_D + I_IN + I_GLU + 2 * I_SQ + I_PP;
#define TR_ITEM(NI, Wp, Kd, Nd, gainp, dstoff, MODE, F8S) \
        if (r < (NI)) { const int nbk = (Nd) / 64, kb = r / nbk, nb = r % nbk, k0 = 64 * kb, n0 = 64 * nb; \
            const int dr = (MODE) == 0 ? n0 : (n0 / 128) * 256 + (n0 % 128) + ((MODE) == 2 ? 128 : 0); \
            tr_item((Wp), (Kd), (Nd), (gainp), (bf16*)(ws + (dstoff)), k0, n0, dr, scr, lane, (F8S)); continue; } r -= (NI);
    for (int it = gw; it < NITEMS * P0_REP; it += NGW) {
        int r = it % NITEMS;
        TR_ITEM(I_GU, in.ffn1_wg, DM, FF, in.ffn1_norm, WS_WGU1, 1, 0.f)
        TR_ITEM(I_GU, in.ffn1_wu, DM, FF, in.ffn1_norm, WS_WGU1, 2, 0.f)
        TR_ITEM(I_D, in.ffn1_wd, FF, DM, (const float*)nullptr, WS_WD1, 0, 0.f)
        TR_ITEM(I_IN, in.w_in, DM, NIN, in.mix_norm, WS_WIN, 0, 0.f)
        TR_ITEM(I_GLU, in.w_glu, SSMW, SSMW, (const float*)nullptr, WS_WGLU, 0, 0.f)
        TR_ITEM(I_SQ, in.w_out, DM, DM, (k0 < 1024 ? in.on_ssm : in.on_sb - 1024), WS_WOUT, 0, 0.f)
        TR_ITEM(I_GU, in.ffn2_wg, DM, FF, in.ffn2_norm, WS_WGU2, 1, pg8::F8_W_SCALE)
        TR_ITEM(I_GU, in.ffn2_wu, DM, FF, in.ffn2_norm, WS_WGU2, 2, pg8::F8_W_SCALE)
        TR_ITEM(I_D, in.ffn2_wd, FF, DM, (const float*)nullptr, WS_WD2, 0, 0.f)
        TR_ITEM(I_SQ, in.w_pg, DM, DM, in.ple_norm, WS_WPG, 0, 0.f)
        TR_ITEM(I_PP, in.w_pp, PLE, DM, (const float*)nullptr, WS_WPP, 0, 0.f)
    }
#undef TR_ITEM
    { bf16* XB = (bf16*)(ws + WS_XB); float* ss1 = (float*)(ws + WS_STAT) + ST_SS1 * MROWS;
      for (int mm = gw; mm < MROWS * P0_REP; mm += NGW) { const int m = mm % MROWS; const GAS f32x4* xr = (const GAS f32x4*)(in.x + (size_t)m * DM) + lane; GAS v2u* o = (GAS v2u*)(XB + (size_t)m * DM) + lane; float s = 0.f;
#pragma unroll
          for (int j = 0; j < 8; ++j) { const f32x4 v = xr[64 * j]; s += (v.x * v.x + v.y * v.y) + (v.z * v.z + v.w * v.w); v2u w; w.x = cvt_pk_bf16(v.x, v.y); w.y = cvt_pk_bf16(v.z, v.w); o[64 * j] = w; }
          s = wave_sum(s); if (lane == 0) ss1[m] = s; } }
    { const GAS f32x4* ps = (const GAS f32x4*)in.p; GAS v2u* o = (GAS v2u*)(ws + WS_PB);
      for (int i = bx * NTHREADS + tid; i < MROWS * PLE / 4; i += G * NTHREADS) { const f32x4 v = ps[i]; v2u w; w.x = cvt_pk_bf16(v.x, v.y); w.y = cvt_pk_bf16(v.z, v.w); o[i] = w; } }
}

constexpr int SSM_DROW = 132, SSM_SROW = 136;
constexpr int SSM_SUB = 64 * SSM_DROW * 4 + 64 * SSM_SROW * 2;
static_assert(2 * SSM_SUB <= RING_BYTES, "S5 LDS");
__device__ __forceinline__ void ssm_unit(unsigned char* ws, LAS unsigned char* lds, int b, int g0, int lane, int wave) {
    const int r16 = lane & 15, q4 = lane >> 4, sub = wave >> 2, w4 = wave & 3, g = g0 + sub;
    LAS float* DL = (LAS float*)(lds + sub * SSM_SUB); LAS bf16* S0 = (LAS bf16*)(lds + sub * SSM_SUB + 64 * SSM_DROW * 4);
    const bf16* Ms = (const bf16*)(ws + WS_SSMMAT) + (size_t)g * 3 * 16384; const bf16* Mi = Ms + 16384; const bf16* Mo = Mi + 16384;
    bf16x8 aS[2][4], aI[2][4];
#pragma unroll
    for (int ct = 0; ct < 2; ++ct)
#pragma unroll
        for (int ks = 0; ks < 4; ++ks) { const int o = (32 * w4 + 16 * ct + r16) * 128 + 32 * ks + 8 * q4; aS[ct][ks] = *(const bf16x8*)(Ms + o); aI[ct][ks] = *(const bf16x8*)(Mi + o); }
    const bf16* ug = (const bf16*)(ws + WS_UG) + (size_t)(b * 64 + g) * 4096 * 16;
    bf16* zb = (bf16*)(ws + WS_Z) + (size_t)b * 4096 * 1024 + g * 16;
    const float* l8 = (const float*)(ws + WS_LAM8) + (g * 64 + lane) * 2; const float l8r = l8[0], l8i = l8[1];
    float sre = 0.f, sim = 0.f;
    bf16x8 bu[4][4];
#define SSM_LOADU(SEG) do { _Pragma("unroll") for (int nt = 0; nt < 4; ++nt) { const int n = 64 * (SEG) + 16 * nt + r16; _Pragma("unroll") for (int ks = 0; ks < 4; ++ks) \
        bu[nt][ks] = *(const bf16x8*)(ug + (size_t)(n * 8 + 2 * ks + (q4 >> 1)) * 16 + 8 * (q4 & 1)); } } while (0)
    SSM_LOADU(0);
    for (int seg = 0; seg < 8; ++seg) {
        f32x4 ay[4][2];
#pragma unroll
        for (int nt = 0; nt < 4; ++nt)
#pragma unroll
            for (int ct = 0; ct < 2; ++ct) { f32x4 acc = {0.f, 0.f, 0.f, 0.f}, accy = {0.f, 0.f, 0.f, 0.f};
#pragma unroll
                for (int ks = 0; ks < 4; ++ks) { acc = mfma16(aS[ct][ks], bu[nt][ks], acc); accy = mfma16(aI[ct][ks], bu[nt][ks], accy); }
                *(LAS f32x4*)(DL + (16 * nt + r16) * SSM_DROW + 32 * w4 + 16 * ct + 4 * q4) = acc; ay[nt][ct] = accy; }
        if (seg < 7) SSM_LOADU(seg + 1);
        __syncthreads();
        if (w4 == 0) {
            for (int nb = 0; nb < 64; nb += 8) { float dr[8], di[8];
#pragma unroll
                for (int j = 0; j < 8; ++j) { dr[j] = DL[(nb + j) * SSM_DROW + lane]; di[j] = DL[(nb + j) * SSM_DROW + 64 + lane]; }
#pragma unroll
                for (int j = 0; j < 8; ++j) { S0[(nb + j) * SSM_SROW + lane] = (bf16)(cvt_pk_bf16(sre, 0.f) & 0xffffu); S0[(nb + j) * SSM_SROW + 64 + lane] = (bf16)(cvt_pk_bf16(sim, 0.f) & 0xffffu);
                    const float nr = l8r * sre - l8i * sim + dr[j], ni = l8r * sim + l8i * sre + di[j]; sre = nr; sim = ni; } }
        }
        bf16x8 aO[2][4];
#pragma unroll
        for (int ct = 0; ct < 2; ++ct)
#pragma unroll
            for (int ks = 0; ks < 4; ++ks) aO[ct][ks] = *(const bf16x8*)(Mo + (32 * w4 + 16 * ct + r16) * 128 + 32 * ks + 8 * q4);
        __syncthreads();
#pragma unroll
        for (int nt = 0; nt < 4; ++nt) { const int n = 64 * seg + 16 * nt + r16; bf16x8 bs[4];
#pragma unroll
            for (int ks = 0; ks < 4; ++ks) bs[ks] = *(const LAS bf16x8*)(S0 + (16 * nt + r16) * SSM_SROW + 32 * ks + 8 * q4);
#pragma unroll
            for (int ct = 0; ct < 2; ++ct) { f32x4 acc = ay[nt][ct];
#pragma unroll
                for (int ks = 0; ks < 4; ++ks) acc = mfma16(aO[ct][ks], bs[ks], acc);
                f32x4 z;
#pragma unroll
                for (int e = 0; e < 4; ++e) { const float y = acc[e]; const float t = 1.5957691216057308f * (y + 0.044715f * y * y * y); z[e] = y * __builtin_amdgcn_rcpf(1.0f + __builtin_amdgcn_exp2f(-1.4426950408889634f * t)); }
                v2u w; w.x = cvt_pk_bf16(z[0], z[1]); w.y = cvt_pk_bf16(z[2], z[3]);
                *(v2u*)(zb + (size_t)(n * 8 + 2 * w4 + ct) * 1024 + 4 * q4) = w; } }
    }
#undef SSM_LOADU
    __syncthreads();
}

constexpr int AT_KROW = 136, AT_VROW = 152, AT_SROW = 68, AT_PROW = 72;
constexpr int AT_KB = 64 * AT_KROW * 2, AT_VB = 64 * AT_VROW * 2, AT_BUF = AT_KB + AT_VB;
constexpr int AT_S_OFF = 2 * AT_BUF, AT_P_OFF = AT_S_OFF + 8 * 16 * AT_SROW * 4, AT_FLAG_OFF = AT_P_OFF + 8 * 16 * AT_PROW * 2;
static_assert(AT_FLAG_OFF + 64 <= RING_BYTES, "attention LDS");
constexpr float AT_THR = -152.0f;
typedef short s16x4 __attribute__((ext_vector_type(4)));
__device__ __forceinline__ s16x4 lds_tr(const LAS bf16* p) { return __builtin_bit_cast(s16x4, __builtin_amdgcn_ds_read_tr16_b64_v4i16((LAS s16x4*)p)); }
__device__ __forceinline__ void attn_unit(unsigned char* ws, LAS unsigned char* lds, int b, int h, int qb, int tid, int lane, int wave, bool do_ss) {
    const int r16 = lane & 15, q4 = lane >> 4;
    LAS float* Sw = (LAS float*)(lds + AT_S_OFF) + wave * 16 * AT_SROW; LAS bf16* Pw = (LAS bf16*)(lds + AT_P_OFF) + wave * 16 * AT_PROW;
    volatile LAS unsigned* flag = (volatile LAS unsigned*)(lds + AT_FLAG_OFF);
    const bf16* Qg = (const bf16*)(ws + WS_Q) + (size_t)b * SEQ * 1024 + h * 128;
    const bf16* Kg = (const bf16*)(ws + WS_K) + (size_t)b * SEQ * 1024 + h * 128;
    const bf16* Vg = (const bf16*)(ws + WS_V) + (size_t)b * SEQ * 1024 + h * 128;
    const int qw0 = 128 * qb + 16 * wave, qrow = qw0 + r16;
    bf16x8 qf[4];
#pragma unroll
    for (int ks = 0; ks < 4; ++ks) qf[ks] = *(const bf16x8*)(Qg + (size_t)qrow * 1024 + 32 * ks + 8 * q4);
    f32x4 o[8];
#pragma unroll
    for (int i = 0; i < 8; ++i) o[i] = (f32x4){0.f, 0.f, 0.f, 0.f};
    float carry = 0.f; bool done = false;
    const int pr0 = tid >> 4, pc = tid & 15;
    v4u kr[2], vr[2];
    int kt = 2 * qb + 1, buf = 0, it = 0;
#define AT_LOAD(KT) do { _Pragma("unroll") for (int i = 0; i < 2; ++i) { const size_t go = (size_t)(64 * (KT) + pr0 + 32 * i) * 1024 + 8 * pc; kr[i] = *(const v4u*)(Kg + go); vr[i] = *(const v4u*)(Vg + go); } } while (0)
#define AT_STAGE(B) do { _Pragma("unroll") for (int i = 0; i < 2; ++i) { const int row = pr0 + 32 * i; *(LAS v4u*)((LAS bf16*)(lds + (B) * AT_BUF) + row * AT_KROW + 8 * pc) = kr[i]; \
        *(LAS v4u*)((LAS bf16*)(lds + (B) * AT_BUF + AT_KB) + row * AT_VROW + 8 * pc) = vr[i]; } } while (0)
    AT_LOAD(kt); AT_STAGE(0);
    if (kt > 0) AT_LOAD(kt - 1);
    __syncthreads();
    for (;;) {
        const LAS bf16* Ks = (const LAS bf16*)(lds + buf * AT_BUF); const LAS bf16* Vs = (const LAS bf16*)(lds + buf * AT_BUF + AT_KB);
        const int j0 = 64 * kt;
        if (!done && j0 < qw0 + 15) {
            f32x4 sc[4];
            {   bf16x8 ak[2][4];
#pragma unroll
                for (int ks = 0; ks < 4; ++ks) ak[0][ks] = *(const LAS bf16x8*)(Ks + r16 * AT_KROW + 32 * ks + 8 * q4);
#pragma unroll
                for (int t4 = 0; t4 < 4; ++t4) {
                    if (t4 < 3) {
#pragma unroll
                        for (int ks = 0; ks < 4; ++ks) ak[(t4 + 1) & 1][ks] = *(const LAS bf16x8*)(Ks + (16 * (t4 + 1) + r16) * AT_KROW + 32 * ks + 8 * q4); }
                    __builtin_amdgcn_sched_barrier(0);
                    f32x4 acc = {0.f, 0.f, 0.f, 0.f};
#pragma unroll
                    for (int ks = 0; ks < 4; ++ks) acc = mfma16(ak[t4 & 1][ks], qf[ks], acc);
                    sc[t4] = acc;
                    __builtin_amdgcn_sched_barrier(0); } }
            float lk[4][4], ls[4][4], rs[4];
#pragma unroll
            for (int t4 = 0; t4 < 4; ++t4) { float r = 0.f;
#pragma unroll
                for (int e = 0; e < 4; ++e) { const float z2 = sc[t4][e]; const float az = __builtin_fabsf(z2); const float ex = __builtin_amdgcn_exp2f(-az); const float sp = fmaxf(z2, 0.f) + __builtin_amdgcn_logf(1.0f + ex);
                    const bool valid = (j0 + 16 * t4 + 4 * q4 + e) < qrow; lk[t4][e] = valid ? -sp : 0.f; ls[t4][e] = valid ? (z2 - sp) : -1.0e30f; r += lk[t4][e]; }
                rs[t4] = r; }
            float offq[4], tot = 0.f;
#pragma unroll
            for (int t4 = 3; t4 >= 0; --t4) { const float r0 = __shfl(rs[t4], r16), r1 = __shfl(rs[t4], r16 + 16), r2 = __shfl(rs[t4], r16 + 32), r3 = __shfl(rs[t4], r16 + 48);
                offq[t4] = tot + (q4 < 1 ? r1 : 0.f) + (q4 < 2 ? r2 : 0.f) + (q4 < 3 ? r3 : 0.f); tot += (r0 + r1) + (r2 + r3); }
            float wv[4][4];
#pragma unroll
            for (int t4 = 0; t4 < 4; ++t4) { float run = carry + offq[t4];
#pragma unroll
                for (int e = 3; e >= 0; --e) { wv[t4][e] = __builtin_amdgcn_exp2f(ls[t4][e] + run); run += lk[t4][e]; } }
            carry += tot;
            bf16x8 bp[2];
#pragma unroll
            for (int ks = 0; ks < 2; ++ks) { v4u pk; pk.x = cvt_pk_bf16(wv[2 * ks][0], wv[2 * ks][1]); pk.y = cvt_pk_bf16(wv[2 * ks][2], wv[2 * ks][3]); pk.z = cvt_pk_bf16(wv[2 * ks + 1][0], wv[2 * ks + 1][1]); pk.w = cvt_pk_bf16(wv[2 * ks + 1][2], wv[2 * ks + 1][3]);
                bp[ks] = __builtin_bit_cast(bf16x8, pk); }
            const LAS bf16* vb = Vs + (4 * q4 + (r16 >> 2)) * AT_VROW + 4 * (r16 & 3);
            {   s16x4 vlo[2][2], vhi[2][2];
#pragma unroll
                for (int ks = 0; ks < 2; ++ks) { vlo[0][ks] = lds_tr(vb + 32 * ks * AT_VROW); vhi[0][ks] = lds_tr(vb + (32 * ks + 16) * AT_VROW); }
#pragma unroll
                for (int dt = 0; dt < 8; ++dt) {
                    if (dt < 7) {
#pragma unroll
                        for (int ks = 0; ks < 2; ++ks) { vlo[(dt + 1) & 1][ks] = lds_tr(vb + 32 * ks * AT_VROW + 16 * (dt + 1)); vhi[(dt + 1) & 1][ks] = lds_tr(vb + (32 * ks + 16) * AT_VROW + 16 * (dt + 1)); } }
                    __builtin_amdgcn_sched_barrier(0);
#pragma unroll
                    for (int ks = 0; ks < 2; ++ks) { const bf16x8 av = __builtin_shufflevector(vlo[dt & 1][ks], vhi[dt & 1][ks], 0, 1, 2, 3, 4, 5, 6, 7); o[dt] = mfma16(av, bp[ks], o[dt]); }
                    __builtin_amdgcn_sched_barrier(0); } }
            done = __all(carry < AT_THR);
        }
        if (kt > 0) { AT_STAGE(buf ^ 1); if (kt > 1) AT_LOAD(kt - 2); }
        if (lane == 0) flag[(it & 1) * 8 + wave] = (!done && kt > 0) ? 1u : 0u;
        __syncthreads();
        unsigned any = 0;
#pragma unroll
        for (int i = 0; i < 8; ++i) any |= flag[(it & 1) * 8 + i];
        if (!any) break;
        --kt; buf ^= 1; ++it;
    }
#undef AT_LOAD
#undef AT_STAGE
    bf16* Y = (bf16*)(ws + WS_YMIX) + (size_t)(b * SEQ + qrow) * 2048 + 1024 + h * 128 + 4 * q4;
    float q = 0.f;
#pragma unroll
    for (int dt = 0; dt < 8; ++dt) { v2u w; w.x = cvt_pk_bf16(o[dt][0], o[dt][1]); w.y = cvt_pk_bf16(o[dt][2], o[dt][3]); *(v2u*)(Y + 16 * dt) = w; q += (o[dt][0] * o[dt][0] + o[dt][1] * o[dt][1]) + (o[dt][2] * o[dt][2] + o[dt][3] * o[dt][3]); }
    q += __shfl_xor(q, 16); q += __shfl_xor(q, 32);
    if (q4 == 0 && do_ss) atomicAdd((float*)(ws + WS_STAT) + ST_SB * MROWS + b * SEQ + qrow, q);
    __syncthreads();
}

#define XB_TMO      128
#define XB_XCNT(j)  (256  + 64 * (j))
#define XB_XSUB(j)  (1280 + 64 * (j))
#define XB_XGEN(j)  (2304 + 64 * (j))
#define XB_TOP      3328
#define XB_TOPGEN   3392
#define XCD_BAR_WORDS 3456
#define XB_SPIN_CAP (1u << 18)

__device__ __forceinline__ unsigned xb_ld(unsigned* p)              { return __hip_atomic_load(p, __ATOMIC_RELAXED, __HIP_MEMORY_SCOPE_AGENT); }
__device__ __forceinline__ unsigned xb_add(unsigned* p, unsigned v) { return __hip_atomic_fetch_add(p, v, __ATOMIC_RELAXED, __HIP_MEMORY_SCOPE_AGENT); }
__device__ __forceinline__ unsigned xb_xcc_id() { return (unsigned)__builtin_amdgcn_s_getreg((3 << 11) | 20) & 0xFu; }
#define XB_SPIN(cond, bar) do { unsigned _sp = 0; while (cond) { __builtin_amdgcn_s_sleep(1); \
    if ((++_sp & 255u) == 0u) { if (xb_ld(&(bar)[XB_TMO])) break; if (_sp > XB_SPIN_CAP) { atomicAdd(&(bar)[XB_TMO], 1u); break; } } } } while (0)

struct XcdBarrier {
    unsigned* bar; unsigned x;
    volatile LAS unsigned* st;
};

__device__ __forceinline__ XcdBarrier xcd_barrier_post(unsigned* bar, volatile LAS unsigned* st) {
    XcdBarrier b; b.bar = bar; b.x = xb_xcc_id(); b.st = st;
    if (threadIdx.x == 0) (void)xb_add(&bar[XB_XCNT(b.x)], 1u);
    return b;
}
__device__ __forceinline__ void xcd_barrier_complete(unsigned* bar, unsigned x, unsigned& nloc, unsigned& nx) {
    const unsigned G = gridDim.x * gridDim.y * gridDim.z;
    unsigned sum, cnt, mine, sp = 0u;
    for (;;) {
        sum = 0u; cnt = 0u; mine = 0u;
#pragma unroll
        for (unsigned j = 0; j < 16; ++j) { const unsigned c = xb_ld(&bar[XB_XCNT(j)]); sum += c; cnt += (c > 0u) ? 1u : 0u; mine = (j == x) ? c : mine; }
        if (sum == G) break;
        __builtin_amdgcn_s_sleep(1);
        if ((++sp & 255u) == 0u) { if (xb_ld(&bar[XB_TMO])) break; if (sp > XB_SPIN_CAP) { atomicAdd(&bar[XB_TMO], 1u); break; } }
    }
    nloc = mine > 0u ? mine : 1u; nx = cnt > 0u ? cnt : 1u;
}

__device__ __forceinline__ void xcd_barrier(const XcdBarrier& b) {
    asm volatile("s_waitcnt vmcnt(0)" ::: "memory");
    __syncthreads();
    if (threadIdx.x == 0) {
        unsigned* bar = b.bar;
        __builtin_amdgcn_s_waitcnt(0);
        unsigned nloc = b.st[0], nx = b.st[1];
        if (nloc == 0u) { xcd_barrier_complete(bar, b.x, nloc, nx); b.st[0] = nloc; b.st[1] = nx; }
        const unsigned old = xb_add(&bar[XB_XSUB(b.x)], 1u);
        const unsigned gen = old / nloc;
        if (old + 1u == (gen + 1u) * nloc) {
            __builtin_amdgcn_fence(__ATOMIC_RELEASE, "agent");
            asm volatile("s_waitcnt vmcnt(0)" ::: "memory");
            const unsigned og = xb_add(&bar[XB_TOP], 1u);
            const unsigned tg = og / nx;
            if (og + 1u == (tg + 1u) * nx) xb_add(&bar[XB_TOPGEN], 1u);
            else XB_SPIN(xb_ld(&bar[XB_TOPGEN]) == tg, bar);
            __builtin_amdgcn_fence(__ATOMIC_ACQUIRE, "agent");
            xb_add(&bar[XB_XGEN(b.x)], 1u);
            asm volatile("s_waitcnt vmcnt(0)" ::: "memory");
        } else {
            XB_SPIN(xb_ld(&bar[XB_XGEN(b.x)]) == gen, bar);
            __builtin_amdgcn_fence(__ATOMIC_ACQUIRE, "agent");
            asm volatile("s_waitcnt vmcnt(0)" ::: "memory");
        }
    }
    __syncthreads();
}

static_assert(BAR_WORDS == XCD_BAR_WORDS, "barrier words");
struct Args { const float* in[31]; float* out; unsigned char* ws; };
#ifndef MK_PHASE_MASK
#define MK_PHASE_MASK 0xFFFFFFFFu
#endif
__global__ void __launch_bounds__(NTHREADS, 2) mk_fwd(Args args) {
    extern __shared__ __attribute__((aligned(16))) unsigned char lds_raw[];
    LAS unsigned char* lds = (LAS unsigned char*)lds_raw;
    cg::grid_group grid = cg::this_grid();
    volatile LAS unsigned* bar_st = (volatile LAS unsigned*)(lds + XCH_OFF + 12288);
    if (threadIdx.x < 2) bar_st[threadIdx.x] = 0u;
    __syncthreads();
    const int wave_s = __builtin_amdgcn_readfirstlane(threadIdx.x >> 6);
#define FRESH_IDS unsigned ones_ = ~0u; asm volatile("" : "+s"(ones_)); const int lane = (int)__builtin_amdgcn_mbcnt_hi(ones_, __builtin_amdgcn_mbcnt_lo(ones_, 0u)), wave = wave_s, tid = wave * 64 + lane; (void)tid; (void)lane; (void)wave;
    const int G = gridDim.x, bx = blockIdx.x;
    unsigned char* ws = args.ws; float* out = args.out;
    In in;
    in.x = args.in[0]; in.p = args.in[1]; in.ffn1_norm = args.in[2]; in.ffn1_wg = args.in[3]; in.ffn1_wu = args.in[4]; in.ffn1_wd = args.in[5]; in.mix_norm = args.in[6]; in.w_in = args.in[7];
    in.lam_re = args.in[8]; in.lam_im = args.in[9]; in.b_re = args.in[10]; in.b_im = args.in[11]; in.c_re = args.in[12]; in.c_im = args.in[13]; in.log_dt = args.in[14]; in.ssm_d = args.in[15];
    in.w_glu = args.in[16]; in.b_glu = args.in[17]; in.q_norm = args.in[18]; in.k_norm = args.in[19]; in.on_ssm = args.in[20]; in.on_sb = args.in[21]; in.w_out = args.in[22];
    in.ffn2_norm = args.in[23]; in.ffn2_wg = args.in[24]; in.ffn2_wu = args.in[25]; in.ffn2_wd = args.in[26]; in.ple_norm = args.in[27]; in.w_pg = args.in[28]; in.w_pp = args.in[29]; in.ple_post = args.in[30];
    float* stat = (float*)(ws + WS_STAT);
    bf16* XB = (bf16*)(ws + WS_XB); bf16* ACT = (bf16*)(ws + WS_ACT); bf16* YMIX = (bf16*)(ws + WS_YMIX);
#define PH(k) ((MK_PHASE_MASK >> (k)) & 1u)
#ifndef MK_DUP
#define MK_DUP 0u
#endif
#define NREP(k) (1 + (int)((MK_DUP >> (k)) & 1u))

    { FRESH_IDS p0_prologue(in, out, ws, lds, tid, lane, wave); }
    grid.sync();
    const XcdBarrier xbar = xcd_barrier_post((unsigned*)(ws + WS_BAR), bar_st);
    for (int rep_ = 0; rep_ < NREP(1); ++rep_) { pg8::Gemm g{XB, (const bf16*)(ws + WS_WGU1), MROWS, 2 * FF, DM, DM}; pg8::StaticOrder S; S.init(MROWS, 2 * FF, G, bx);
        pg8::EpiSwiGLU<false> E{ACT, stat + ST_SS1 * MROWS, FF, (LAS float*)(lds + XCH_OFF), 1.0f}; pg8::gemm_phase<pg8::EpiSwiGLU<false>, pg8::StaticOrder, true, true>(lds, g, S, E, wave_s); }
    xcd_barrier(xbar);
    for (int rep_ = 0; rep_ < NREP(2); ++rep_) { pg8::Gemm g{ACT, (const bf16*)(ws + WS_WD1), MROWS, DM, FF, FF}; pg8::StaticOrder S; S.init(MROWS, DM, G, bx);
        pg8::EpiResid<0, false> E{nullptr, XB, (rep_ + 1 < NREP(2)) ? nullptr : stat + ST_SS2 * MROWS, nullptr, nullptr, nullptr, 0.5f}; pg8::gemm_phase<pg8::EpiResid<0, false>, pg8::StaticOrder, true, true, true>(lds, g, S, E, wave_s); }
    xcd_barrier(xbar);
    for (int rep_ = 0; rep_ < NREP(3); ++rep_) { pg8::Gemm g{XB, (const bf16*)(ws + WS_WIN), MROWS, NIN, DM, DM}; pg8::StaticOrder S; S.init(MROWS, NIN, G, bx);
        pg8::EpiWin E{stat + ST_SS2 * MROWS, (bf16*)(ws + WS_UG), (bf16*)(ws + WS_Q), (bf16*)(ws + WS_K), (bf16*)(ws + WS_V), in.q_norm, in.k_norm, (LAS float*)(lds + XCH_OFF)};
        pg8::gemm_phase<pg8::EpiWin, pg8::StaticOrder, true, true>(lds, g, S, E, wave_s); }
    xcd_barrier(xbar);
    { FRESH_IDS
        for (int itt = bx; itt < (256 + 2048) * P4_REP; itt += G) { const int it = itt % (256 + 2048);
            unsigned o2_ = ~0u; asm volatile("" : "+s"(o2_)); const int lane2 = (int)__builtin_amdgcn_mbcnt_hi(o2_, __builtin_amdgcn_mbcnt_lo(o2_, 0u)), tid2 = wave * 64 + lane2;
            if (it < 256) ssm_unit(ws, lds, it >> 5, 2 * (it & 31), lane2, wave);
            else { const int a = it - 256; attn_unit(ws, lds, a >> 8, (a >> 5) & 7, a & 31, tid2, lane2, wave, itt >= (256 + 2048) * (P4_REP - 1)); }
        }
    }
    xcd_barrier(xbar);
    if (PH(5)) { pg8::Gemm g{(const bf16*)(ws + WS_Z), (const bf16*)(ws + WS_WGLU), MROWS, SSMW, SSMW, SSMW}; pg8::StaticOrder S; S.init(MROWS, SSMW, G, bx);
        pg8::EpiGlu E{(const bf16*)(ws + WS_Z), in.b_glu, YMIX, stat + ST_SSM * MROWS}; pg8::gemm_phase<pg8::EpiGlu, pg8::StaticOrder, true, true>(lds, g, S, E, wave_s); }
    xcd_barrier(xbar);
    if (PH(6)) { pg8::Gemm g{YMIX, (const bf16*)(ws + WS_WOUT), MROWS, DM, DM, DM / 2}; pg8::SplitOrder S; S.base.init(MROWS, DM, G, bx);
        pg8::EpiResid<1, false, false, true> E{nullptr, XB, stat + ST_SS3 * MROWS, stat + ST_SSM * MROWS, stat + ST_SB * MROWS, ws + WS_XB8, 0.f}; pg8::gemm_phase<pg8::EpiResid<1, false, false, true>, pg8::SplitOrder, true, true>(lds, g, S, E, wave_s); }
    xcd_barrier(xbar);
    if (PH(7)) { pg8::Gemm g{(const bf16*)(ws + WS_XB8), (const bf16*)(ws + WS_WGU2), MROWS, 2 * FF, DM / 2, DM / 2}; pg8::StaticOrder S; S.init(MROWS, 2 * FF, G, bx);
        pg8::EpiSwiGLU<false, true> E{ACT, stat + ST_SS3 * MROWS, FF, (LAS float*)(lds + XCH_OFF), 1.0f / (pg8::F8_X_SCALE * pg8::F8_W_SCALE)}; pg8::gemm_phase<pg8::EpiSwiGLU<false, true>, pg8::StaticOrder, true, true, false, true>(lds, g, S, E, wave_s); }
    xcd_barrier(xbar);
    if (PH(8)) { pg8::Gemm g{ACT, (const bf16*)(ws + WS_WD2), MROWS, DM, FF, FF}; pg8::StaticOrder S; S.init(MROWS, DM, G, bx);
        pg8::EpiResid<0, false> E{nullptr, XB, stat + ST_SS4 * MROWS, nullptr, nullptr, nullptr, 0.5f}; pg8::gemm_phase<pg8::EpiResid<0, false>, pg8::StaticOrder, true, true, true>(lds, g, S, E, wave_s); }
    xcd_barrier(xbar);
    if (PH(9)) { pg8::Gemm g{(const bf16*)(ws + WS_PB), (const bf16*)(ws + WS_WPP), MROWS, DM, PLE, PLE}; pg8::StaticOrder S; S.init(MROWS, DM, G, bx);
        pg8::EpiPlain E{YMIX, DM}; pg8::gemm_phase<pg8::EpiPlain, pg8::StaticOrder, true, true>(lds, g, S, E, wave_s); }
    asm volatile("s_waitcnt vmcnt(0)" ::: "memory"); __syncthreads();
    if (PH(10)) { pg8::Gemm g{XB, (const bf16*)(ws + WS_WPG), MROWS, DM, DM, DM}; pg8::StaticOrder S; S.init(MROWS, DM, G, bx);
        pg8::EpiPle E{YMIX, stat + ST_SS4 * MROWS, (bf16*)(ws + WS_E), stat + ST_SSE * MROWS}; pg8::gemm_phase<pg8::EpiPle, pg8::StaticOrder, true, true>(lds, g, S, E, wave_s); }
    xcd_barrier(xbar);
    if (PH(11)) { FRESH_IDS const bf16* E = (const bf16*)(ws + WS_E); const float* sse = stat + ST_SSE * MROWS; const int gw = bx * NWAVES + wave, NGW = G * NWAVES;
        for (int m = gw; m < MROWS; m += NGW) { const float r = pg8::rstd_of(sse[m], 1.0f / 2048.0f); GAS f32x4* xr = (GAS f32x4*)(out + (size_t)m * DM) + lane; const GAS v2u* xbr = (const GAS v2u*)(XB + (size_t)m * DM) + lane; const GAS v2u* er = (const GAS v2u*)(E + (size_t)m * DM) + lane;
            const GAS f32x4* gp = (const GAS f32x4*)in.ple_post + lane;
#pragma unroll
            for (int j = 0; j < 8; ++j) { const v2u xw = xbr[64 * j]; const v2u w = er[64 * j]; const f32x4 gg = gp[64 * j]; f32x4 v;
                v.x = pg8::bf_lo(xw.x) + pg8::bf_lo(w.x) * r * gg.x; v.y = pg8::bf_hi(xw.x) + pg8::bf_hi(w.x) * r * gg.y; v.z = pg8::bf_lo(xw.y) + pg8::bf_lo(w.y) * r * gg.z; v.w = pg8::bf_hi(xw.y) + pg8::bf_hi(w.y) * r * gg.w; xr[64 * j] = v; } } }
#undef PH
}

extern "C" void kernel_launch(void* const* d_in, const int* in_sizes, int n_in, void* d_out, int out_size, void* d_ws, size_t ws_size, hipStream_t stream) {
    static int grid = 0;
    if (grid == 0) {
        if (n_in != 31 || out_size != MROWS * DM || ws_size < WS_END) { fprintf(stderr, "kernel_launch: unexpected shapes (n_in %d, out %d, ws %zu)\n", n_in, out_size, ws_size); grid = -1; return; }
        int dev = 0, cus = 0, per_cu = 0;
        hipGetDevice(&dev); hipDeviceGetAttribute(&cus, hipDeviceAttributeMultiprocessorCount, dev);
        if (hipFuncSetAttribute((const void*)mk_fwd, hipFuncAttributeMaxDynamicSharedMemorySize, LDS_BYTES) != hipSuccess) { fprintf(stderr, "kernel_launch: hipFuncSetAttribute failed\n"); grid = -1; return; }
        if (hipOccupancyMaxActiveBlocksPerMultiprocessor(&per_cu, (const void*)mk_fwd, NTHREADS, LDS_BYTES) != hipSuccess || per_cu < 1) { fprintf(stderr, "kernel_launch: occupancy query gives %d\n", per_cu); per_cu = 1; }
        (void)hipGetLastError();
        grid = cus * 1;
    }
    if (grid < 0) return;
    Args a{};
    for (int i = 0; i < 31; ++i) a.in[i] = (const float*)d_in[i];
    a.out = (float*)d_out; a.ws = (unsigned char*)d_ws;
    void* kargs[] = {&a};
    hipError_t e = hipLaunchCooperativeKernel((const void*)mk_fwd, dim3(grid), dim3(NTHREADS), kargs, LDS_BYTES, stream);
    if (e != hipSuccess) fprintf(stderr, "kernel_launch: cooperative launch failed: %s (grid %d)\n", hipGetErrorString(e), grid);
}
```
